# Optimizing an MI355X kernel written in HIP

```python
import math
import jax
import jax.numpy as jnp
from jax import lax
import numpy as np

D_MODEL = 1024
BATCH = 8
SEQ = 4096
DEPTH = 4

GRID_W = 64
CTX_LEN = 256
EPS = 1e-6
FOURIER_GROUPS = 4
FOURIER_GROUP_W = 64
FOURIER_WIDTH = FOURIER_GROUPS * FOURIER_GROUP_W
HYENA_WIDTH = 256
HYENA_SHORT = 3
HYENA_BANDS = 16
HYENA_EMB = 1 + 2 * HYENA_BANDS
HYENA_FFN = 64
HYENA_MIN_DECAY = -math.log(1e-2) / 1.5
HYENA_MAX_DECAY = -math.log(1e-2) / 0.3
POOL_WINDOWS = (2, 4, 8, 16)
POOL_GROUP_W = 64
POOL_WIDTH = len(POOL_WINDOWS) * POOL_GROUP_W
SSM_GROUPS = 2
HEADS_PER_GROUP = 4
SSM_HEADS = SSM_GROUPS * HEADS_PER_GROUP
SSM_HEAD_DIM = 64
SSM_WIDTH = SSM_HEADS * SSM_HEAD_DIM
SSM_STATE = 128
SSM_CONV = 3
SSM_CHUNK = 128
SSM_CONV_CH = SSM_WIDTH + 2 * SSM_GROUPS * SSM_STATE
SSM_IN = SSM_WIDTH + SSM_CONV_CH + 2 * SSM_HEADS
IN_WIDTH = FOURIER_WIDTH + 3 * HYENA_WIDTH + POOL_WIDTH + SSM_IN
IN_SPLITS = (FOURIER_WIDTH, FOURIER_WIDTH + 3 * HYENA_WIDTH, FOURIER_WIDTH + 3 * HYENA_WIDTH + POOL_WIDTH)
N_BRANCHES = 4
BRANCH_WIDTH = FOURIER_WIDTH + HYENA_WIDTH + POOL_WIDTH + SSM_WIDTH
BRANCH_SPLITS = (FOURIER_WIDTH, FOURIER_WIDTH + HYENA_WIDTH, FOURIER_WIDTH + HYENA_WIDTH + POOL_WIDTH)
N_EXPERTS = 32
TOP_K = 4
EXPERT_FF = 1024
SWIGLU_LIMIT = 7.0
SWIGLU_ALPHA = 1.702
MOE_BLOCK = 128

kernel_name = 'hybrid_fourier_hyena_pool_ssd_moe_dit'


def rmsnorm(x, g):
    xf = x.astype(jnp.float32)
    y = xf * lax.rsqrt(jnp.mean(xf * xf, axis=-1, keepdims=True) + EPS)
    return y.astype(x.dtype) * g


def dwconv_centred(x, w, b):
    k_w = w.shape[0]
    n = x.shape[1]
    xp = jnp.pad(x, ((0, 0), ((k_w - 1) // 2, k_w // 2), (0, 0)))
    return sum(w[k] * xp[:, k:k + n] for k in range(k_w)) + b


def fourier_mix(u):
    b, n, _ = u.shape
    ug = u.reshape(b, n, FOURIER_GROUPS, FOURIER_GROUP_W).astype(jnp.float32)
    y = jnp.fft.fft2(ug, axes=(1, 3), norm='ortho').real
    return y.reshape(b, n, FOURIER_WIDTH).astype(u.dtype)


def implicit_filter(n, lp):
    pos = jnp.arange(n, dtype=jnp.float32)
    t = pos / (n - 1)
    ang = 2.0 * math.pi * pos / n
    freqs = jnp.linspace(1e-4, HYENA_BANDS - 1, HYENA_BANDS, dtype=jnp.float32)
    feats = jnp.concatenate([t[:, None], jnp.cos(ang[:, None] * freqs), -jnp.sin(ang[:, None] * freqs)], axis=-1)
    hdn = jnp.sin(feats @ lp['hy_ffn_w1'] + lp['hy_ffn_b1'])
    hdn = jnp.sin(hdn @ lp['hy_ffn_w2'] + lp['hy_ffn_b2'])
    k = (hdn @ lp['hy_ffn_w3']).astype(jnp.float32).reshape(n, 2, HYENA_WIDTH)
    deltas = jnp.linspace(HYENA_MIN_DECAY, HYENA_MAX_DECAY, HYENA_WIDTH, dtype=jnp.float32)
    k = k * jnp.exp(-t[:, None, None] * deltas)
    k_two = jnp.concatenate([k[:, 0], jnp.zeros((1, HYENA_WIDTH), jnp.float32), jnp.flip(k[1:, 1], axis=0)], axis=0)
    return k_two / jnp.sum(jnp.abs(k_two), axis=0, keepdims=True)


def hyena_mix(u, lp):
    b, n, _ = u.shape
    u = dwconv_centred(u, lp['hy_conv_w'], lp['hy_conv_b'])
    x1, x2, v = jnp.split(u, 3, axis=-1)
    k_two = implicit_filter(n, lp)
    vv = (x2 * v).astype(jnp.float32)
    n_fft = 2 * n
    y = jnp.fft.irfft(jnp.fft.rfft(vv, n=n_fft, axis=1) * jnp.fft.rfft(k_two, n=n_fft, axis=0)[None], n=n_fft, axis=1)[:, :n]
    y = y + vv * lp['hy_bias']
    return (x1 * y).astype(u.dtype)


def pool_mix(u, lp, n_rows):
    b, n, cw = u.shape
    row_len = n // n_rows
    ug = u.reshape(b, n_rows, row_len, len(POOL_WINDOWS), POOL_GROUP_W)
    cs = jnp.pad(jnp.cumsum(ug.astype(jnp.float32), axis=2), ((0, 0), (0, 0), (1, 0), (0, 0), (0, 0)))
    pos = jnp.arange(row_len)
    means = []
    for gi, win in enumerate(POOL_WINDOWS):
        lo = jnp.clip(pos - win // 2, 0, row_len)
        hi = jnp.clip(pos + win // 2, 0, row_len)
        csg = cs[:, :, :, gi]
        means.append((csg[:, :, hi] - csg[:, :, lo]) / (hi - lo).astype(jnp.float32)[:, None])
    pooled = jnp.stack(means, axis=3) - ug
    mixed = jnp.einsum('brwgc,gcd->brwgd', pooled, lp['pool_w'])
    return mixed.reshape(b, n, cw) * lp['pool_scale']


def ssd_scan(xs, dt, a, bm, cm, h0):
    b, n_tok, g, r, p = xs.shape
    n_st = bm.shape[-1]
    q = SSM_CHUNK
    nc = n_tok // q
    xs = xs.reshape(b, nc, q, g, r, p)
    dt = dt.reshape(b, nc, q, g, r)
    bm = bm.reshape(b, nc, q, g, n_st)
    cm = cm.reshape(b, nc, q, g, n_st)
    acs = jnp.cumsum(dt * a, axis=2)
    seg = acs[:, :, :, None] - acs[:, :, None, :]
    mask = jnp.tril(jnp.ones((q, q), bool))[:, :, None, None]
    decay_in = jnp.exp(jnp.where(mask, seg, -jnp.inf))
    scores = jnp.einsum('bcign,bcjgn->bcijg', cm, bm)
    xdt = xs * dt[..., None]
    y_diag = jnp.einsum('bcijgr,bcjgrp->bcigrp', scores[..., None] * decay_in, xdt)
    to_end = jnp.exp(acs[:, :, -1:] - acs)
    chunk_state = jnp.einsum('bcjgn,bcjgr,bcjgrp->bcgrpn', bm, to_end, xdt)
    chunk_decay = jnp.exp(acs[:, :, -1])

    def carry_step(h, inp):
        s, d = inp
        return h * d[..., None, None] + s, h

    h_last, h_enter = lax.scan(carry_step, h0, (jnp.moveaxis(chunk_state, 1, 0), jnp.moveaxis(chunk_decay, 1, 0)))
    h_enter = jnp.moveaxis(h_enter, 0, 1)
    y_off = jnp.einsum('bcign,bcgrpn,bcigr->bcigrp', cm, h_enter, jnp.exp(acs))
    return (y_diag + y_off).reshape(b, n_tok, g, r, p), h_last


def ssd_mix(u, lp, init_f, init_b):
    b, n, _ = u.shape
    z, xbc, dt_raw = jnp.split(u, [SSM_WIDTH, SSM_WIDTH + SSM_CONV_CH], axis=-1)
    xbc = jax.nn.silu(dwconv_centred(xbc, lp['ssm_conv_w'], lp['ssm_conv_b']))
    xs, bm, cm = jnp.split(xbc, [SSM_WIDTH, SSM_WIDTH + SSM_GROUPS * SSM_STATE], axis=-1)
    xs = xs.reshape(b, n, SSM_GROUPS, HEADS_PER_GROUP, SSM_HEAD_DIM)
    bm = bm.reshape(b, n, SSM_GROUPS, SSM_STATE)
    cm = cm.reshape(b, n, SSM_GROUPS, SSM_STATE)
    dt = jax.nn.softplus(dt_raw.astype(jnp.float32).reshape(b, n, 2, SSM_GROUPS, HEADS_PER_GROUP)
                         + lp['ssm_dt_bias'].astype(jnp.float32).reshape(2, SSM_GROUPS, HEADS_PER_GROUP))
    a = -jnp.exp(lp['ssm_a_log'].astype(jnp.float32)).reshape(2, SSM_GROUPS, HEADS_PER_GROUP)
    flip = lambda t: jnp.flip(t, axis=1)
    y_f, s_f = ssd_scan(xs, dt[:, :, 0], a[0], bm, cm, init_f)
    y_b, s_b = ssd_scan(flip(xs), flip(dt[:, :, 1]), a[1], flip(bm), flip(cm), init_b)
    y = y_f + flip(y_b) + xs * lp['ssm_d'].reshape(SSM_GROUPS, HEADS_PER_GROUP)[:, :, None]
    y = y.reshape(b, n, SSM_WIDTH) * jax.nn.silu(z)
    return rmsnorm(y, lp['ssm_norm']), (s_f, s_b)


def token_mixer(h, lp, n_rows, init_f, init_b):
    proj = h @ lp['w_in']
    f_in, hy_in, pool_in, ssm_in = jnp.split(proj, IN_SPLITS, axis=-1)
    y_ssm, states = ssd_mix(ssm_in, lp, init_f, init_b)
    ys = (fourier_mix(f_in), hyena_mix(hy_in, lp), pool_mix(pool_in, lp, n_rows), y_ssm)
    w_br = jnp.split(lp['w_branch'], BRANCH_SPLITS, axis=0)
    merged = 0.0
    for k in range(N_BRANCHES):
        gate = jax.nn.sigmoid(h @ lp['w_gate'][k])
        merged = merged + gate * (ys[k] @ w_br[k])
    return merged @ lp['w_out'], states


def moe_ffn(h, lp):
    lead = h.shape[:-1]
    h = h.reshape(-1, D_MODEL)
    n_tok = h.shape[0]
    n_pairs = n_tok * TOP_K
    logits = (h @ lp['router_w'] + lp['router_b']).astype(jnp.float32)
    top_logit, top_e = lax.top_k(logits, TOP_K)
    top_w = jax.nn.softmax(top_logit, axis=-1)
    flat_e = top_e.reshape(-1)
    order = jnp.argsort(flat_e)
    e_sorted = flat_e[order]
    tok_sorted = (order // TOP_K).astype(jnp.int32)
    w_sorted = top_w.reshape(-1)[order]
    counts = jnp.bincount(flat_e, length=N_EXPERTS)
    padded = (counts + MOE_BLOCK - 1) // MOE_BLOCK * MOE_BLOCK
    start = jnp.cumsum(counts) - counts
    pad_end = jnp.cumsum(padded)
    pad_start = pad_end - padded
    dest = pad_start[e_sorted] + jnp.arange(n_pairs) - start[e_sorted]
    n_blk = -(-(n_pairs + N_EXPERTS * (MOE_BLOCK - 1)) // MOE_BLOCK)
    n_rows = n_blk * MOE_BLOCK
    row_tok = jnp.full((n_rows,), n_tok, jnp.int32).at[dest].set(tok_sorted)
    row_w = jnp.zeros((n_rows,), jnp.float32).at[dest].set(w_sorted)
    blk_e = jnp.minimum(jnp.searchsorted(pad_end, jnp.arange(n_blk) * MOE_BLOCK, side='right'), N_EXPERTS - 1)
    h_pad = jnp.concatenate([h, jnp.zeros((1, D_MODEL), h.dtype)], axis=0)
    w_up, b_up, w_down, b_down = lp['exp_w_up'], lp['exp_b_up'], lp['exp_w_down'], lp['exp_b_down']

    def expert_block(args):
        rows, wts, e = args
        hu = h_pad[rows] @ w_up[e] + b_up[e]
        glu = jnp.minimum(hu[:, :EXPERT_FF], SWIGLU_LIMIT)
        lin = jnp.clip(hu[:, EXPERT_FF:], -SWIGLU_LIMIT, SWIGLU_LIMIT)
        act = glu * jax.nn.sigmoid(SWIGLU_ALPHA * glu) * (lin + 1.0)
        y = act @ w_down[e] + b_down[e]
        return y * wts[:, None].astype(y.dtype)

    y_rows = lax.map(expert_block, (row_tok.reshape(n_blk, MOE_BLOCK), row_w.reshape(n_blk, MOE_BLOCK), blk_e))
    y = jax.ops.segment_sum(y_rows.reshape(n_rows, D_MODEL), row_tok, num_segments=n_tok + 1)[:n_tok]
    return y.reshape(*lead, D_MODEL)


def setup_inputs(seed: int = 0) -> dict:
    key = jax.random.key(seed)
    keys = iter(jax.random.split(key, 48))

    def nrm(shape, scale):
        return scale * jax.random.normal(next(keys), shape, jnp.float32)

    def gain(shape):
        return 1.0 + nrm(shape, 0.05)

    dt0 = jnp.exp(jax.random.uniform(next(keys), (DEPTH, 2, SSM_HEADS), jnp.float32, math.log(1e-3), math.log(1e-1)))
    a0 = jax.random.uniform(next(keys), (DEPTH, 2, SSM_HEADS), jnp.float32, 1.0, 16.0)
    branch_scale = jnp.concatenate([jnp.full((BRANCH_WIDTH - SSM_WIDTH, 1), FOURIER_WIDTH ** -0.5, jnp.float32),
                                    jnp.full((SSM_WIDTH, 1), SSM_WIDTH ** -0.5, jnp.float32)], axis=0)
    return {
        'x': nrm((BATCH, SEQ, D_MODEL), 1.0),
        'c': nrm((BATCH, D_MODEL), 1.0),
        'ctx': nrm((BATCH, CTX_LEN, D_MODEL), 1.0),
        'c_ctx': nrm((D_MODEL,), 1.0),
        'w_mod': nrm((DEPTH, D_MODEL, 6 * D_MODEL), 0.3 * D_MODEL ** -0.5),
        'b_mod': nrm((DEPTH, 6 * D_MODEL), 0.02),
        'norm_mix': gain((DEPTH, D_MODEL)),
        'norm_ffn': gain((DEPTH, D_MODEL)),
        'w_in': nrm((DEPTH, D_MODEL, IN_WIDTH), D_MODEL ** -0.5),
        'hy_conv_w': nrm((DEPTH, HYENA_SHORT, 3 * HYENA_WIDTH), HYENA_SHORT ** -0.5),
        'hy_conv_b': nrm((DEPTH, 3 * HYENA_WIDTH), 0.02),
        'hy_ffn_w1': nrm((DEPTH, HYENA_EMB, HYENA_FFN), HYENA_EMB ** -0.5),
        'hy_ffn_b1': nrm((DEPTH, HYENA_FFN), 0.02),
        'hy_ffn_w2': nrm((DEPTH, HYENA_FFN, HYENA_FFN), HYENA_FFN ** -0.5),
        'hy_ffn_b2': nrm((DEPTH, HYENA_FFN), 0.02),
        'hy_ffn_w3': nrm((DEPTH, HYENA_FFN, 2 * HYENA_WIDTH), HYENA_FFN ** -0.5),
        'hy_bias': nrm((DEPTH, HYENA_WIDTH), 0.5),
        'pool_w': nrm((DEPTH, len(POOL_WINDOWS), POOL_GROUP_W, POOL_GROUP_W), POOL_GROUP_W ** -0.5),
        'pool_scale': gain((DEPTH, POOL_WIDTH)),
        'ssm_conv_w': nrm((DEPTH, SSM_CONV, SSM_CONV_CH), SSM_CONV ** -0.5),
        'ssm_conv_b': nrm((DEPTH, SSM_CONV_CH), 0.02),
        'ssm_dt_bias': dt0 + jnp.log(-jnp.expm1(-dt0)),
        'ssm_a_log': jnp.log(a0),
        'ssm_d': 1.0 + nrm((DEPTH, SSM_HEADS), 0.1),
        'ssm_norm': gain((DEPTH, SSM_WIDTH)),
        'w_branch': nrm((DEPTH, BRANCH_WIDTH, D_MODEL), 1.0) * branch_scale,
        'w_gate': nrm((DEPTH, N_BRANCHES, D_MODEL, D_MODEL), D_MODEL ** -0.5),
        'w_out': nrm((DEPTH, D_MODEL, D_MODEL), D_MODEL ** -0.5),
        'router_w': nrm((DEPTH, D_MODEL, N_EXPERTS), D_MODEL ** -0.5),
        'router_b': nrm((DEPTH, N_EXPERTS), 0.01),
        'exp_w_up': nrm((DEPTH, N_EXPERTS, D_MODEL, 2 * EXPERT_FF), D_MODEL ** -0.5),
        'exp_b_up': nrm((DEPTH, N_EXPERTS, 2 * EXPERT_FF), 0.02),
        'exp_w_down': nrm((DEPTH, N_EXPERTS, EXPERT_FF, D_MODEL), EXPERT_FF ** -0.5),
        'exp_b_down': nrm((DEPTH, N_EXPERTS, D_MODEL), 0.02),
        'norm_final': gain((D_MODEL,)),
    }


def reference(x, c, ctx, c_ctx, w_mod, b_mod, norm_mix, norm_ffn, w_in, hy_conv_w, hy_conv_b,
              hy_ffn_w1, hy_ffn_b1, hy_ffn_w2, hy_ffn_b2, hy_ffn_w3, hy_bias, pool_w, pool_scale,
              ssm_conv_w, ssm_conv_b, ssm_dt_bias, ssm_a_log, ssm_d, ssm_norm, w_branch, w_gate, w_out,
              router_w, router_b, exp_w_up, exp_b_up, exp_w_down, exp_b_down, norm_final):
    batch, n_lat = x.shape[0], x.shape[1]
    rows = n_lat // GRID_W
    zero_state = jnp.zeros((batch, SSM_GROUPS, HEADS_PER_GROUP, SSM_HEAD_DIM, SSM_STATE), jnp.float32)
    silu_c = jax.nn.silu(c)
    silu_cc = jax.nn.silu(c_ctx)
    for layer in range(DEPTH):
        lp = {
            'w_in': w_in[layer], 'hy_conv_w': hy_conv_w[layer], 'hy_conv_b': hy_conv_b[layer],
            'hy_ffn_w1': hy_ffn_w1[layer], 'hy_ffn_b1': hy_ffn_b1[layer], 'hy_ffn_w2': hy_ffn_w2[layer],
            'hy_ffn_b2': hy_ffn_b2[layer], 'hy_ffn_w3': hy_ffn_w3[layer], 'hy_bias': hy_bias[layer],
            'pool_w': pool_w[layer], 'pool_scale': pool_scale[layer],
            'ssm_conv_w': ssm_conv_w[layer], 'ssm_conv_b': ssm_conv_b[layer], 'ssm_dt_bias': ssm_dt_bias[layer],
            'ssm_a_log': ssm_a_log[layer], 'ssm_d': ssm_d[layer], 'ssm_norm': ssm_norm[layer],
            'w_branch': w_branch[layer], 'w_gate': w_gate[layer], 'w_out': w_out[layer],
            'router_w': router_w[layer], 'router_b': router_b[layer],
            'exp_w_up': exp_w_up[layer], 'exp_b_up': exp_b_up[layer],
            'exp_w_down': exp_w_down[layer], 'exp_b_down': exp_b_down[layer],
        }
        mod_lat = (silu_c @ w_mod[layer] + b_mod[layer])[:, None, :]
        mod_ctx = (silu_cc @ w_mod[layer] + b_mod[layer])[None, None, :]
        sh1, sc1, g1, sh2, sc2, g2 = jnp.split(mod_lat, 6, axis=-1)
        csh1, csc1, cg1, csh2, csc2, cg2 = jnp.split(mod_ctx, 6, axis=-1)
        h_ctx = rmsnorm(ctx, norm_mix[layer]) * (1.0 + csc1) + csh1
        y_ctx, ctx_states = token_mixer(h_ctx, lp, 1, zero_state, zero_state)
        h_lat = rmsnorm(x, norm_mix[layer]) * (1.0 + sc1) + sh1
        y_lat, _ = token_mixer(h_lat, lp, rows, ctx_states[0], ctx_states[1])
        x = x + g1 * y_lat
        h_lat = rmsnorm(x, norm_ffn[layer]) * (1.0 + sc2) + sh2
        x = x + g2 * moe_ffn(h_lat, lp)
        if layer < DEPTH - 1:
            ctx = ctx + cg1 * y_ctx
            h_ctx = rmsnorm(ctx, norm_ffn[layer]) * (1.0 + csc2) + csh2
            ctx = ctx + cg2 * moe_ffn(h_ctx, lp)
    return rmsnorm(x, norm_final)
```

```cpp
#include <hip/hip_runtime.h>
#include <cstdio>
#include <cstdint>
#define LAS __attribute__((address_space(3)))
typedef unsigned short bf16_t;
typedef short bf16x8 __attribute__((ext_vector_type(8)));
typedef short bf16x4 __attribute__((ext_vector_type(4)));
typedef float f32x4 __attribute__((ext_vector_type(4)));
typedef float f32x16 __attribute__((ext_vector_type(16)));
typedef unsigned u32x4 __attribute__((ext_vector_type(4)));
typedef unsigned u32x2 __attribute__((ext_vector_type(2)));

constexpr int DM = 1024, NB = 8, SEQ = 4096, CTXL = 256, NL = 4;
constexpr int TL = NB * SEQ, TC = NB * CTXL, T = TL + TC;
constexpr int NTH = 512;
constexpr int INW = 2832;
constexpr int N1 = 6912;
constexpr int PJW = 2560;
constexpr int YCW = 1536;
constexpr int NEXP = 32, EFF = 1024;
constexpr int NCH = 34;
constexpr int MAXU = 576;
constexpr int RMAX = MAXU * 256;
constexpr float EPSN = 1e-6f;

constexpr size_t alup(size_t x) { return (x + 255) & ~size_t(255); }
constexpr size_t WS_CTL   = 0;
constexpr size_t WS_W1T   = 16384;
constexpr size_t WS_WFT   = WS_W1T   + alup((size_t)NL * N1 * 1024 * 2);
constexpr size_t WS_WBRT  = WS_WFT   + alup((size_t)NL * 512 * 1024 * 2);
constexpr size_t WS_WOUTT = WS_WBRT  + alup((size_t)NL * 1024 * YCW * 2);
constexpr size_t WS_WUPT  = WS_WOUTT + alup((size_t)NL * 1024 * 1024 * 2);
constexpr size_t WS_WDNT  = WS_WUPT  + alup((size_t)NL * 32 * 2048 * 1024 * 2);
constexpr size_t WS_D4C   = WS_WDNT  + alup((size_t)NL * 32 * 1024 * 1024 * 2);
constexpr size_t WS_D4S   = WS_D4C   + alup((size_t)4096 * 4096 * 2);
constexpr size_t WS_D256  = WS_D4S   + alup((size_t)4096 * 4096 * 2);
constexpr size_t WS_KRAW  = WS_D256  + alup((size_t)256 * 4096 * 2);
constexpr size_t WS_KPART = WS_KRAW  + alup((size_t)NL * 2 * 4096 * 512 * 4);
constexpr size_t WS_MOD   = WS_KPART + alup((size_t)NL * 2 * 64 * 512 * 4);
constexpr size_t WS_H     = WS_MOD   + alup((size_t)NL * 9 * 6144 * 4);
constexpr size_t WS_G     = WS_H     + alup((size_t)T * 1024 * 2);
constexpr size_t WS_PJ    = WS_G     + alup((size_t)T * 4096 * 2);
constexpr size_t WS_DTR   = WS_PJ    + alup((size_t)T * PJW * 2);
constexpr size_t WS_DT    = WS_DTR   + alup((size_t)T * 16 * 4);
constexpr size_t WS_VT    = WS_DT    + alup((size_t)T * 16 * 4);
constexpr size_t WS_VTC   = WS_VT    + alup((size_t)2048 * 8192 * 2);
constexpr size_t WS_YC    = WS_VTC   + alup((size_t)2048 * 8192 * 2);
constexpr size_t WS_XBN   = WS_YC    + alup((size_t)T * YCW * 2);
constexpr size_t WS_XST   = WS_XBN   + alup((size_t)T * 1024 * 2);
constexpr size_t WS_XSTC  = WS_XST   + alup((size_t)8 * 768 * 4096 * 2);
constexpr size_t WS_VVT   = WS_XSTC  + alup((size_t)8 * 768 * 256 * 2);
constexpr size_t WS_VVTC  = WS_VVT   + alup((size_t)8 * 256 * 4096 * 2);
constexpr size_t WS_CVT   = WS_VVTC  + alup((size_t)8 * 256 * 256 * 2);
constexpr size_t WS_CVTC  = WS_CVT   + alup((size_t)8 * 256 * 4096 * 4);
constexpr size_t WS_ST    = WS_CVTC  + alup((size_t)8 * 256 * 256 * 4);
constexpr size_t WS_HENT  = WS_ST    + alup((size_t)8 * 2 * 4 * 2 * NCH * 8192 * 4);
constexpr size_t WS_ACT   = WS_HENT  + alup((size_t)8 * 2 * 4 * 2 * NCH * 8192 * 2);
constexpr size_t WS_YD    = WS_ACT   + alup((size_t)8 * 2 * 4 * 2 * NCH * 4);
constexpr size_t WS_SSQ   = WS_YD    + alup((size_t)T * 512 * 4);
constexpr size_t WS_MG    = WS_SSQ   + alup((size_t)T * 8 * 4);
constexpr size_t WS_X1    = WS_MG    + alup((size_t)T * 1024 * 2);
constexpr size_t WS_XC    = WS_X1    + alup((size_t)T * 1024 * 4);
constexpr size_t WS_H2    = WS_XC    + alup((size_t)T * 1024 * 4);
constexpr size_t WS_TKE   = WS_H2    + alup((size_t)T * 1024 * 2);
constexpr size_t WS_TKW   = WS_TKE   + alup((size_t)T * 4 * 4);
constexpr size_t WS_BCNT  = WS_TKW   + alup((size_t)T * 4 * 4);
constexpr size_t WS_RTOK  = WS_BCNT  + alup((size_t)1024 * 32 * 4);
constexpr size_t WS_RPAIR = WS_RTOK  + alup((size_t)RMAX * 4);
constexpr size_t WS_RW    = WS_RPAIR + alup((size_t)RMAX * 4);
constexpr size_t WS_META  = WS_RW    + alup((size_t)RMAX * 4);
constexpr size_t WS_ACTB  = WS_META  + alup(256);
constexpr size_t WS_YP    = WS_ACTB  + alup((size_t)RMAX * 1024 * 2);
constexpr size_t WS_END   = WS_YP    + alup((size_t)T * 4 * 1024 * 2);

constexpr int LDS_BYTES = 155648;
constexpr int LDS_XB = LDS_BYTES - 64;

__device__ __forceinline__ unsigned cvt_pk_bf16(float lo, float hi) { typedef __bf16 bf2_t __attribute__((ext_vector_type(2))); const bf2_t v = {(__bf16)lo, (__bf16)hi}; return __builtin_bit_cast(unsigned, v); }
__device__ __forceinline__ bf16_t f2bf(float f) { return (bf16_t)(cvt_pk_bf16(f, 0.f) & 0xffffu); }
__device__ __forceinline__ float bf2f(bf16_t b) { return __uint_as_float(((unsigned)b) << 16); }
__device__ __forceinline__ float bflo(unsigned u) { return __uint_as_float(u << 16); }
__device__ __forceinline__ float bfhi(unsigned u) { return __uint_as_float(u & 0xffff0000u); }
template <int X> __device__ __forceinline__ float swz_xor(float v) { return __int_as_float(__builtin_amdgcn_ds_swizzle(__float_as_int(v), (X << 10) | 0x1f)); }
__device__ __forceinline__ float xor32_sum(float v) {
    typedef unsigned u2 __attribute__((ext_vector_type(2)));
    const u2 r = __builtin_amdgcn_permlane32_swap(__float_as_uint(v), __float_as_uint(v), false, false);
    return __uint_as_float(r[0]) + __uint_as_float(r[1]);
}
__device__ __forceinline__ float wave_sum(float v) {
    v += swz_xor<1>(v); v += swz_xor<2>(v); v += swz_xor<4>(v); v += swz_xor<8>(v); v += swz_xor<16>(v);
    return xor32_sum(v);
}
__device__ __forceinline__ int otid() { int t = threadIdx.x; asm volatile("" : "+v"(t)); return t; }
__device__ __forceinline__ int obid() { int t = blockIdx.x; asm volatile("" : "+s"(t)); return t; }
__device__ __forceinline__ int ouni(int t) { asm volatile("" : "+s"(t)); return t; }
__device__ __forceinline__ float fsigmoid(float x) { return __builtin_amdgcn_rcpf(1.f + __expf(-x)); }
__device__ __forceinline__ float fsilu(float x) { return x * fsigmoid(x); }
__device__ __forceinline__ float fsoftplus(float x) { return x > 20.f ? x : log1pf(expf(x)); }

#define XB_TMO      128
#define XB_XCNT(j)  (256  + 64 * (j))
#define XB_XSUB(j)  (1280 + 64 * (j))
#define XB_XGEN(j)  (2304 + 64 * (j))
#define XB_TOP      3328
#define XB_TOPGEN   3392
#define XCD_BAR_WORDS 3456
#define XB_SPIN_CAP (1u << 22)
__device__ __forceinline__ unsigned xb_ld(unsigned* p)              { return __hip_atomic_load(p, __ATOMIC_RELAXED, __HIP_MEMORY_SCOPE_AGENT); }
__device__ __forceinline__ unsigned xb_add(unsigned* p, unsigned v) { return __hip_atomic_fetch_add(p, v, __ATOMIC_RELAXED, __HIP_MEMORY_SCOPE_AGENT); }
__device__ __forceinline__ unsigned xb_xcc_id() { return (unsigned)__builtin_amdgcn_s_getreg((3 << 11) | 20) & 0xFu; }
#define XB_SPIN(cond, bar) do { unsigned _sp = 0; while (cond) { __builtin_amdgcn_s_sleep(1); \
    if ((++_sp & 255u) == 0u) { if (xb_ld(&(bar)[XB_TMO])) break; if (_sp > XB_SPIN_CAP) { atomicAdd(&(bar)[XB_TMO], 1u); break; } } } } while (0)
struct XcdBarrier { unsigned* bar; unsigned x; volatile LAS unsigned* st; };
__device__ __forceinline__ XcdBarrier xcd_barrier_post(unsigned* bar, volatile LAS unsigned* st) {
    XcdBarrier b; b.bar = bar; b.x = xb_xcc_id(); b.st = st;
    if (threadIdx.x == 0) (void)xb_add(&bar[XB_XCNT(b.x)], 1u);
    return b;
}
__device__ __forceinline__ void xcd_barrier_complete(unsigned* bar, unsigned x, unsigned& nloc, unsigned& nx) {
    const unsigned G = gridDim.x * gridDim.y * gridDim.z;
    unsigned sum, cnt, mine, sp = 0u;
    for (;;) {
        sum = 0u; cnt = 0u; mine = 0u;
#pragma unroll
        for (unsigned j = 0; j < 16; ++j) { const unsigned c = xb_ld(&bar[XB_XCNT(j)]); sum += c; cnt += (c > 0u) ? 1u : 0u; mine = (j == x) ? c : mine; }
        if (sum == G) break;
        __builtin_amdgcn_s_sleep(1);
        if ((++sp & 255u) == 0u) { if (xb_ld(&bar[XB_TMO])) break; if (sp > XB_SPIN_CAP) { atomicAdd(&bar[XB_TMO], 1u); break; } }
    }
    nloc = mine > 0u ? mine : 1u; nx = cnt > 0u ? cnt : 1u;
}
__device__ __forceinline__ void xcd_barrier(const XcdBarrier& b) {
    asm volatile("s_waitcnt vmcnt(0)" ::: "memory");
    __syncthreads();
    if (threadIdx.x == 0) {
        unsigned* bar = b.bar;
        __builtin_amdgcn_s_waitcnt(0);
        unsigned nloc = b.st[0], nx = b.st[1];
        if (nloc == 0u) { xcd_barrier_complete(bar, b.x, nloc, nx); b.st[0] = nloc; b.st[1] = nx; }
        const unsigned old = xb_add(&bar[XB_XSUB(b.x)], 1u);
        const unsigned gen = old / nloc;
        if (old + 1u == (gen + 1u) * nloc) {
            __builtin_amdgcn_fence(__ATOMIC_RELEASE, "agent");
            asm volatile("s_waitcnt vmcnt(0)" ::: "memory");
            const unsigned og = xb_add(&bar[XB_TOP], 1u);
            const unsigned tg = og / nx;
            if (og + 1u == (tg + 1u) * nx) xb_add(&bar[XB_TOPGEN], 1u);
            else XB_SPIN(xb_ld(&bar[XB_TOPGEN]) == tg, bar);
            __builtin_amdgcn_fence(__ATOMIC_ACQUIRE, "agent");
            xb_add(&bar[XB_XGEN(b.x)], 1u);
            asm volatile("s_waitcnt vmcnt(0)" ::: "memory");
        } else {
            XB_SPIN(xb_ld(&bar[XB_XGEN(b.x)]) == gen, bar);
            __builtin_amdgcn_fence(__ATOMIC_ACQUIRE, "agent");
            asm volatile("s_waitcnt vmcnt(0)" ::: "memory");
        }
    }
    __syncthreads();
}

namespace pg8 {
constexpr int BM = 256, BK = 64, HALF = 128, HTB = HALF * BK * 2, STAGE_BYTES = 8 * HTB, NXCD = 8, WGM = 8;
__host__ __device__ __forceinline__ int lds_byte(int r, int c) { const int st = (r >> 4) * 2 + (c >> 5), rr = r & 15, cc = c & 31, ob = rr * 64 + cc * 2; return st * 1024 + (ob ^ (((ob >> 9) & 1) << 5)); }
__host__ __device__ __forceinline__ void stage_rc(int b, int& R, int& C) { const int st = b / 1024, sb = b % 1024, swz = sb ^ (((sb >> 9) & 1) << 5); R = (st >> 1) * 16 + swz / 64; C = (st & 1) * 32 + (swz % 64) / 2; }
__host__ __device__ __forceinline__ int perm32(int rho) { const int n = rho >> 4, i = rho & 15; return 8 * (i >> 2) + 4 * n + (i & 3); }

__device__ __forceinline__ void remap_tile(int L, int nM, int nN, int& pm, int& pn) {
    const int nwg = nM * nN; int wgid = L;
    { const int q = nwg / NXCD, r = nwg % NXCD, xcd = wgid % NXCD, off = wgid / NXCD; wgid = (xcd < r ? xcd * (q + 1) : r * (q + 1) + (xcd - r) * q) + off; }
    const int nig = WGM * nN, gid = wgid / nig, fm = gid * WGM, gsz = (nM - fm) < WGM ? (nM - fm) : WGM;
    pm = fm + ((wgid % nig) % gsz); pn = (wgid % nig) / gsz;
}

struct GUnit { const char* a0; const char* a1; const char* b0; const char* b1; const int* gidx; int nt, pm, pn, kind, e; };

template <bool GATHER, class Src, class Epi>
__device__ __forceinline__ void gemm_phase(LAS unsigned char* lds, const Src& S, const Epi& E, const int lda, const int ldb) {
    const int tid = otid(), wid = __builtin_amdgcn_readfirstlane(tid >> 6), lane = tid & 63, wr = wid >> 2, wc = wid & 3, fr = lane & 15, fq = lane >> 4;
    unsigned voffA[2], voffB[2];
#pragma unroll
    for (int i = 0; i < 2; ++i) { int R, C; stage_rc(tid * 16 + i * 8192, R, C); const int Rb = (R & ~31) + perm32(R & 31);
        voffA[i] = (unsigned)(R * lda + C) * 2u; voffB[i] = (unsigned)(Rb * ldb + C) * 2u; }
    const size_t kstep = (size_t)(BK * 2);
    const unsigned ldsw = (unsigned)wid * 1024u;
    const int aoff = lds_byte(wr * 64 + fr, fq * 8), boff = lds_byte(wc * 32 + fr, fq * 8);
#define PG8_SA(b, h) (((b) * 2 + (h)) * HTB)
#define PG8_SB(b, h) ((4 + (b) * 2 + (h)) * HTB)
#define PG8_STAGE(bufoff, gbase, voff) do { _Pragma("unroll") for (int _i = 0; _i < 2; ++_i) \
        __builtin_amdgcn_global_load_lds((const unsigned*)((const char*)(gbase) + (voff)[_i]), (LAS unsigned*)(lds + (bufoff) + ldsw + _i * 8192), 16, 0, 0); } while (0)
#define PG8_LDA(dst, b, h) do { _Pragma("unroll") for (int m = 0; m < 4; ++m) _Pragma("unroll") for (int k = 0; k < 2; ++k) dst[m][k] = *(const LAS bf16x8*)(lds + PG8_SA(b, h) + aoff + m * 2048 + k * 1024); } while (0)
#define PG8_LDB(dst, b, h) do { _Pragma("unroll") for (int n = 0; n < 2; ++n) _Pragma("unroll") for (int k = 0; k < 2; ++k) dst[n][k] = *(const LAS bf16x8*)(lds + PG8_SB(b, h) + boff + n * 2048 + k * 1024); } while (0)
#define PG8_MMA(ai, bj, At, Bt) do { __builtin_amdgcn_s_setprio(1); _Pragma("unroll") for (int m = 0; m < 4; ++m) _Pragma("unroll") for (int n = 0; n < 2; ++n) _Pragma("unroll") for (int k = 0; k < 2; ++k) \
        acc[ai][bj][m][n] = __builtin_amdgcn_mfma_f32_16x16x32_bf16(Bt[n][k], At[m][k], acc[ai][bj][m][n], 0, 0, 0); __builtin_amdgcn_s_setprio(0); } while (0)
#define PG8_WAIT_V(n) asm volatile("s_waitcnt vmcnt(" #n ")" ::: "memory")
#define PG8_WAIT_L(n) asm volatile("s_waitcnt lgkmcnt(" #n ")" ::: "memory")
#define PG8_BAR __builtin_amdgcn_s_barrier()
#define PG8_SCHED __builtin_amdgcn_sched_barrier(0)
#define PG8_LOADV(u, v) do { int _tt = tid; asm volatile("" : "+v"(_tt)); _Pragma("unroll") for (int _i = 0; _i < 2; ++_i) { int _R, _C; stage_rc(_tt * 16 + _i * 8192, _R, _C); \
        _Pragma("unroll") for (int _h = 0; _h < 2; ++_h) { if constexpr (GATHER) v[_h][_i] = (unsigned)((u).gidx[_h * 128 + _R] * lda + _C) * 2u; else v[_h][_i] = voffA[_i]; } } } while (0)
    GUnit cur, nxt; int ui = 0;
    if (!S.get(0, cur)) return;
    f32x4 acc[2][2][4][2];
#pragma unroll
    for (int a = 0; a < 2; ++a)
#pragma unroll
        for (int b = 0; b < 2; ++b)
#pragma unroll
            for (int m = 0; m < 4; ++m)
#pragma unroll
                for (int n = 0; n < 2; ++n) acc[a][b][m][n] = (f32x4){0.f, 0.f, 0.f, 0.f};
    bf16x8 At[4][2], B0[2][2], B1[2][2];
    unsigned va[2][2];
    PG8_LOADV(cur, va);
    const char* cA0 = cur.a0; const char* cA1 = cur.a1; const char* cB0 = cur.b0; const char* cB1 = cur.b1;
    PG8_STAGE(PG8_SB(0, 0), cB0, voffB); PG8_STAGE(PG8_SA(0, 0), cA0, va[0]); PG8_STAGE(PG8_SB(0, 1), cB1, voffB); PG8_STAGE(PG8_SA(0, 1), cA1, va[1]);
    if (wr == 1) PG8_BAR;
    PG8_WAIT_V(4); PG8_BAR;
    PG8_STAGE(PG8_SB(1, 0), cB0 + kstep, voffB); PG8_STAGE(PG8_SA(1, 0), cA0 + kstep, va[0]); PG8_STAGE(PG8_SB(1, 1), cB1 + kstep, voffB);
    PG8_WAIT_V(6); PG8_BAR;
    for (;;) {
        const bool has_next = S.get(ui + 1, nxt);
        const char* nA0 = has_next ? nxt.a0 : cA0; const char* nA1 = has_next ? nxt.a1 : cA1;
        const char* nB0 = has_next ? nxt.b0 : cB0; const char* nB1 = has_next ? nxt.b1 : cB1;
        const int nt = cur.nt;
        for (int t = 0; t < nt; t += 2) {
            const bool last = (t == nt - 2);
            const char* a1h1 = cA1 + (size_t)(t + 1) * kstep;
            const char* a2h0 = last ? nA0 : cA0 + (size_t)(t + 2) * kstep; const char* a2h1 = last ? nA1 : cA1 + (size_t)(t + 2) * kstep;
            const char* b2h0 = last ? nB0 : cB0 + (size_t)(t + 2) * kstep; const char* b2h1 = last ? nB1 : cB1 + (size_t)(t + 2) * kstep;
            const char* a3h0 = a2h0 + kstep; const char* b3h0 = b2h0 + kstep; const char* b3h1 = b2h1 + kstep;
            PG8_LDB(B0, 0, 0); PG8_SCHED; PG8_LDA(At, 0, 0); PG8_STAGE(PG8_SA(1, 1), a1h1, va[1]);
            if constexpr (GATHER) { if (last && has_next) { PG8_LOADV(nxt, va); } }
            PG8_WAIT_L(8); PG8_BAR; PG8_WAIT_L(0); PG8_MMA(0, 0, At, B0); PG8_BAR; PG8_SCHED;
            PG8_LDB(B1, 0, 1); PG8_STAGE(PG8_SB(0, 0), b2h0, voffB);
            PG8_BAR; PG8_WAIT_L(0); PG8_MMA(0, 1, At, B1); PG8_BAR;
            PG8_LDA(At, 0, 1); PG8_STAGE(PG8_SA(0, 0), a2h0, va[0]);
            PG8_BAR; PG8_WAIT_L(0); PG8_MMA(1, 0, At, B0); PG8_BAR; PG8_SCHED;
            PG8_STAGE(PG8_SB(0, 1), b2h1, voffB);
            PG8_WAIT_V(6); PG8_BAR; PG8_MMA(1, 1, At, B1); PG8_BAR;
            PG8_LDB(B0, 1, 0); PG8_SCHED; PG8_LDA(At, 1, 0); PG8_STAGE(PG8_SA(0, 1), a2h1, va[1]);
            PG8_WAIT_L(8); PG8_BAR; PG8_WAIT_L(0); PG8_MMA(0, 0, At, B0); PG8_BAR; PG8_SCHED;
            PG8_LDB(B1, 1, 1); PG8_STAGE(PG8_SB(1, 0), b3h0, voffB);
            PG8_BAR; PG8_WAIT_L(0); PG8_MMA(0, 1, At, B1); PG8_BAR;
            PG8_LDA(At, 1, 1); PG8_STAGE(PG8_SA(1, 0), a3h0, va[0]);
            PG8_BAR; PG8_WAIT_L(0); PG8_MMA(1, 0, At, B0); PG8_BAR; PG8_SCHED;
            PG8_STAGE(PG8_SB(1, 1), b3h1, voffB);
            PG8_WAIT_V(6); PG8_BAR; PG8_MMA(1, 1, At, B1); PG8_BAR;
        }
        E(acc, cur, wr, wc, fr, fq);
        if (!has_next) break;
#pragma unroll
        for (int a = 0; a < 2; ++a)
#pragma unroll
            for (int b = 0; b < 2; ++b)
#pragma unroll
                for (int m = 0; m < 4; ++m)
#pragma unroll
                    for (int n = 0; n < 2; ++n) acc[a][b][m][n] = (f32x4){0.f, 0.f, 0.f, 0.f};
        cur = nxt; cA0 = nA0; cA1 = nA1; cB0 = nB0; cB1 = nB1; ++ui;
    }
    PG8_WAIT_V(0);
    if (wr == 0) PG8_BAR;
    PG8_BAR;
#undef PG8_SA
#undef PG8_SB
#undef PG8_STAGE
#undef PG8_LDA
#undef PG8_LDB
#undef PG8_MMA
#undef PG8_WAIT_V
#undef PG8_WAIT_L
#undef PG8_BAR
#undef PG8_SCHED
#undef PG8_LOADV
}
}
using pg8::GUnit;

struct Params { const float* in[35]; float* out; unsigned char* ws; };
typedef const Params __attribute__((address_space(4))) CParams;
__device__ __forceinline__ CParams* kparams() { CParams* p = (CParams*)__builtin_amdgcn_kernarg_segment_ptr(); asm volatile("" : "+s"(p)); return p; }
enum { I_X = 0, I_C, I_CTX, I_CCTX, I_WMOD, I_BMOD, I_NMIX, I_NFFN, I_WIN, I_HCW, I_HCB, I_HW1, I_HB1, I_HW2, I_HB2, I_HW3, I_HBIAS, I_PW, I_PS,
       I_SCW, I_SCB, I_SDTB, I_SALOG, I_SD, I_SNORM, I_WBR, I_WGATE, I_WOUT, I_RW, I_RB, I_WUP, I_BUP, I_WDN, I_BDN, I_NFIN };

__device__ __forceinline__ int tok_modj(int t) { return t < TL ? (t >> 12) : 8; }

struct TJob { const float* src; size_t ld_src; int K, N; bf16_t* dst; size_t ld_dst; int nmat; size_t src_ms, dst_ms; const float* kscale; };
__device__ __forceinline__ TJob make_tjob(CParams& P, int l, int j) {
    unsigned char* ws = P.ws; TJob J;
    bf16_t* W1T = (bf16_t*)(ws + WS_W1T) + (size_t)l * N1 * 1024;
    bf16_t* WBRT = (bf16_t*)(ws + WS_WBRT) + (size_t)l * 1024 * YCW;
    const float* wbr = P.in[I_WBR] + (size_t)l * 1280 * 1024;
    J.kscale = nullptr; J.nmat = 1; J.src_ms = 0; J.dst_ms = 0; J.ld_src = 1024; J.K = 1024; J.N = 1024; J.ld_dst = 1024;
    if (j == 0) { J.src = P.in[I_WGATE] + (size_t)l * 4 * 1024 * 1024; J.dst = W1T; J.nmat = 4; J.src_ms = (size_t)1024 * 1024; J.dst_ms = (size_t)1024 * 1024; }
    else if (j == 1) { J.src = P.in[I_WIN] + (size_t)l * 1024 * INW + 256; J.ld_src = INW; J.N = 2576; J.dst = W1T + (size_t)4096 * 1024; }
    else if (j == 2) { J.src = wbr; J.K = 256; J.dst = WBRT; J.ld_dst = YCW; }
    else if (j == 3) { J.src = wbr; J.K = 256; J.dst = WBRT + 256; J.ld_dst = YCW; }
    else if (j == 4) { J.src = wbr + (size_t)256 * 1024; J.K = 256; J.dst = WBRT + 512; J.ld_dst = YCW; }
    else if (j == 5) { J.src = wbr + (size_t)768 * 1024; J.K = 512; J.dst = WBRT + 1024; J.ld_dst = YCW; J.kscale = P.in[I_SNORM] + l * 512; }
    else if (j == 6) { J.src = P.in[I_WOUT] + (size_t)l * 1024 * 1024; J.dst = (bf16_t*)(ws + WS_WOUTT) + (size_t)l * 1024 * 1024; }
    else if (j == 7) { J.src = P.in[I_WUP] + (size_t)l * 32 * 1024 * 2048; J.ld_src = 2048; J.N = 2048; J.dst = (bf16_t*)(ws + WS_WUPT) + (size_t)l * 32 * 2048 * 1024; J.nmat = 32; J.src_ms = (size_t)1024 * 2048; J.dst_ms = (size_t)2048 * 1024; }
    else { J.src = P.in[I_WDN] + (size_t)l * 32 * 1024 * 1024; J.dst = (bf16_t*)(ws + WS_WDNT) + (size_t)l * 32 * 1024 * 1024; J.nmat = 32; J.src_ms = (size_t)1024 * 1024; J.dst_ms = (size_t)1024 * 1024; }
    return J;
}
__device__ __forceinline__ void p0_transposes(CParams& P, unsigned char* smem) {
    float* tile = (float*)smem;
    const int G = gridDim.x, tid = otid(), bid = obid();
    int base = 0;
#pragma unroll 1
    for (int jj = 0; jj < NL * 9; ++jj) {
        const TJob J = make_tjob(P, jj / 9, jj % 9);
        const int ktiles = J.K / 64, ntiles = (J.N + 255) / 256, per = ktiles * ntiles, total = per * J.nmat;
        const int first = (bid - base % G + G) % G;
#pragma unroll 1
        for (int tI = first; tI < total; tI += G) {
            const int mat = tI / per, r = tI % per, nt = r / ktiles, kt = r % ktiles;
            const float* s = J.src + (size_t)mat * J.src_ms + (size_t)(kt * 64) * J.ld_src + nt * 256;
            bf16_t* d = J.dst + (size_t)mat * J.dst_ms + (size_t)(nt * 256) * J.ld_dst + kt * 64;
            const int nval = (J.N - nt * 256) < 256 ? (J.N - nt * 256) : 256;
            {
                const int row = tid >> 3, c0 = (tid & 7) * 4;
                const float sc = J.kscale ? J.kscale[kt * 64 + row] : 1.f;
                const float* sr = s + (size_t)row * J.ld_src;
#pragma unroll
                for (int j = 0; j < 8; ++j) { const int c = c0 + 32 * j;
                    f32x4 v = (c < nval) ? *(const f32x4*)(sr + c) : (f32x4){0.f, 0.f, 0.f, 0.f};
                    float* tp = tile + row * 257 + c; tp[0] = v[0] * sc; tp[1] = v[1] * sc; tp[2] = v[2] * sc; tp[3] = v[3] * sc; }
            }
            __syncthreads();
            {
                const int n = tid >> 1, kh = (tid & 1) * 32;
                if (n < nval) {
#pragma unroll
                    for (int q = 0; q < 4; ++q) { u32x4 o;
#pragma unroll
                        for (int e = 0; e < 4; ++e) o[e] = cvt_pk_bf16(tile[(kh + q * 8 + 2 * e) * 257 + n], tile[(kh + q * 8 + 2 * e + 1) * 257 + n]);
                        *(u32x4*)(d + (size_t)n * J.ld_dst + kh + q * 8) = o; }
                }
            }
            __syncthreads();
        }
        base += total;
    }
}

__device__ __forceinline__ void p0_prep(CParams& P, unsigned char* smem) {
    const int G = gridDim.x, tid = otid(), bid = obid();
    unsigned char* ws = P.ws;
    p0_transposes(P, smem);
    {
        float* wt = (float*)smem;
        float* ctab = wt + 64 * 65; float* stab = ctab + 64;
        if (tid < 64) { float s, c; sincospif((float)tid / 32.f, &s, &c); ctab[tid] = c * 0.125f; stab[tid] = s * 0.125f; }
        for (int it = bid; it < NL * 4 * 16; it += G) {
            const int l = it / 64, g = (it / 16) & 3, kb = it & 15;
            __syncthreads();
            { const int row = tid >> 3, c0 = (tid & 7) * 8; const float* sr = P.in[I_WIN] + ((size_t)l * 1024 + kb * 64 + row) * INW + g * 64 + c0;
#pragma unroll
              for (int j = 0; j < 8; ++j) wt[row * 65 + c0 + j] = sr[j]; }
            __syncthreads();
            const int rp = tid >> 2, kq = tid & 3, half = rp >> 6, cp = rp & 63;
            const float* tab = half ? stab : ctab;
            float o[16];
#pragma unroll
            for (int kk = 0; kk < 16; ++kk) o[kk] = 0.f;
            for (int c = 0; c < 64; ++c) { const float tv = tab[(c * cp) & 63];
#pragma unroll
                for (int kk = 0; kk < 16; ++kk) o[kk] += wt[(kq * 16 + kk) * 65 + c] * tv; }
            bf16_t* d = (bf16_t*)(ws + WS_WFT) + ((size_t)l * 512 + (g * 2 + half) * 64 + cp) * 1024 + kb * 64 + kq * 16;
            u32x4 o0, o1;
#pragma unroll
            for (int e = 0; e < 4; ++e) { o0[e] = cvt_pk_bf16(o[2 * e], o[2 * e + 1]); o1[e] = cvt_pk_bf16(o[8 + 2 * e], o[8 + 2 * e + 1]); }
            *(u32x4*)d = o0; *(u32x4*)(d + 8) = o1;
        }
        __syncthreads();
    }
    {
        float* pw = (float*)smem;
        float* wb = pw + 64 * 65;
        for (int it = bid; it < NL * 4 * 4; it += G) {
            const int l = it / 16, g = (it / 4) & 3, nb = it & 3;
            __syncthreads();
            for (int e = tid; e < 4096; e += NTH) { const int c = e >> 6, d = e & 63;
                pw[c * 65 + d] = P.in[I_PW][(((size_t)l * 4 + g) * 64 + c) * 64 + d] * P.in[I_PS][l * 256 + g * 64 + d]; }
            for (int e = tid; e < 64 * 256; e += NTH) { const int d = e >> 8, n = e & 255;
                wb[d * 257 + n] = P.in[I_WBR][((size_t)l * 1280 + 512 + g * 64 + d) * 1024 + nb * 256 + n]; }
            __syncthreads();
            const int n = tid & 255, ch = tid >> 8;
            bf16_t* d0 = (bf16_t*)(ws + WS_WBRT) + ((size_t)l * 1024 + nb * 256 + n) * YCW + 768 + g * 64 + ch * 32;
            float o[32];
#pragma unroll
            for (int e = 0; e < 32; ++e) o[e] = 0.f;
#pragma unroll 1
            for (int d = 0; d < 64; ++d) { const float wv = wb[d * 257 + n];
#pragma unroll
                for (int e = 0; e < 32; ++e) o[e] += pw[(ch * 32 + e) * 65 + d] * wv; }
#pragma unroll
            for (int q = 0; q < 4; ++q) { u32x4 ov;
#pragma unroll
                for (int e = 0; e < 4; ++e) ov[e] = cvt_pk_bf16(o[q * 8 + 2 * e], o[q * 8 + 2 * e + 1]);
                *(u32x4*)(d0 + q * 8) = ov; }
        }
        __syncthreads();
    }
    {
        bf16_t* D4C = (bf16_t*)(ws + WS_D4C); bf16_t* D4S = (bf16_t*)(ws + WS_D4S); bf16_t* D256 = (bf16_t*)(ws + WS_D256);
        const int gth = bid * NTH + tid, nth = G * NTH;
        for (int ch = gth; ch < 4096 * 512; ch += nth) {
            const int pp = ch >> 9, p0 = (ch & 511) * 8;
            u32x4 oc, os; float cv[8], sv[8];
#pragma unroll
            for (int e = 0; e < 8; ++e) { const int j = (pp * (p0 + e)) & 4095; float s, c; sincospif((float)j / 2048.f, &s, &c); cv[e] = c * (1.f / 64.f); sv[e] = -s * (1.f / 64.f); }
#pragma unroll
            for (int e = 0; e < 4; ++e) { oc[e] = cvt_pk_bf16(cv[2 * e], cv[2 * e + 1]); os[e] = cvt_pk_bf16(sv[2 * e], sv[2 * e + 1]); }
            *(u32x4*)(D4C + (size_t)pp * 4096 + p0) = oc; *(u32x4*)(D4S + (size_t)pp * 4096 + p0) = os;
        }
        for (int ch = gth; ch < 256 * 64; ch += nth) {
            const int pp = ch >> 6, k0 = (ch & 63) * 8; u32x4 o; float v[8];
#pragma unroll
            for (int e = 0; e < 8; ++e) { const int k = k0 + e; const int j = (pp * (k & 255)) & 255; float s, c; sincospif((float)j / 128.f, &s, &c); v[e] = (k < 256 ? c : -s) * (1.f / 16.f); }
#pragma unroll
            for (int e = 0; e < 4; ++e) o[e] = cvt_pk_bf16(v[2 * e], v[2 * e + 1]);
            *(u32x4*)(D256 + (size_t)pp * 4096 + k0) = o;
        }
    }
    {
        float* feats = (float*)smem;
        float* h1 = feats + 64 * 33;
        float* h2 = h1 + 64 * 65;
        const float dmin = 4.605170185988091f / 1.5f, dmax = 4.605170185988091f / 0.3f;
        for (int it = bid; it < NL * 68; it += G) {
            const int l = it / 68, r = it % 68, cfg = r < 64 ? 0 : 1, tile = cfg ? r - 64 : r, n = cfg ? 256 : 4096;
            __syncthreads();
            for (int e = tid; e < 64 * 33; e += NTH) { const int i = e / 33, f = e % 33; const int pos = tile * 64 + i;
                float v;
                if (f == 0) v = (float)pos / (float)(n - 1);
                else { const int j = (f - 1) & 15; const float fr = 1e-4f + (float)j * ((15.f - 1e-4f) / 15.f);
                       const float ang = 6.283185307179586f * (float)pos / (float)n * fr; v = (f <= 16) ? cosf(ang) : -sinf(ang); }
                feats[e] = v; }
            __syncthreads();
            { const int j = tid & 63, pg = tid >> 6; const float* w1 = P.in[I_HW1] + (size_t)l * 33 * 64; const float b = P.in[I_HB1][l * 64 + j];
              for (int q = 0; q < 8; ++q) { const int i = pg * 8 + q; float s = b; for (int f = 0; f < 33; ++f) s += feats[i * 33 + f] * w1[f * 64 + j]; h1[i * 65 + j] = sinf(s); } }
            __syncthreads();
            { const int j = tid & 63, pg = tid >> 6; const float* w2 = P.in[I_HW2] + (size_t)l * 64 * 64; const float b = P.in[I_HB2][l * 64 + j];
              for (int q = 0; q < 8; ++q) { const int i = pg * 8 + q; float s = b; for (int f = 0; f < 64; ++f) s += h1[i * 65 + f] * w2[f * 64 + j]; h2[i * 65 + j] = sinf(s); } }
            __syncthreads();
            { const int o = tid, c = o & 255, dir = o >> 8; const float* w3 = P.in[I_HW3] + (size_t)l * 64 * 512;
              float w[64];
#pragma unroll
              for (int f = 0; f < 64; ++f) w[f] = w3[f * 512 + o];
              const float delta = dmin + (float)c * ((dmax - dmin) / 255.f);
              float* kr = (float*)(ws + WS_KRAW) + (((size_t)l * 2 + cfg) * 4096 + tile * 64) * 512 + o;
              float asum = 0.f;
              for (int i = 0; i < 64; ++i) { float s = 0.f;
#pragma unroll
                  for (int f = 0; f < 64; ++f) s += h2[i * 65 + f] * w[f];
                  const int pos = tile * 64 + i; const float tt = (float)pos / (float)(n - 1);
                  s *= expf(-tt * delta);
                  kr[(size_t)i * 512] = s;
                  if (!(dir == 1 && pos == 0)) asum += fabsf(s); }
              ((float*)(ws + WS_KPART))[(((size_t)l * 2 + cfg) * 64 + tile) * 512 + o] = asum; }
        }
        __syncthreads();
    }
    {
        float* sc = (float*)smem;
        float* red = sc + 9 * 1024;
        for (int it = bid; it < NL * 24; it += G) {
            const int l = it / 24, nb = it % 24;
            __syncthreads();
            for (int e = tid; e < 9 * 1024; e += NTH) { const int j = e >> 10, k = e & 1023; const float v = j < 8 ? P.in[I_C][j * 1024 + k] : P.in[I_CCTX][k]; sc[e] = fsilu(v); }
            __syncthreads();
            const int n = nb * 256 + (tid & 255), kh = tid >> 8;
            const float* w = P.in[I_WMOD] + (size_t)l * 1024 * 6144 + n;
            float a[9];
#pragma unroll
            for (int j = 0; j < 9; ++j) a[j] = 0.f;
#pragma unroll 8
            for (int k = kh * 512; k < kh * 512 + 512; ++k) { const float wv = w[(size_t)k * 6144];
#pragma unroll
                for (int j = 0; j < 9; ++j) a[j] += sc[j * 1024 + k] * wv; }
            if (kh == 1) {
#pragma unroll
                for (int j = 0; j < 9; ++j) red[(tid & 255) * 9 + j] = a[j]; }
            __syncthreads();
            if (kh == 0) { const float b = P.in[I_BMOD][l * 6144 + n];
#pragma unroll
                for (int j = 0; j < 9; ++j) ((float*)(ws + WS_MOD))[((size_t)l * 9 + j) * 6144 + n] = a[j] + red[(tid & 255) * 9 + j] + b; }
        }
        __syncthreads();
    }
}

__device__ __forceinline__ void norm_row_store(const f32x4 (&v)[4], const float* gain, const float* sc, const float* sh, bf16_t* dst, int lane) {
    float ss = 0.f;
#pragma unroll
    for (int q = 0; q < 4; ++q) ss += v[q][0] * v[q][0] + v[q][1] * v[q][1] + v[q][2] * v[q][2] + v[q][3] * v[q][3];
    ss = wave_sum(ss);
    const float rs = rsqrtf(ss * (1.f / 1024.f) + EPSN);
#pragma unroll
    for (int q = 0; q < 4; ++q) { const int c = q * 256 + lane * 4;
        const f32x4 g = *(const f32x4*)(gain + c), a = *(const f32x4*)(sc + c), b = *(const f32x4*)(sh + c);
        u32x2 o; o[0] = cvt_pk_bf16(v[q][0] * rs * g[0] * (1.f + a[0]) + b[0], v[q][1] * rs * g[1] * (1.f + a[1]) + b[1]);
        o[1] = cvt_pk_bf16(v[q][2] * rs * g[2] * (1.f + a[2]) + b[2], v[q][3] * rs * g[3] * (1.f + a[3]) + b[3]);
        *(u32x2*)(dst + c) = o; }
}
__device__ __forceinline__ void p1_norm0(CParams& P) {
    const int tid_ = otid(), lane = tid_ & 63, w = (obid() * NTH + tid_) >> 6, nw = gridDim.x * (NTH / 64);
    bf16_t* H = (bf16_t*)(P.ws + WS_H); const float* MOD = (const float*)(P.ws + WS_MOD);
    for (int t = w; t < T; t += nw) {
        const float* src = t < TL ? P.in[I_X] + (size_t)t * 1024 : P.in[I_CTX] + (size_t)(t - TL) * 1024;
        f32x4 v[4];
#pragma unroll
        for (int q = 0; q < 4; ++q) v[q] = *(const f32x4*)(src + q * 256 + lane * 4);
        const float* md = MOD + (size_t)tok_modj(t) * 6144;
        norm_row_store(v, P.in[I_NMIX], md + 1024, md, H + (size_t)t * 1024, lane);
    }
}

struct TileGeo { int tok0, b, pos0, slen, isctx; };
__device__ __forceinline__ TileGeo tile_geo(int tt) {
    TileGeo g; g.tok0 = tt * 64;
    if (g.tok0 < TL) { g.isctx = 0; g.b = g.tok0 >> 12; g.pos0 = g.tok0 & 4095; g.slen = 4096; }
    else { g.isctx = 1; const int r = g.tok0 - TL; g.b = r >> 8; g.pos0 = r & 255; g.slen = 256; }
    return g;
}
__device__ __forceinline__ void unpack4(u32x2 u, float (&o)[4]) { o[0] = bflo(u[0]); o[1] = bfhi(u[0]); o[2] = bflo(u[1]); o[3] = bfhi(u[1]); }
__device__ __forceinline__ void unpack8(u32x4 u, float (&o)[8]) {
#pragma unroll
    for (int e = 0; e < 4; ++e) { o[2 * e] = bflo(u[e]); o[2 * e + 1] = bfhi(u[e]); } }

__device__ __forceinline__ void p3_prep(CParams& P, unsigned char* smem, int l) {
    const int G = gridDim.x, tid = otid(), bid = obid();
    unsigned char* ws = P.ws;
    const bf16_t* PJ = (const bf16_t*)(ws + WS_PJ);
    {
        bf16_t* vvL = (bf16_t*)smem;
        const int c4 = tid & 63, tq = tid >> 6;
        const float* cw = P.in[I_HCW] + (size_t)l * 3 * 768; const float* cb = P.in[I_HCB] + (size_t)l * 768;
        float wx[3][4], wv[3][4], bx[4], bv[4];
#pragma unroll
        for (int e = 0; e < 4; ++e) { bx[e] = cb[256 + 4 * c4 + e]; bv[e] = cb[512 + 4 * c4 + e];
#pragma unroll
            for (int k = 0; k < 3; ++k) { wx[k][e] = cw[k * 768 + 256 + 4 * c4 + e]; wv[k][e] = cw[k * 768 + 512 + 4 * c4 + e]; } }
        for (int tt = bid; tt < T / 64; tt += G) {
            const TileGeo g = tile_geo(tt);
            const int p0 = g.pos0 + tq * 8;
            float rx[3][4], rv[3][4];
            const bf16_t* rowp = PJ + (size_t)(g.tok0 + tq * 8) * PJW;
#define LD_HROW(dstx, dstv, dp) do { const int pp = p0 + (dp); if (pp >= 0 && pp < g.slen) { const bf16_t* rp = rowp + (ptrdiff_t)(dp) * PJW; \
                unpack4(*(const u32x2*)(rp + 256 + 4 * c4), dstx); unpack4(*(const u32x2*)(rp + 512 + 4 * c4), dstv); } else { \
                _Pragma("unroll") for (int e = 0; e < 4; ++e) { dstx[e] = 0.f; dstv[e] = 0.f; } } } while (0)
            LD_HROW(rx[0], rv[0], -1); LD_HROW(rx[1], rv[1], 0);
#pragma unroll
            for (int j = 0; j < 8; ++j) {
                LD_HROW(rx[2], rv[2], j + 1);
#pragma unroll
                for (int e = 0; e < 4; ++e) {
                    const float x2 = wx[0][e] * rx[0][e] + wx[1][e] * rx[1][e] + wx[2][e] * rx[2][e] + bx[e];
                    const float vv = wv[0][e] * rv[0][e] + wv[1][e] * rv[1][e] + wv[2][e] * rv[2][e] + bv[e];
                    vvL[(4 * c4 + e) * 72 + tq * 8 + j] = f2bf(x2 * vv);
                    rx[0][e] = rx[1][e]; rx[1][e] = rx[2][e]; rv[0][e] = rv[1][e]; rv[1][e] = rv[2][e]; }
            }
#undef LD_HROW
            __syncthreads();
            { const int c = tid >> 1, hf = tid & 1;
              bf16_t* d = g.isctx ? (bf16_t*)(ws + WS_VVTC) + ((size_t)g.b * 256 + c) * 256 + g.pos0 + hf * 32
                                  : (bf16_t*)(ws + WS_VVT) + ((size_t)g.b * 256 + c) * 4096 + g.pos0 + hf * 32;
#pragma unroll
              for (int q = 0; q < 4; ++q) *(u32x4*)(d + q * 8) = *(const u32x4*)(vvL + c * 72 + hf * 32 + q * 8); }
            __syncthreads();
        }
    }
    {
        bf16_t* YC = (bf16_t*)(ws + WS_YC);
        const int c8 = tid & 31, ts = tid >> 5;
        const int gi = c8 >> 3, hw = 1 << gi;
        for (int tt = bid; tt < T / 64; tt += G) {
            const TileGeo g = tile_geo(tt);
            const int rlen = g.isctx ? 256 : 64;
            for (int q = 0; q < 4; ++q) {
                const int tl = q * 16 + ts, pos = g.pos0 + tl, rpos = pos % rlen;
                int lo = rpos - hw; lo = lo < 0 ? 0 : lo; int hi = rpos + hw; hi = hi > rlen ? rlen : hi;
                const bf16_t* base = PJ + (size_t)(g.tok0 + tl - rpos) * PJW + 768 + 8 * c8;
                float s[8], self[8];
#pragma unroll
                for (int e = 0; e < 8; ++e) s[e] = 0.f;
                for (int j = lo; j < hi; ++j) { float v[8]; unpack8(*(const u32x4*)(base + (size_t)j * PJW), v);
#pragma unroll
                    for (int e = 0; e < 8; ++e) s[e] += v[e]; }
                unpack8(*(const u32x4*)(base + (size_t)rpos * PJW), self);
                const float inv = 1.f / (float)(hi - lo);
                u32x4 o;
#pragma unroll
                for (int e = 0; e < 4; ++e) o[e] = cvt_pk_bf16(s[2 * e] * inv - self[2 * e], s[2 * e + 1] * inv - self[2 * e + 1]);
                *(u32x4*)(YC + (size_t)(g.tok0 + tl) * YCW + 768 + 8 * c8) = o;
            }
        }
    }
    {
        bf16_t* xsL = (bf16_t*)smem;
        bf16_t* XBN = (bf16_t*)(ws + WS_XBN);
        const int c8 = tid & 127, tq = tid >> 7;
        const float* cw = P.in[I_SCW] + (size_t)l * 3 * 1024; const float* cb = P.in[I_SCB] + (size_t)l * 1024;
        float w[3][8], bb[8];
#pragma unroll
        for (int e = 0; e < 8; ++e) { bb[e] = cb[8 * c8 + e];
#pragma unroll
            for (int k = 0; k < 3; ++k) w[k][e] = cw[k * 1024 + 8 * c8 + e]; }
        for (int tt = bid; tt < T / 64; tt += G) {
            const TileGeo g = tile_geo(tt);
            const int p0 = g.pos0 + tq * 16;
            const bf16_t* rowp = PJ + (size_t)(g.tok0 + tq * 16) * PJW + 1536 + 8 * c8;
            float r0[8], r1[8], r2[8];
#define LD_SROW(dst, dp) do { const int pp = p0 + (dp); if (pp >= 0 && pp < g.slen) unpack8(*(const u32x4*)(rowp + (ptrdiff_t)(dp) * PJW), dst); else { \
                _Pragma("unroll") for (int e = 0; e < 8; ++e) dst[e] = 0.f; } } while (0)
            LD_SROW(r0, -1); LD_SROW(r1, 0);
            for (int j = 0; j < 16; ++j) {
                LD_SROW(r2, j + 1);
                float o[8];
#pragma unroll
                for (int e = 0; e < 8; ++e) { o[e] = fsilu(w[0][e] * r0[e] + w[1][e] * r1[e] + w[2][e] * r2[e] + bb[e]); r0[e] = r1[e]; r1[e] = r2[e]; }
                u32x4 ov;
#pragma unroll
                for (int e = 0; e < 4; ++e) ov[e] = cvt_pk_bf16(o[2 * e], o[2 * e + 1]);
                *(u32x4*)(XBN + (size_t)(g.tok0 + tq * 16 + j) * 1024 + 8 * c8) = ov;
                if (c8 < 96) {
#pragma unroll
                    for (int e = 0; e < 8; ++e) xsL[(8 * c8 + e) * 72 + tq * 16 + j] = (bf16_t)((e & 1) ? (ov[e >> 1] >> 16) : (ov[e >> 1] & 0xffffu)); }
            }
#undef LD_SROW
            __syncthreads();
            for (int ch = tid; ch < 768 * 8; ch += NTH) { const int c = ch >> 3, q = ch & 7;
                bf16_t* d = g.isctx ? (bf16_t*)(ws + WS_XSTC) + ((size_t)g.b * 768 + c) * 256 + g.pos0 + q * 8
                                    : (bf16_t*)(ws + WS_XST) + ((size_t)g.b * 768 + c) * 4096 + g.pos0 + q * 8;
                *(u32x4*)d = *(const u32x4*)(xsL + c * 72 + q * 8); }
            __syncthreads();
        }
        const float* dtr = (const float*)(ws + WS_DTR); float* dt = (float*)(ws + WS_DT);
        for (int e = bid * NTH + tid; e < T * 16; e += G * NTH) dt[e] = fsoftplus(dtr[e] + P.in[I_SDTB][l * 16 + (e & 15)]);
    }
}

#define EPI_ROWS_BEGIN _Pragma("unroll") for (int ai = 0; ai < 2; ++ai) { _Pragma("unroll") for (int m = 0; m < 4; ++m) { const int rl = ai * 128 + wr * 64 + m * 16 + fr;
#define EPI_ROWS_END } }
typedef f32x4 acc_t[2][2][4][2];
__device__ __forceinline__ u32x4 pack8(const f32x4& a, const f32x4& b) { u32x4 o; o[0] = cvt_pk_bf16(a[0], a[1]); o[1] = cvt_pk_bf16(a[2], a[3]); o[2] = cvt_pk_bf16(b[0], b[1]); o[3] = cvt_pk_bf16(b[2], b[3]); return o; }

struct Src1 {
    const char* H; const char* W1T; const char* WFT; int G, c;
    __device__ __forceinline__ bool get(int i, GUnit& u) const {
        const int L = i * G + c; constexpr int NU1 = (T / 256) * (N1 / 256);
        if (L < NU1) { int pm, pn; pg8::remap_tile(L, T / 256, N1 / 256, pm, pn);
            u.a0 = H + (size_t)pm * 256 * 2048; u.a1 = u.a0 + (size_t)128 * 2048; u.b0 = W1T + (size_t)pn * 256 * 2048; u.b1 = u.b0 + (size_t)128 * 2048;
            u.nt = 16; u.pm = pm; u.pn = pn; u.kind = pn < 16 ? 0 : (pn < 26 ? 1 : 2); u.gidx = nullptr; u.e = 0; return true; }
        const int j = L - NU1; if (j >= 2 * (T / 256)) return false;
        const int pm = j & 1, pn = j >> 1;
        u.a0 = WFT + (size_t)pm * 256 * 2048; u.a1 = u.a0 + (size_t)128 * 2048; u.b0 = H + (size_t)pn * 256 * 2048; u.b1 = u.b0 + (size_t)128 * 2048;
        u.nt = 16; u.pm = pm; u.pn = pn; u.kind = 3; u.gidx = nullptr; u.e = 0; return true;
    }
};
struct Epi1 {
    bf16_t* Gt; bf16_t* PJ; float* DTR; bf16_t* VT; bf16_t* VTC;
    __device__ __forceinline__ void operator()(const acc_t& acc, const GUnit& u, int wr, int wc, int fr, int fq) const {
        const int cl = wc * 32 + 8 * fq;
        if (u.kind == 0) {
            EPI_ROWS_BEGIN { bf16_t* rp = Gt + (size_t)(u.pm * 256 + rl) * 4096 + u.pn * 256 + cl;
#pragma unroll
                for (int bj = 0; bj < 2; ++bj) { f32x4 a = acc[ai][bj][m][0], b = acc[ai][bj][m][1];
#pragma unroll
                    for (int e = 0; e < 4; ++e) { a[e] = fsigmoid(a[e]); b[e] = fsigmoid(b[e]); }
                    *(u32x4*)(rp + bj * 128) = pack8(a, b); } } EPI_ROWS_END
        } else if (u.kind == 1) {
            EPI_ROWS_BEGIN { bf16_t* rp = PJ + (size_t)(u.pm * 256 + rl) * PJW + (u.pn - 16) * 256 + cl;
#pragma unroll
                for (int bj = 0; bj < 2; ++bj) *(u32x4*)(rp + bj * 128) = pack8(acc[ai][bj][m][0], acc[ai][bj][m][1]); } EPI_ROWS_END
        } else if (u.kind == 2) {
            if (wc == 0 && fq < 2) {
                EPI_ROWS_BEGIN { float* rp = DTR + (size_t)(u.pm * 256 + rl) * 16 + 8 * fq; *(f32x4*)rp = acc[ai][0][m][0]; *(f32x4*)(rp + 4) = acc[ai][0][m][1]; } EPI_ROWS_END
            }
        } else {
#pragma unroll
            for (int bj = 0; bj < 2; ++bj) {
                const int tok = u.pn * 256 + bj * 128 + cl;
                bf16_t* cb;
                if (tok < TL) { const int b = tok >> 12, p = tok & 4095; cb = VT + ((size_t)b * 256) * 8192 + p; }
                else { const int r = tok - TL, b = r >> 8, q = r & 255; cb = VTC + ((size_t)b * 256) * 8192 + q; }
                const int hoff = tok < TL ? 4096 : 256;
                EPI_ROWS_BEGIN { const int r = u.pm * 256 + rl, g = r >> 7, half = (r >> 6) & 1, cp = r & 63;
                    *(u32x4*)(cb + (size_t)(g * 64 + cp) * 8192 + half * hoff) = pack8(acc[ai][bj][m][0], acc[ai][bj][m][1]); } EPI_ROWS_END
            }
        }
    }
};

struct SrcDft {
    const char* D4C; const char* D4S; const char* D256; const char* VT; const char* VTC; int G, c;
    __device__ __forceinline__ bool get(int i, GUnit& u) const {
        const int L = i * G + c; u.gidx = nullptr; u.e = 0;
        if (L < 256) { const int sc = L >> 7, r = L & 127, pm = r & 15, pn = r >> 4;
            u.a0 = (sc ? D4S : D4C) + (size_t)pm * 256 * 8192; u.a1 = u.a0 + (size_t)128 * 8192;
            u.b0 = VT + (size_t)pn * 256 * 16384 + (size_t)sc * 8192; u.b1 = u.b0 + (size_t)128 * 16384;
            u.nt = 64; u.pm = pm; u.pn = pn; u.kind = sc; return true; }
        if (L < 264) { const int pn = L - 256;
            u.a0 = D256; u.a1 = u.a0 + (size_t)128 * 8192; u.b0 = VTC + (size_t)pn * 256 * 16384; u.b1 = u.b0 + (size_t)128 * 16384;
            u.nt = 8; u.pm = 0; u.pn = pn; u.kind = 2; return true; }
        return false;
    }
};
struct EpiDft {
    bf16_t* YC;
    __device__ __forceinline__ void operator()(const acc_t& acc, const GUnit& u, int wr, int wc, int fr, int fq) const {
        const int cl = wc * 32 + 8 * fq;
        const int tok0 = u.kind == 2 ? TL + u.pn * 256 : u.pn * 4096 + u.pm * 256;
        const int coff = u.kind == 1 ? 256 : 0;
        const float hs = u.kind == 2 ? 0.5f : 1.f;
        EPI_ROWS_BEGIN { bf16_t* rp = YC + (size_t)(tok0 + rl) * YCW + coff + cl;
#pragma unroll
            for (int bj = 0; bj < 2; ++bj) { const u32x4 o = pack8(acc[ai][bj][m][0] * hs, acc[ai][bj][m][1] * hs); *(u32x4*)(rp + bj * 128) = o;
                if (u.kind == 2) *(u32x4*)(rp + 256 + bj * 128) = o; } } EPI_ROWS_END
    }
};

struct SrcBr {
    const char* YC; const char* WBRT; int G, c;
    __device__ __forceinline__ bool get(int i, GUnit& u) const {
        const int k = i & 3, L = (i >> 2) * G + c; if (L >= (T / 256) * 4) return false;
        int pm, pn; pg8::remap_tile(L, T / 256, 4, pm, pn);
        const int koff = k == 0 ? 0 : (k == 1 ? 512 : (k == 2 ? 768 : 1024));
        u.a0 = YC + ((size_t)pm * 256 * YCW + koff) * 2; u.a1 = u.a0 + (size_t)128 * YCW * 2;
        u.b0 = WBRT + ((size_t)pn * 256 * YCW + koff) * 2; u.b1 = u.b0 + (size_t)128 * YCW * 2;
        u.nt = (k == 0 || k == 3) ? 8 : 4; u.pm = pm; u.pn = pn; u.kind = k; u.gidx = nullptr; u.e = 0; return true;
    }
};
struct EpiBr {
    const bf16_t* Gt; bf16_t* MG; const float* SSQ;
    __device__ __forceinline__ void operator()(const acc_t& acc, const GUnit& u, int wr, int wc, int fr, int fq) const {
        const int cl = wc * 32 + 8 * fq, k = u.kind;
        EPI_ROWS_BEGIN { const size_t row = (size_t)u.pm * 256 + rl;
            float rs = 1.f;
            if (k == 3) { const f32x4 s0 = *(const f32x4*)(SSQ + row * 8), s1 = *(const f32x4*)(SSQ + row * 8 + 4);
                rs = rsqrtf((s0[0] + s0[1] + s0[2] + s0[3] + s1[0] + s1[1] + s1[2] + s1[3]) * (1.f / 512.f) + EPSN); }
#pragma unroll
            for (int bj = 0; bj < 2; ++bj) {
                const int col = u.pn * 256 + bj * 128 + cl;
                float gt[8], mg[8]; unpack8(*(const u32x4*)(Gt + row * 4096 + k * 1024 + col), gt);
                bf16_t* mp = MG + row * 1024 + col;
                if (k == 0) {
#pragma unroll
                    for (int e = 0; e < 8; ++e) mg[e] = 0.f;
                } else unpack8(*(const u32x4*)mp, mg);
                f32x4 a = acc[ai][bj][m][0], b = acc[ai][bj][m][1];
#pragma unroll
                for (int e = 0; e < 4; ++e) { a[e] = mg[e] + gt[e] * a[e] * rs; b[e] = mg[4 + e] + gt[4 + e] * b[e] * rs; }
                *(u32x4*)mp = pack8(a, b); } } EPI_ROWS_END
    }
};

struct SrcOut {
    const char* MG; const char* WOUTT; int G, c;
    __device__ __forceinline__ bool get(int i, GUnit& u) const {
        const int L = i * G + c; if (L >= (T / 256) * 4) return false;
        int pm, pn; pg8::remap_tile(L, T / 256, 4, pm, pn);
        u.a0 = MG + (size_t)pm * 256 * 2048; u.a1 = u.a0 + (size_t)128 * 2048; u.b0 = WOUTT + (size_t)pn * 256 * 2048; u.b1 = u.b0 + (size_t)128 * 2048;
        u.nt = 16; u.pm = pm; u.pn = pn; u.kind = 0; u.gidx = nullptr; u.e = 0; return true;
    }
};
struct EpiOut {
    const float* xlat; const float* xctx; float* X1; const float* MODL;
    __device__ __forceinline__ void operator()(const acc_t& acc, const GUnit& u, int wr, int wc, int fr, int fq) const {
        const int cl = wc * 32 + 8 * fq;
        const int mj = u.pm < TL / 256 ? (u.pm >> 4) : 8;
        const float* xs = u.pm < TL / 256 ? xlat + (size_t)u.pm * 256 * 1024 : xctx + (size_t)(u.pm - TL / 256) * 256 * 1024;
        const float* g1 = MODL + (size_t)mj * 6144 + 2048 + u.pn * 256 + cl;
        f32x4 gv[2][2];
#pragma unroll
        for (int bj = 0; bj < 2; ++bj) { gv[bj][0] = *(const f32x4*)(g1 + bj * 128); gv[bj][1] = *(const f32x4*)(g1 + bj * 128 + 4); }
        EPI_ROWS_BEGIN { const float* xr = xs + (size_t)rl * 1024 + u.pn * 256 + cl; float* orow = X1 + ((size_t)u.pm * 256 + rl) * 1024 + u.pn * 256 + cl;
#pragma unroll
            for (int bj = 0; bj < 2; ++bj) {
                const f32x4 x0 = *(const f32x4*)(xr + bj * 128), x1 = *(const f32x4*)(xr + bj * 128 + 4);
                *(f32x4*)(orow + bj * 128) = x0 + gv[bj][0] * acc[ai][bj][m][0]; *(f32x4*)(orow + bj * 128 + 4) = x1 + gv[bj][1] * acc[ai][bj][m][1]; } } EPI_ROWS_END
    }
};

struct SrcUp {
    const char* H2; const char* WUPT; const int* rtok; const int* meta; int G, c;
    __device__ __forceinline__ bool get(int i, GUnit& u) const {
        const int L = i * G + c, nu = meta[33]; if (L >= nu * 8) return false;
        const int ru = L >> 3, j = L & 7; int e = 0;
#pragma unroll
        for (int s = 16; s > 0; s >>= 1) if (meta[e + s] <= ru) e += s;
        u.a0 = H2; u.a1 = H2; u.gidx = rtok + (size_t)ru * 256;
        u.b0 = WUPT + ((size_t)e * 2048 + j * 128) * 2048; u.b1 = u.b0 + (size_t)1024 * 2048;
        u.nt = 16; u.pm = ru; u.pn = j; u.kind = 0; u.e = e; return true;
    }
};
struct EpiUp {
    bf16_t* ACT; const float* BUP;
    __device__ __forceinline__ void operator()(const acc_t& acc, const GUnit& u, int wr, int wc, int fr, int fq) const {
        const int cl = wc * 32 + 8 * fq, col = u.pn * 128 + cl;
        const float* bp = BUP + (size_t)u.e * 2048 + col;
        const f32x4 bg0 = *(const f32x4*)bp, bg1 = *(const f32x4*)(bp + 4), bl0 = *(const f32x4*)(bp + 1024), bl1 = *(const f32x4*)(bp + 1028);
        EPI_ROWS_BEGIN { f32x4 g0 = acc[ai][0][m][0] + bg0, g1 = acc[ai][0][m][1] + bg1, l0 = acc[ai][1][m][0] + bl0, l1 = acc[ai][1][m][1] + bl1;
#pragma unroll
            for (int e = 0; e < 4; ++e) {
                float a = fminf(g0[e], 7.f), b = fminf(fmaxf(l0[e], -7.f), 7.f); g0[e] = a * fsigmoid(1.702f * a) * (b + 1.f);
                a = fminf(g1[e], 7.f); b = fminf(fmaxf(l1[e], -7.f), 7.f); g1[e] = a * fsigmoid(1.702f * a) * (b + 1.f); }
            *(u32x4*)(ACT + ((size_t)u.pm * 256 + rl) * 1024 + col) = pack8(g0, g1); } EPI_ROWS_END
    }
};
struct SrcDn {
    const char* ACT; const char* WDNT; const int* meta; int G, c;
    __device__ __forceinline__ bool get(int i, GUnit& u) const {
        const int L = i * G + c, nu = meta[33]; if (L >= nu * 4) return false;
        const int ru = L >> 2, j = L & 3; int e = 0;
#pragma unroll
        for (int s = 16; s > 0; s >>= 1) if (meta[e + s] <= ru) e += s;
        u.a0 = ACT + (size_t)ru * 256 * 2048; u.a1 = u.a0 + (size_t)128 * 2048;
        u.b0 = WDNT + ((size_t)e * 1024 + j * 256) * 2048; u.b1 = u.b0 + (size_t)128 * 2048;
        u.nt = 16; u.pm = ru; u.pn = j; u.kind = 0; u.e = e; u.gidx = nullptr; return true;
    }
};
struct EpiDn {
    bf16_t* YP; const float* BDN; const int* rpair; const float* rw;
    __device__ __forceinline__ void operator()(const acc_t& acc, const GUnit& u, int wr, int wc, int fr, int fq) const {
        const int cl = wc * 32 + 8 * fq;
        const float* bp = BDN + (size_t)u.e * 1024 + u.pn * 256 + cl;
        f32x4 bv[2][2];
#pragma unroll
        for (int bj = 0; bj < 2; ++bj) { bv[bj][0] = *(const f32x4*)(bp + bj * 128); bv[bj][1] = *(const f32x4*)(bp + bj * 128 + 4); }
        EPI_ROWS_BEGIN { const int prow = u.pm * 256 + rl; const int pair = rpair[prow];
            if (pair >= 0) { const float w = rw[prow]; bf16_t* op = YP + (size_t)pair * 1024 + u.pn * 256 + cl;
#pragma unroll
                for (int bj = 0; bj < 2; ++bj) *(u32x4*)(op + bj * 128) = pack8((acc[ai][bj][m][0] + bv[bj][0]) * w, (acc[ai][bj][m][1] + bv[bj][1]) * w); } } EPI_ROWS_END
    }
};

constexpr int HY_FC = 0, HY_VI = 65536, HY_VRS = 8512, HY_YRS = 4116;
__device__ __forceinline__ void hyena_conv(CParams& P, unsigned char* smem, LAS unsigned char* lds, int l) {
    const int G = gridDim.x, tid = otid(), bid = obid(), lane = tid & 63, wid = __builtin_amdgcn_readfirstlane(tid >> 6);
    unsigned char* ws = P.ws;
    const float* KRAW = (const float*)(ws + WS_KRAW) + (size_t)l * 2 * 4096 * 512;
    const float* KPART = (const float*)(ws + WS_KPART) + (size_t)l * 2 * 64 * 512;
    for (int c = bid; c < 256; c += G) {
        __syncthreads();
        float* red = (float*)(smem + 140000);
        if (tid < 64) { float s = KPART[(size_t)tid * 512 + c] + KPART[(size_t)tid * 512 + 256 + c]; s = wave_sum(s); if (tid == 0) red[0] = 1.f / s; }
        __syncthreads();
        const float inv = red[0];
        bf16_t* fc = (bf16_t*)(smem + HY_FC);
        for (int idx = tid; idx < 8192; idx += NTH) { const int lag = 4096 - idx; float v;
            if (lag >= 4096) v = 0.f; else if (lag >= 0) v = KRAW[(size_t)lag * 512 + c] * inv; else v = KRAW[(size_t)(-lag) * 512 + 256 + c] * inv;
            fc[idx] = f2bf(v); }
        {
            const bf16_t* vsrc = (const bf16_t*)(ws + WS_VVT) + (size_t)c * 4096;
#pragma unroll 4
            for (int q = 0; q < 8; ++q) { const int ch = tid + q * NTH, b = ch >> 9, s = (ch & 511) * 8;
                *(u32x4*)(smem + HY_VI + b * HY_VRS + s * 2 + 16 * (s >> 8)) = *(const u32x4*)(vsrc + (size_t)b * 256 * 4096 + s); }
        }
        __syncthreads();
        for (int e = tid; e < 3 * 8192; e += NTH) { const int q = 1 + e / 8192, idx = e & 8191; fc[q * 8192 + idx] = idx >= q ? fc[idx - q] : (bf16_t)0; }
        __syncthreads();
        {
            const int t0 = wid, q = t0 & 3, a = t0 >> 2, rho = lane & 31, h = lane >> 5, col = lane & 31, b = col >> 2, i = col & 3;
            f32x16 acc[4];
#pragma unroll
            for (int ct = 0; ct < 4; ++ct)
#pragma unroll
                for (int e = 0; e < 16; ++e) acc[ct][e] = 0.f;
            const LAS unsigned char* fq_ = lds + HY_FC + q * 16384;
            const LAS unsigned char* vi = lds + HY_VI + b * HY_VRS;
            const int ebase = 4096 - 8 * (rho - h) - 4 * a;
#pragma unroll 1
            for (int dl = -4080; dl <= 3840; dl += 16) {
                const int e = ebase - dl;
                const bf16x4 alo = *(const LAS bf16x4*)(fq_ + 2 * e), ahi = *(const LAS bf16x4*)(fq_ + 2 * e + 8);
                const bf16x8 af = __builtin_shufflevector(alo, ahi, 0, 1, 2, 3, 4, 5, 6, 7);
#pragma unroll
                for (int ct = 0; ct < 4; ++ct) {
                    if (dl >= 1024 * ct - 4080 && dl <= 1024 * ct + 768) {
                        const int s = 1024 * ct + 256 * i - dl + 8 * h; const bool ok = (unsigned)s < 4096u; const int sc = ok ? s : 0;
                        bf16x8 bf = *(const LAS bf16x8*)(vi + sc * 2 + 16 * (sc >> 8));
                        if (!ok) bf = (bf16x8){0, 0, 0, 0, 0, 0, 0, 0};
                        acc[ct] = __builtin_amdgcn_mfma_f32_32x32x16_bf16(af, bf, acc[ct], 0, 0, 0);
                    }
                }
            }
            __syncthreads();
            float* Y = (float*)smem;
#pragma unroll
            for (int ct = 0; ct < 4; ++ct)
#pragma unroll
                for (int r = 0; r < 16; ++r) { const int rr = (r & 3) + 8 * (r >> 2) + 4 * h; const int t = 1024 * ct + 256 * i + t0 + 8 * rr;
                    Y[b * HY_YRS + t + (t >> 8)] = acc[ct][r]; }
        }
        __syncthreads();
        {
            const float* Y = (const float*)smem; float* dst = (float*)(ws + WS_CVT) + (size_t)c * 4096; const int tid2 = otid();
#pragma unroll 2
            for (int q = 0; q < 16; ++q) { const int ch = tid2 + q * NTH, b = ch >> 10, t = (ch & 1023) * 4; const float* yp = Y + b * HY_YRS + t + (t >> 8);
                *(f32x4*)(dst + (size_t)b * 256 * 4096 + t) = (f32x4){yp[0], yp[1], yp[2], yp[3]}; }
        }
        __syncthreads();
        {
            float* fl = (float*)smem;
            float* vc = fl + 512;
            const float* KR1 = KRAW + (size_t)4096 * 512; const float* KP1 = KPART + (size_t)64 * 512;
            if (tid < 64) { float s = tid < 4 ? KP1[(size_t)tid * 512 + c] + KP1[(size_t)tid * 512 + 256 + c] : 0.f; s = wave_sum(s); if (tid == 0) red[0] = 1.f / s; }
            __syncthreads();
            const float inv1 = red[0];
            { const int lag = tid - 256; float v; if (lag <= -256) v = 0.f; else if (lag >= 0) v = KR1[(size_t)lag * 512 + c] * inv1; else v = KR1[(size_t)(-lag) * 512 + 256 + c] * inv1; fl[tid] = v; }
            for (int e = tid; e < 2048; e += NTH) { const int b = e >> 8, s = e & 255; vc[e] = bf2f(((const bf16_t*)(ws + WS_VVTC))[((size_t)b * 256 + c) * 256 + s]); }
            __syncthreads();
            const int b = tid >> 6, tb = (tid & 63) * 4; float o[4] = {0.f, 0.f, 0.f, 0.f};
            for (int s = 0; s < 256; ++s) { const float v = vc[b * 256 + s];
#pragma unroll
                for (int j = 0; j < 4; ++j) o[j] += fl[tb + j - s + 256] * v; }
            *(f32x4*)((float*)(ws + WS_CVTC) + ((size_t)b * 256 + c) * 256 + tb) = (f32x4){o[0], o[1], o[2], o[3]};
        }
    }
    __syncthreads();
}

__device__ __forceinline__ void hyena_finish(CParams& P, unsigned char* smem, int l) {
    const int G = gridDim.x, tid = otid(), bid = obid();
    unsigned char* ws = P.ws;
    const bf16_t* PJ = (const bf16_t*)(ws + WS_PJ); bf16_t* YC = (bf16_t*)(ws + WS_YC);
    float* cvL = (float*)smem;
    const int c4 = tid & 63, tq = tid >> 6;
    const float* cw = P.in[I_HCW] + (size_t)l * 3 * 768; const float* cb = P.in[I_HCB] + (size_t)l * 768;
    float w1[3][4], wx[3][4], wv[3][4], b1[4], bx[4], bv[4], hb[4];
#pragma unroll
    for (int e = 0; e < 4; ++e) { b1[e] = cb[4 * c4 + e]; bx[e] = cb[256 + 4 * c4 + e]; bv[e] = cb[512 + 4 * c4 + e]; hb[e] = P.in[I_HBIAS][l * 256 + 4 * c4 + e];
#pragma unroll
        for (int k = 0; k < 3; ++k) { w1[k][e] = cw[k * 768 + 4 * c4 + e]; wx[k][e] = cw[k * 768 + 256 + 4 * c4 + e]; wv[k][e] = cw[k * 768 + 512 + 4 * c4 + e]; } }
    for (int tt = bid; tt < T / 64; tt += G) {
        const TileGeo g = tile_geo(tt);
        __syncthreads();
        { const float* src = g.isctx ? (const float*)(ws + WS_CVTC) + (size_t)g.b * 256 * 256 + g.pos0 : (const float*)(ws + WS_CVT) + (size_t)g.b * 256 * 4096 + g.pos0;
          const size_t rs = g.isctx ? 256 : 4096;
#pragma unroll
          for (int q = 0; q < 8; ++q) { const int ch = tid + q * NTH, c = ch >> 4, j = (ch & 15) * 4; const f32x4 v = *(const f32x4*)(src + (size_t)c * rs + j);
              float* d = cvL + c * 68 + j; d[0] = v[0]; d[1] = v[1]; d[2] = v[2]; d[3] = v[3]; } }
        __syncthreads();
        const int p0 = g.pos0 + tq * 8;
        const bf16_t* rowp = PJ + (size_t)(g.tok0 + tq * 8) * PJW;
        float r1[3][4], rx[3][4], rv[3][4];
#define LD_FROW(k, dp) do { const int pp = p0 + (dp); if (pp >= 0 && pp < g.slen) { const bf16_t* rp = rowp + (ptrdiff_t)(dp) * PJW; \
            unpack4(*(const u32x2*)(rp + 4 * c4), r1[k]); unpack4(*(const u32x2*)(rp + 256 + 4 * c4), rx[k]); unpack4(*(const u32x2*)(rp + 512 + 4 * c4), rv[k]); } else { \
            _Pragma("unroll") for (int e = 0; e < 4; ++e) { r1[k][e] = 0.f; rx[k][e] = 0.f; rv[k][e] = 0.f; } } } while (0)
        LD_FROW(0, -1); LD_FROW(1, 0);
#pragma unroll
        for (int j = 0; j < 8; ++j) {
            LD_FROW(2, j + 1);
            float o[4];
#pragma unroll
            for (int e = 0; e < 4; ++e) {
                const float x1 = w1[0][e] * r1[0][e] + w1[1][e] * r1[1][e] + w1[2][e] * r1[2][e] + b1[e];
                const float x2 = wx[0][e] * rx[0][e] + wx[1][e] * rx[1][e] + wx[2][e] * rx[2][e] + bx[e];
                const float vv = wv[0][e] * rv[0][e] + wv[1][e] * rv[1][e] + wv[2][e] * rv[2][e] + bv[e];
                const float xv = x2 * vv;
                o[e] = x1 * (cvL[(4 * c4 + e) * 68 + tq * 8 + j] + xv * hb[e]);
                r1[0][e] = r1[1][e]; r1[1][e] = r1[2][e]; rx[0][e] = rx[1][e]; rx[1][e] = rx[2][e]; rv[0][e] = rv[1][e]; rv[1][e] = rv[2][e]; }
            u32x2 ov; ov[0] = cvt_pk_bf16(o[0], o[1]); ov[1] = cvt_pk_bf16(o[2], o[3]);
            *(u32x2*)(YC + (size_t)(g.tok0 + tq * 8 + j) * YCW + 512 + 4 * c4) = ov;
        }
#undef LD_FROW
    }
    __syncthreads();
}

constexpr int SS_LD = 136;
__device__ __forceinline__ int ssd_tokbase(int b, int cc) { return cc < 2 ? TL + b * 256 + cc * 128 : b * 4096 + (cc - 2) * 128; }
__device__ __forceinline__ const bf16_t* ssd_trow(const unsigned char* ws, int b, int cc, int row) {
    return cc < 2 ? (const bf16_t*)(ws + WS_XSTC) + ((size_t)b * 768 + row) * 256 + cc * 128 : (const bf16_t*)(ws + WS_XST) + ((size_t)b * 768 + row) * 4096 + (cc - 2) * 128;
}
__device__ __forceinline__ void ssd_dt_arrays(CParams& P, float* sm, int l, int b, int g, int cc) {
    const int tid = otid(); const float* DT = (const float*)(P.ws + WS_DT); const int tb = ssd_tokbase(b, cc);
    for (int e = tid; e < 1024; e += NTH) { const int dir = e >> 9, i = (e >> 2) & 127, r = e & 3; sm[dir * 512 + i * 4 + r] = DT[(size_t)(tb + i) * 16 + dir * 8 + g * 4 + r]; }
    __syncthreads();
    if (tid < 8) { const int dir = tid >> 2, r = tid & 3; const float a = -expf(P.in[I_SALOG][l * 16 + dir * 8 + g * 4 + r]);
        float s = 0.f;
        if (dir == 0) { for (int i = 0; i < 128; ++i) { s += sm[i * 4 + r] * a; sm[1024 + i * 4 + r] = s; } }
        else { for (int i = 127; i >= 0; --i) { s += sm[512 + i * 4 + r] * a; sm[1536 + i * 4 + r] = s; } } }
    __syncthreads();
}
#define SS_FRAG(base, row, k0) (*(const LAS bf16x8*)((base) + ((row) * SS_LD + (k0) + 8 * fq) * 2))

__device__ __forceinline__ void ssd_phase_a(CParams& P, unsigned char* smem, LAS unsigned char* lds, int l) {
    const int G = gridDim.x, tid = otid(), bid = obid(), lane = tid & 63, w = __builtin_amdgcn_readfirstlane(tid >> 6), fr = lane & 15, fq = lane >> 4;
    unsigned char* ws = P.ws;
    constexpr int R0 = 0, R1 = 34816, R2 = 69632, R3 = 87040, RS = 104448;
    float* sm = (float*)(smem + RS); float* dtf = sm; float* dtb = sm + 512; float* acf = sm + 1024; float* acb = sm + 1536;
    const bf16_t* XBN = (const bf16_t*)(ws + WS_XBN);
    for (int un = bid; un < NB * 2 * NCH; un += G) {
        const int b = un / (2 * NCH), g = (un / NCH) & 1, cc = un % NCH, tb = ssd_tokbase(b, cc);
        __syncthreads();
        ssd_dt_arrays(P, sm, l, b, g, cc);
#pragma unroll
        for (int q = 0; q < 4; ++q) { const int ch = tid + q * NTH, row = ch >> 4, k8 = (ch & 15) * 8;
            *(u32x4*)(smem + R0 + (row * SS_LD + k8) * 2) = *(const u32x4*)(XBN + (size_t)(tb + row) * 1024 + 768 + g * 128 + k8);
            *(u32x4*)(smem + R1 + (row * SS_LD + k8) * 2) = *(const u32x4*)(XBN + (size_t)(tb + row) * 1024 + 512 + g * 128 + k8); }
        __syncthreads();
        f32x4 S[8];
#pragma unroll
        for (int nt = 0; nt < 8; ++nt) S[nt] = (f32x4){0.f, 0.f, 0.f, 0.f};
#pragma unroll
        for (int k0 = 0; k0 < 128; k0 += 32) { const bf16x8 af = SS_FRAG(lds + R0, 16 * w + fr, k0);
#pragma unroll
            for (int nt = 0; nt < 8; ++nt) S[nt] = __builtin_amdgcn_mfma_f32_16x16x32_bf16(SS_FRAG(lds + R1, 16 * nt + fr, k0), af, S[nt], 0, 0, 0); }
        __syncthreads();
#pragma unroll
        for (int q = 0; q < 4; ++q) { const int ch = tid + q * NTH, row = ch >> 4, k8 = (ch & 15) * 8;
            *(u32x4*)(smem + R1 + (row * SS_LD + k8) * 2) = *(const u32x4*)(ssd_trow(ws, b, cc, 512 + g * 128 + row) + k8); }
        for (int r = 0; r < 4; ++r) {
#pragma unroll
            for (int q = 0; q < 2; ++q) { const int ch = tid + q * NTH, row = ch >> 4, k8 = (ch & 15) * 8;
                *(u32x4*)(smem + R2 + (row * SS_LD + k8) * 2) = *(const u32x4*)(ssd_trow(ws, b, cc, g * 256 + r * 64 + row) + k8); }
            { const int i = 16 * w + fr; const float afi = acf[i * 4 + r], abi = acb[i * 4 + r];
#pragma unroll
              for (int nt = 0; nt < 8; ++nt) { float o[4];
#pragma unroll
                  for (int e = 0; e < 4; ++e) { const int j = 16 * nt + 4 * fq + e;
                      const float f = (j <= i) ? __expf(afi - acf[j * 4 + r]) * dtf[j * 4 + r] : 0.f;
                      const float bw = (j >= i) ? __expf(abi - acb[j * 4 + r]) * dtb[j * 4 + r] : 0.f;
                      o[e] = S[nt][e] * (f + bw); }
                  u32x2 ov; ov[0] = cvt_pk_bf16(o[0], o[1]); ov[1] = cvt_pk_bf16(o[2], o[3]);
                  *(u32x2*)(smem + R0 + (i * SS_LD + 16 * nt + 4 * fq) * 2) = ov; } }
            __syncthreads();
            { const int p = tid >> 3, j0 = (tid & 7) * 16; const float al = acf[127 * 4 + r];
#pragma unroll
              for (int h2 = 0; h2 < 2; ++h2) { float v[8]; unpack8(*(const u32x4*)(smem + R2 + (p * SS_LD + j0 + 8 * h2) * 2), v); u32x4 ov;
#pragma unroll
                  for (int e = 0; e < 8; ++e) { const int j = j0 + 8 * h2 + e; v[e] *= dtf[j * 4 + r] * __expf(al - acf[j * 4 + r]); }
#pragma unroll
                  for (int e = 0; e < 4; ++e) ov[e] = cvt_pk_bf16(v[2 * e], v[2 * e + 1]);
                  *(u32x4*)(smem + R3 + (p * SS_LD + j0 + 8 * h2) * 2) = ov; } }
            { f32x4 yd[4];
#pragma unroll
              for (int nt = 0; nt < 4; ++nt) yd[nt] = (f32x4){0.f, 0.f, 0.f, 0.f};
#pragma unroll
              for (int k0 = 0; k0 < 128; k0 += 32) { const bf16x8 af = SS_FRAG(lds + R0, 16 * w + fr, k0);
#pragma unroll
                  for (int nt = 0; nt < 4; ++nt) yd[nt] = __builtin_amdgcn_mfma_f32_16x16x32_bf16(SS_FRAG(lds + R2, 16 * nt + fr, k0), af, yd[nt], 0, 0, 0); }
              float* yp = (float*)(ws + WS_YD) + (size_t)(tb + 16 * w + fr) * 512 + g * 256 + r * 64 + 4 * fq;
#pragma unroll
              for (int nt = 0; nt < 4; ++nt) *(f32x4*)(yp + 16 * nt) = yd[nt]; }
            __syncthreads();
#pragma unroll
            for (int dir = 0; dir < 2; ++dir) {
                if (dir == 1) {
                    const int p = tid >> 3, j0 = (tid & 7) * 16; const float al = acb[r];
#pragma unroll
                    for (int h2 = 0; h2 < 2; ++h2) { float v[8]; unpack8(*(const u32x4*)(smem + R2 + (p * SS_LD + j0 + 8 * h2) * 2), v); u32x4 ov;
#pragma unroll
                        for (int e = 0; e < 8; ++e) { const int j = j0 + 8 * h2 + e; v[e] *= dtb[j * 4 + r] * __expf(al - acb[j * 4 + r]); }
#pragma unroll
                        for (int e = 0; e < 4; ++e) ov[e] = cvt_pk_bf16(v[2 * e], v[2 * e + 1]);
                        *(u32x4*)(smem + R3 + (p * SS_LD + j0 + 8 * h2) * 2) = ov; }
                    __syncthreads();
                }
                const int pt = w & 3, nt0 = (w >> 2) * 4;
                f32x4 st[4];
#pragma unroll
                for (int q = 0; q < 4; ++q) st[q] = (f32x4){0.f, 0.f, 0.f, 0.f};
#pragma unroll
                for (int k0 = 0; k0 < 128; k0 += 32) { const bf16x8 af = SS_FRAG(lds + R3, 16 * pt + fr, k0);
#pragma unroll
                    for (int q = 0; q < 4; ++q) st[q] = __builtin_amdgcn_mfma_f32_16x16x32_bf16(SS_FRAG(lds + R1, 16 * (nt0 + q) + fr, k0), af, st[q], 0, 0, 0); }
                float* sp = (float*)(ws + WS_ST) + ((((size_t)(b * 2 + g) * 4 + r) * 2 + dir) * NCH + cc) * 8192 + (16 * pt + fr) * 128 + 4 * fq;
#pragma unroll
                for (int q = 0; q < 4; ++q) *(f32x4*)(sp + 16 * (nt0 + q)) = st[q];
                __syncthreads();
            }
        }
        if (tid < 8) { const int dir = tid >> 2, r = tid & 3; ((float*)(ws + WS_ACT))[(((size_t)(b * 2 + g) * 4 + r) * 2 + dir) * NCH + cc] = dir ? acb[r] : acf[127 * 4 + r]; }
    }
    __syncthreads();
}

__device__ __forceinline__ void ssd_phase_b(CParams& P) {
    unsigned char* ws = P.ws;
    const float* ST = (const float*)(ws + WS_ST); const float* ACTS = (const float*)(ws + WS_ACT); bf16_t* HENT = (bf16_t*)(ws + WS_HENT);
    for (int it = obid() * NTH + otid(); it < NB * 2 * 4 * 2 * 2048; it += gridDim.x * NTH) {
        const int hd = it >> 11, e4 = (it & 2047) * 4, dir = hd & 1;
        f32x4 h = (f32x4){0.f, 0.f, 0.f, 0.f};
#pragma unroll 2
        for (int s = 0; s < NCH; ++s) { const int cc = dir == 0 ? s : (s < 2 ? 1 - s : NCH + 1 - s);
            const size_t o = ((size_t)hd * NCH + cc) * 8192 + e4;
            u32x2 ov; ov[0] = cvt_pk_bf16(h[0], h[1]); ov[1] = cvt_pk_bf16(h[2], h[3]); *(u32x2*)(HENT + o) = ov;
            const float d = __expf(ACTS[(size_t)hd * NCH + cc]); const f32x4 sv = *(const f32x4*)(ST + o);
            h = h * d + sv; }
    }
}

__device__ __forceinline__ void ssd_phase_c(CParams& P, unsigned char* smem, LAS unsigned char* lds, int l) {
    const int G = gridDim.x, tid = otid(), bid = obid(), lane = tid & 63, w = __builtin_amdgcn_readfirstlane(tid >> 6), fr = lane & 15, fq = lane >> 4;
    unsigned char* ws = P.ws;
    constexpr int R0 = 0, R1 = 34816, R2 = 52224, RS = 69632;
    float* sm = (float*)(smem + RS); float* acf = sm + 1024; float* acb = sm + 1536;
    const bf16_t* XBN = (const bf16_t*)(ws + WS_XBN); const bf16_t* PJ = (const bf16_t*)(ws + WS_PJ); const bf16_t* HENT = (const bf16_t*)(ws + WS_HENT);
    bf16_t* YC = (bf16_t*)(ws + WS_YC); const float* YD = (const float*)(ws + WS_YD); float* SSQ = (float*)(ws + WS_SSQ);
    for (int un = bid; un < NB * 2 * NCH; un += G) {
        const int b = un / (2 * NCH), g = (un / NCH) & 1, cc = un % NCH, tb = ssd_tokbase(b, cc);
        __syncthreads();
        ssd_dt_arrays(P, sm, l, b, g, cc);
#pragma unroll
        for (int q = 0; q < 4; ++q) { const int ch = tid + q * NTH, row = ch >> 4, k8 = (ch & 15) * 8;
            *(u32x4*)(smem + R0 + (row * SS_LD + k8) * 2) = *(const u32x4*)(XBN + (size_t)(tb + row) * 1024 + 768 + g * 128 + k8); }
        for (int r = 0; r < 4; ++r) {
            __syncthreads();
#pragma unroll
            for (int q = 0; q < 4; ++q) { const int ch = tid + q * NTH, dir = ch >> 10, row = (ch >> 4) & 63, k8 = (ch & 15) * 8;
                *(u32x4*)(smem + (dir ? R2 : R1) + (row * SS_LD + k8) * 2) = *(const u32x4*)(HENT + ((((size_t)(b * 2 + g) * 4 + r) * 2 + dir) * NCH + cc) * 8192 + row * 128 + k8); }
            __syncthreads();
            f32x4 yf[4], yb[4];
#pragma unroll
            for (int nt = 0; nt < 4; ++nt) { yf[nt] = (f32x4){0.f, 0.f, 0.f, 0.f}; yb[nt] = (f32x4){0.f, 0.f, 0.f, 0.f}; }
#pragma unroll
            for (int k0 = 0; k0 < 128; k0 += 32) { const bf16x8 af = SS_FRAG(lds + R0, 16 * w + fr, k0);
#pragma unroll
                for (int nt = 0; nt < 4; ++nt) { yf[nt] = __builtin_amdgcn_mfma_f32_16x16x32_bf16(SS_FRAG(lds + R1, 16 * nt + fr, k0), af, yf[nt], 0, 0, 0);
                                                 yb[nt] = __builtin_amdgcn_mfma_f32_16x16x32_bf16(SS_FRAG(lds + R2, 16 * nt + fr, k0), af, yb[nt], 0, 0, 0); } }
            const int i = 16 * w + fr; const size_t tok = (size_t)tb + i; const int hc = g * 256 + r * 64 + 4 * fq;
            const float ef = __expf(acf[i * 4 + r]), eb = __expf(acb[i * 4 + r]), dsk = P.in[I_SD][l * 8 + g * 4 + r];
            float ssq = 0.f;
#pragma unroll
            for (int nt = 0; nt < 4; ++nt) {
                const f32x4 yd = *(const f32x4*)(YD + tok * 512 + hc + 16 * nt);
                float xv[4], zv[4]; unpack4(*(const u32x2*)(XBN + tok * 1024 + hc + 16 * nt), xv); unpack4(*(const u32x2*)(PJ + tok * PJW + 1024 + hc + 16 * nt), zv);
                float o[4];
#pragma unroll
                for (int e = 0; e < 4; ++e) { o[e] = (yd[e] + ef * yf[nt][e] + eb * yb[nt][e] + xv[e] * dsk) * fsilu(zv[e]); ssq += o[e] * o[e]; }
                u32x2 ov; ov[0] = cvt_pk_bf16(o[0], o[1]); ov[1] = cvt_pk_bf16(o[2], o[3]);
                *(u32x2*)(YC + tok * YCW + 1024 + hc + 16 * nt) = ov; }
            ssq += swz_xor<16>(ssq); ssq = xor32_sum(ssq);
            if (fq == 0) SSQ[tok * 8 + g * 4 + r] = ssq;
        }
    }
    __syncthreads();
}

__device__ __forceinline__ void p7a_route(CParams& P, unsigned char* smem, int l) {
    const int G = gridDim.x, tid = otid(), bid = obid(), lane = tid & 63, w = tid >> 6;
    unsigned char* ws = P.ws;
    float* h2t = (float*)smem;
    float* part = h2t + 8192;
    float* lg = part + 4096;
    int* hist = (int*)(lg + 256);
    const float* X1 = (const float*)(ws + WS_X1); bf16_t* H2 = (bf16_t*)(ws + WS_H2);
    const float* MODL = (const float*)(ws + WS_MOD) + (size_t)l * 9 * 6144;
    const float* nf = P.in[I_NFFN] + (size_t)l * 1024;
    const int e_ = tid & 31, kq = tid >> 5;
    float wreg[64];
    { const float* rw = P.in[I_RW] + (size_t)l * 1024 * 32 + (size_t)kq * 64 * 32 + e_;
#pragma unroll
      for (int k = 0; k < 64; ++k) wreg[k] = rw[k * 32]; }
    if (tid < 32) hist[tid] = 0;
    const int nit = (T / 8 + G - 1) / G;
    for (int it = 0; it < nit; ++it) {
        const int t0 = (it * G + bid) * 8;
        __syncthreads();
        if (t0 < T) {
            const int t = t0 + w; const float* src = X1 + (size_t)t * 1024; const float* md = MODL + (size_t)tok_modj(t) * 6144;
            f32x4 v[4]; float ss = 0.f;
#pragma unroll
            for (int q = 0; q < 4; ++q) { v[q] = *(const f32x4*)(src + q * 256 + lane * 4); ss += v[q][0] * v[q][0] + v[q][1] * v[q][1] + v[q][2] * v[q][2] + v[q][3] * v[q][3]; }
            ss = wave_sum(ss); const float rs = rsqrtf(ss * (1.f / 1024.f) + EPSN);
#pragma unroll
            for (int q = 0; q < 4; ++q) { const int c = q * 256 + lane * 4;
                const f32x4 g = *(const f32x4*)(nf + c), a = *(const f32x4*)(md + 4096 + c), b = *(const f32x4*)(md + 3072 + c);
                f32x4 o;
#pragma unroll
                for (int e = 0; e < 4; ++e) o[e] = v[q][e] * rs * g[e] * (1.f + a[e]) + b[e];
                u32x2 ov; ov[0] = cvt_pk_bf16(o[0], o[1]); ov[1] = cvt_pk_bf16(o[2], o[3]);
                *(u32x2*)(H2 + (size_t)t * 1024 + c) = ov;
                *(f32x4*)(h2t + w * 1024 + c) = o; }
        }
        __syncthreads();
        if (t0 < T) {
#pragma unroll
            for (int tk = 0; tk < 8; ++tk) { float s = 0.f; const float* hp = h2t + tk * 1024 + kq * 64;
#pragma unroll
                for (int k4 = 0; k4 < 16; ++k4) { const f32x4 hv = *(const f32x4*)(hp + k4 * 4);
                    s += hv[0] * wreg[k4 * 4] + hv[1] * wreg[k4 * 4 + 1] + hv[2] * wreg[k4 * 4 + 2] + hv[3] * wreg[k4 * 4 + 3]; }
                part[(tk * 16 + kq) * 32 + e_] = s; }
        }
        __syncthreads();
        if (t0 < T && tid < 256) { const int tk = tid >> 5, e = tid & 31; float s = P.in[I_RB][l * 32 + e];
#pragma unroll
            for (int q = 0; q < 16; ++q) s += part[(tk * 16 + q) * 32 + e];
            lg[tk * 32 + e] = s; }
        __syncthreads();
        if (t0 < T && tid < 8) {
            const int t = t0 + tid; float v[4]; int ix[4]; unsigned used = 0u;
#pragma unroll
            for (int k = 0; k < 4; ++k) { float best = -3.0e38f; int bi = 0;
                for (int e = 0; e < 32; ++e) { const float x = lg[tid * 32 + e]; if (!((used >> e) & 1u) && x > best) { best = x; bi = e; } }
                used |= 1u << bi; v[k] = best; ix[k] = bi; }
            float ex[4], sum = 0.f;
#pragma unroll
            for (int k = 0; k < 4; ++k) { ex[k] = expf(v[k] - v[0]); sum += ex[k]; }
            const float inv = 1.f / sum;
#pragma unroll
            for (int k = 0; k < 4; ++k) { ((int*)(ws + WS_TKE))[(size_t)t * 4 + k] = ix[k]; ((float*)(ws + WS_TKW))[(size_t)t * 4 + k] = ex[k] * inv; atomicAdd(&hist[ix[k]], 1); }
        }
    }
    __syncthreads();
    if (tid < 32) ((int*)(ws + WS_BCNT))[bid * 32 + tid] = hist[tid];
}
__device__ __forceinline__ void p7b_scatter(CParams& P, unsigned char* smem) {
    const int G = gridDim.x, tid = otid(), bid = obid();
    unsigned char* ws = P.ws;
    int* cur = (int*)smem; int* tot = cur + 32; int* rst = tot + 32; int* ust = rst + 32;
    const int* BC = (const int*)(ws + WS_BCNT);
    __syncthreads();
    if (tid < 32) { int before = 0, total = 0; for (int b = 0; b < G; ++b) { const int c = BC[b * 32 + tid]; total += c; before += (b < bid) ? c : 0; } tot[tid] = total; cur[tid] = before; }
    __syncthreads();
    if (tid == 0) { int u = 0; for (int e = 0; e < 32; ++e) { ust[e] = u; rst[e] = u * 256; u += (tot[e] + 255) >> 8; } ust[32] = u; }
    __syncthreads();
    if (tid < 32) cur[tid] += rst[tid];
    if (bid == 0 && tid < 33) ((int*)(ws + WS_META))[tid] = ust[tid];
    if (bid == 0 && tid == 33) ((int*)(ws + WS_META))[33] = ust[32];
    __syncthreads();
    int* RTOK = (int*)(ws + WS_RTOK); int* RPAIR = (int*)(ws + WS_RPAIR); float* RW = (float*)(ws + WS_RW);
    const int nit = (T / 8 + G - 1) / G;
    for (int pi = tid; pi < nit * 32; pi += NTH) {
        const int it = pi >> 5, wq = (pi >> 2) & 7, k = pi & 3, t = (it * G + bid) * 8 + wq;
        if (t < T) { const int e = ((const int*)(ws + WS_TKE))[(size_t)t * 4 + k]; const int pos = atomicAdd(&cur[e], 1);
            RTOK[pos] = t; RPAIR[pos] = t * 4 + k; RW[pos] = ((const float*)(ws + WS_TKW))[(size_t)t * 4 + k]; }
    }
    for (int e = bid; e < 32; e += G) { const int lo = rst[e] + tot[e], hi = rst[e] + (((tot[e] + 255) >> 8) << 8);
        for (int r = lo + tid; r < hi; r += NTH) { RTOK[r] = 0; RPAIR[r] = -1; RW[r] = 0.f; } }
    __syncthreads();
}

__device__ __forceinline__ void p10_combine(CParams& P, int l) {
    const int tid_ = otid(), lane = tid_ & 63, w = (obid() * NTH + tid_) >> 6, nw = gridDim.x * (NTH / 64);
    unsigned char* ws = P.ws;
    const float* X1 = (const float*)(ws + WS_X1); const bf16_t* YP = (const bf16_t*)(ws + WS_YP);
    const float* MODL = (const float*)(ws + WS_MOD) + (size_t)l * 9 * 6144;
    for (int t = w; t < T; t += nw) {
        if (l == NL - 1 && t >= TL) continue;
        const float* md = MODL + (size_t)tok_modj(t) * 6144;
        f32x4 v[4];
#pragma unroll
        for (int q = 0; q < 4; ++q) { const int c = q * 256 + lane * 4;
            f32x4 s = (f32x4){0.f, 0.f, 0.f, 0.f};
#pragma unroll
            for (int k = 0; k < 4; ++k) { float y[4]; unpack4(*(const u32x2*)(YP + ((size_t)t * 4 + k) * 1024 + c), y); s[0] += y[0]; s[1] += y[1]; s[2] += y[2]; s[3] += y[3]; }
            v[q] = *(const f32x4*)(X1 + (size_t)t * 1024 + c) + *(const f32x4*)(md + 5120 + c) * s; }
        if (l < NL - 1) {
#pragma unroll
            for (int q = 0; q < 4; ++q) *(f32x4*)((float*)(ws + WS_XC) + (size_t)t * 1024 + q * 256 + lane * 4) = v[q];
            const float* mdn = MODL + (size_t)9 * 6144 + (size_t)tok_modj(t) * 6144;
            norm_row_store(v, P.in[I_NMIX] + (size_t)(l + 1) * 1024, mdn + 1024, mdn, (bf16_t*)(ws + WS_H) + (size_t)t * 1024, lane);
        } else {
            float ss = 0.f;
#pragma unroll
            for (int q = 0; q < 4; ++q) ss += v[q][0] * v[q][0] + v[q][1] * v[q][1] + v[q][2] * v[q][2] + v[q][3] * v[q][3];
            ss = wave_sum(ss); const float rs = rsqrtf(ss * (1.f / 1024.f) + EPSN);
#pragma unroll
            for (int q = 0; q < 4; ++q) { const int c = q * 256 + lane * 4; const f32x4 g = *(const f32x4*)(P.in[I_NFIN] + c);
                *(f32x4*)(P.out + (size_t)t * 1024 + c) = v[q] * rs * g; }
        }
    }
}


#ifndef PROBE_ID
#define PROBE_ID 0
#endif
template <class Tsrc> __device__ __forceinline__ void probe_dump(const Tsrc* src, size_t n, float* out) {
    const size_t nout = (size_t)TL * 1024; const size_t gth = (size_t)blockIdx.x * NTH + threadIdx.x, nth = (size_t)gridDim.x * NTH;
    for (size_t i = gth; i < nout; i += nth) { float v;
        if constexpr (sizeof(Tsrc) == 2) v = bf2f(((const bf16_t*)src)[i % n]); else v = (float)src[i % n];
        out[i] = v; }
}
#define PROBE_AT(id, type, off, n) do { if (PROBE_ID == (id) && l == 0) { GRID_BAR(); probe_dump((const type*)(WSP + (off)), (size_t)(n), kparams()->out); return; } } while (0)

template <class Tsrc> __device__ __forceinline__ void probe_max(const Tsrc* src, size_t lo, size_t hi, float* out, unsigned* word) {
    const size_t nout = (size_t)TL * 1024; const size_t gth = (size_t)blockIdx.x * NTH + threadIdx.x, nth = (size_t)gridDim.x * NTH;
    float m = 0.f;
    for (size_t i = lo + gth; i < hi; i += nth) { float v; if constexpr (sizeof(Tsrc) == 2) v = bf2f(((const bf16_t*)src)[i]); else v = (float)src[i]; m = fmaxf(m, fabsf(v)); }
    atomicMax(word, __float_as_uint(m));
    for (size_t i = gth; i < nout; i += nth) out[i] = 0.f;
}
#define PROBE_MAX(id, type, off, lo, hi) do { if (PROBE_ID == (id) && l == 0) { GRID_BAR(); unsigned* w_ = (unsigned*)(WSP + WS_CTL) + 3600; probe_max((const type*)(WSP + (off)), (size_t)(lo), (size_t)(hi), kparams()->out, w_); \
    GRID_BAR(); if (blockIdx.x == 0 && threadIdx.x == 0) kparams()->out[0] = __uint_as_float(__hip_atomic_load(w_, __ATOMIC_RELAXED, __HIP_MEMORY_SCOPE_AGENT)); return; } } while (0)

template <class Tsrc> __device__ __forceinline__ void probe_cnt(const Tsrc* src, size_t lo, size_t hi, float thr, float* out, unsigned* word) {
    const size_t nout = (size_t)TL * 1024; const size_t gth = (size_t)blockIdx.x * NTH + threadIdx.x, nth = (size_t)gridDim.x * NTH;
    unsigned m = 0;
    for (size_t i = lo + gth; i < hi; i += nth) { float v; if constexpr (sizeof(Tsrc) == 2) v = bf2f(((const bf16_t*)src)[i]); else v = (float)src[i]; m += (fabsf(v) > thr || v != v) ? 1u : 0u; }
    atomicAdd(word, m);
    for (size_t i = gth; i < nout; i += nth) out[i] = 0.f;
}
#define PROBE_CNT(id, type, off, lo, hi, thr) do { if (PROBE_ID == (id) && l == 0) { GRID_BAR(); unsigned* w_ = (unsigned*)(WSP + WS_CTL) + 3600; probe_cnt((const type*)(WSP + (off)), (size_t)(lo), (size_t)(hi), thr, kparams()->out, w_); \
    GRID_BAR(); if (blockIdx.x == 0 && threadIdx.x == 0) kparams()->out[0] = 100.f + (float)__hip_atomic_load(w_, __ATOMIC_RELAXED, __HIP_MEMORY_SCOPE_AGENT); return; } } while (0)

__device__ __forceinline__ void probe_cnt2(const bf16_t* src, int r0, int r1, int c0, int c1, int ld, float thr, float* out, unsigned* word) {
    const size_t nout = (size_t)TL * 1024; const size_t gth = (size_t)blockIdx.x * NTH + threadIdx.x, nth = (size_t)gridDim.x * NTH;
    unsigned m = 0; const size_t w = (size_t)(c1 - c0), n = (size_t)(r1 - r0) * w;
    for (size_t i = gth; i < n; i += nth) { const size_t r = r0 + i / w, c = c0 + i % w; const float v = bf2f(src[r * ld + c]); m += (fabsf(v) > thr || v != v) ? 1u : 0u; }
    atomicAdd(word, m);
    for (size_t i = gth; i < nout; i += nth) out[i] = 0.f;
}
#define PROBE_CNT2(id, off, r0, r1, c0, c1, ld, thr) do { if (PROBE_ID == (id) && l == 0) { GRID_BAR(); unsigned* w_ = (unsigned*)(WSP + WS_CTL) + 3600; probe_cnt2((const bf16_t*)(WSP + (off)), r0, r1, c0, c1, ld, thr, kparams()->out, w_); \
    GRID_BAR(); if (blockIdx.x == 0 && threadIdx.x == 0) kparams()->out[0] = 100.f + (float)__hip_atomic_load(w_, __ATOMIC_RELAXED, __HIP_MEMORY_SCOPE_AGENT); return; } } while (0)
__global__ void __launch_bounds__(NTH, 2) fwd_kernel(Params Pk) {
    extern __shared__ __attribute__((aligned(16))) unsigned char smem[];
    LAS unsigned char* lds = (LAS unsigned char*)smem;
    const int tid = threadIdx.x, G = gridDim.x;
#define bid obid()
#define LL ouni(l)
#define P (*kparams())
#define WSP (kparams()->ws)
    if (tid < 4) ((volatile LAS unsigned*)(lds + LDS_XB))[tid] = 0u;
    __syncthreads();
    (void)xcd_barrier_post((unsigned*)(Pk.ws + WS_CTL), (volatile LAS unsigned*)(lds + LDS_XB));
#define GRID_BAR() do { XcdBarrier b_; b_.bar = (unsigned*)(kparams()->ws + WS_CTL); b_.x = xb_xcc_id(); b_.st = (volatile LAS unsigned*)(lds + LDS_XB); xcd_barrier(b_); } while (0)

    p0_prep(P, smem);
    GRID_BAR();
    p1_norm0(P);
    GRID_BAR();
    for (int l = 0; l < NL; ++l) {
        { Src1 S{(const char*)(WSP + WS_H), (const char*)(WSP + WS_W1T) + (size_t)LL * N1 * 2048, (const char*)(WSP + WS_WFT) + (size_t)LL * 512 * 2048, G, bid};
          Epi1 E{(bf16_t*)(WSP + WS_G), (bf16_t*)(WSP + WS_PJ), (float*)(WSP + WS_DTR), (bf16_t*)(WSP + WS_VT), (bf16_t*)(WSP + WS_VTC)};
          pg8::gemm_phase<false>(lds, S, E, 1024, 1024); }
        PROBE_AT(1, bf16_t, WS_PJ, (size_t)T * PJW);
        PROBE_AT(2, bf16_t, WS_G, (size_t)T * 4096);
        PROBE_MAX(20, bf16_t, WS_G, 0, (size_t)T * 4096);
        PROBE_MAX(21, bf16_t, WS_PJ, 0, (size_t)T * PJW);
        PROBE_CNT(23, bf16_t, WS_G, 0, (size_t)T * 4096, 1.001f);
        PROBE_CNT2(24, WS_G, 0, T, 0, 2048, 4096, 1.001f);
        PROBE_CNT2(25, WS_G, 0, T, 3840, 4096, 4096, 1.001f);
        PROBE_CNT2(26, WS_G, 0, 256, 0, 4096, 4096, 1.001f);
        PROBE_MAX(22, bf16_t, WS_H, 0, (size_t)T * 1024);
        GRID_BAR();
        p3_prep(P, smem, LL);
        GRID_BAR();
        { SrcDft S{(const char*)(WSP + WS_D4C), (const char*)(WSP + WS_D4S), (const char*)(WSP + WS_D256), (const char*)(WSP + WS_VT), (const char*)(WSP + WS_VTC), G, bid};
          EpiDft E{(bf16_t*)(WSP + WS_YC)};
          pg8::gemm_phase<false>(lds, S, E, 4096, 8192); }
        hyena_conv(P, smem, lds, LL);
        ssd_phase_a(P, smem, lds, LL);
        GRID_BAR();
        ssd_phase_b(P);
        hyena_finish(P, smem, LL);
        GRID_BAR();
        ssd_phase_c(P, smem, lds, LL);
        PROBE_AT(3, bf16_t, WS_YC, (size_t)T * YCW);
        GRID_BAR();
        { SrcBr S{(const char*)(WSP + WS_YC), (const char*)(WSP + WS_WBRT) + (size_t)LL * 1024 * YCW * 2, G, bid};
          EpiBr E{(const bf16_t*)(WSP + WS_G), (bf16_t*)(WSP + WS_MG), (const float*)(WSP + WS_SSQ)};
          pg8::gemm_phase<false>(lds, S, E, YCW, YCW); }
        GRID_BAR();
        PROBE_AT(6, bf16_t, WS_MG, (size_t)T * 1024);
        PROBE_AT(7, float, WS_SSQ, (size_t)T * 8);
        { SrcOut S{(const char*)(WSP + WS_MG), (const char*)(WSP + WS_WOUTT) + (size_t)LL * 1024 * 2048, G, bid};
          EpiOut E{LL == 0 ? P.in[I_X] : (const float*)(WSP + WS_XC), LL == 0 ? P.in[I_CTX] : (const float*)(WSP + WS_XC) + (size_t)TL * 1024, (float*)(WSP + WS_X1),
                   (const float*)(WSP + WS_MOD) + (size_t)LL * 9 * 6144};
          pg8::gemm_phase<false>(lds, S, E, 1024, 1024); }
        GRID_BAR();
        PROBE_AT(4, float, WS_X1, (size_t)T * 1024);
        p7a_route(P, smem, LL);
        GRID_BAR();
        p7b_scatter(P, smem);
        GRID_BAR();
        { SrcUp S{(const char*)(WSP + WS_H2), (const char*)(WSP + WS_WUPT) + (size_t)LL * 32 * 2048 * 2048, (const int*)(WSP + WS_RTOK), (const int*)(WSP + WS_META), G, bid};
          EpiUp E{(bf16_t*)(WSP + WS_ACTB), P.in[I_BUP] + (size_t)LL * 32 * 2048};
          pg8::gemm_phase<true>(lds, S, E, 1024, 1024); }
        GRID_BAR();
        { SrcDn S{(const char*)(WSP + WS_ACTB), (const char*)(WSP + WS_WDNT) + (size_t)LL * 32 * 1024 * 2048, (const int*)(WSP + WS_META), G, bid};
          EpiDn E{(bf16_t*)(WSP + WS_YP), P.in[I_BDN] + (size_t)LL * 32 * 1024, (const int*)(WSP + WS_RPAIR), (const float*)(WSP + WS_RW)};
          pg8::gemm_phase<false>(lds, S, E, 1024, 1024); }
        GRID_BAR();
        PROBE_AT(5, bf16_t, WS_YP, (size_t)T * 4 * 1024);
        p10_combine(P, LL);
        GRID_BAR();
    }
}
#undef bid
#undef LL
#undef GRID_BAR
#undef P
#undef WSP

extern "C" void kernel_launch(void* const* d_in, const int* in_sizes, int n_in, void* d_out, int out_size, void* d_ws, size_t ws_size, hipStream_t stream) {
    static int grid = 0;
    if (grid == 0) {
        if (n_in != 35 || ws_size < WS_END) { fprintf(stderr, "kernel_launch: need 35 inputs and %zu bytes of workspace (got %d, %zu)\n", (size_t)WS_END, n_in, ws_size); grid = -1; return; }
        int dev = 0, cus = 0, per_cu = 0;
        if (hipGetDevice(&dev) != hipSuccess || hipDeviceGetAttribute(&cus, hipDeviceAttributeMultiprocessorCount, dev) != hipSuccess) { grid = -1; return; }
        if (hipFuncSetAttribute((const void*)fwd_kernel, hipFuncAttributeMaxDynamicSharedMemorySize, LDS_BYTES) != hipSuccess) { fprintf(stderr, "kernel_launch: hipFuncSetAttribute failed\n"); grid = -1; return; }
        if (hipOccupancyMaxActiveBlocksPerMultiprocessor(&per_cu, (const void*)fwd_kernel, NTH, LDS_BYTES) != hipSuccess || per_cu < 1) { fprintf(stderr, "kernel_launch: occupancy query says %d\n", per_cu); }
        (void)hipGetLastError();
        grid = cus;
    }
    if (grid < 0) return;
    (void)in_sizes; (void)out_size;
    hipMemsetAsync((char*)d_ws + WS_CTL, 0, 16384, stream);
    Params p{};
    for (int i = 0; i < 35; ++i) p.in[i] = (const float*)d_in[i];
    p.out = (float*)d_out; p.ws = (unsigned char*)d_ws;
    hipLaunchKernelGGL(fwd_kernel, dim3(grid), dim3(NTH), LDS_BYTES, stream, p);
}
```

```cpp
#include <hip/hip_runtime.h>
#include <cstdio>
#include <cstdint>
#define LAS __attribute__((address_space(3)))
typedef unsigned short bf16_t;
typedef short bf16x8 __attribute__((ext_vector_type(8)));
typedef short bf16x4 __attribute__((ext_vector_type(4)));
typedef float f32x4 __attribute__((ext_vector_type(4)));
typedef float f32x2 __attribute__((ext_vector_type(2)));
typedef float f32x16 __attribute__((ext_vector_type(16)));
typedef unsigned u32x4 __attribute__((ext_vector_type(4)));
typedef unsigned u32x2 __attribute__((ext_vector_type(2)));

constexpr int DM = 1024, NB = 8, SEQ = 4096, CTXL = 256, NL = 4;
constexpr int TL = NB * SEQ, TC = NB * CTXL, T = TL + TC;
constexpr int NTH = 512;
constexpr int INW = 2832;
constexpr int N1 = 6912;
constexpr int PJW = 2560;
constexpr int YCW = 1536;
constexpr int NEXP = 32, EFF = 1024;
constexpr int NCH = 34;
constexpr int MAXU = 576;
constexpr int RMAX = MAXU * 256;
constexpr float EPSN = 1e-6f;

constexpr size_t alup(size_t x) { return (x + 255) & ~size_t(255); }
constexpr size_t WS_CTL   = 0;
constexpr size_t WS_W1T   = 16384;
constexpr size_t WS_WFT   = WS_W1T   + alup((size_t)NL * N1 * 1024 * 2);
constexpr size_t WS_WBRT  = WS_WFT   + alup((size_t)NL * 512 * 1024 * 2);
constexpr size_t WS_WOUTT = WS_WBRT  + alup((size_t)NL * 1024 * YCW * 2);
constexpr size_t WS_WUPT  = WS_WOUTT + alup((size_t)NL * 1024 * 1024 * 2);
constexpr size_t WS_WDNT  = WS_WUPT  + alup((size_t)NL * 32 * 2048 * 1024 * 2);
constexpr size_t WS_D4C   = WS_WDNT  + alup((size_t)NL * 32 * 1024 * 1024 * 2);
constexpr size_t WS_D4S   = WS_D4C   + alup((size_t)4096 * 4096 * 2);
constexpr size_t WS_D256  = WS_D4S   + alup((size_t)4096 * 4096 * 2);
constexpr size_t WS_KRAW  = WS_D256  + alup((size_t)256 * 4096 * 2);
constexpr size_t WS_KPART = WS_KRAW  + alup((size_t)NL * 2 * 4096 * 512 * 4);
constexpr size_t WS_MOD   = WS_KPART + alup((size_t)NL * 2 * 64 * 512 * 4);
constexpr size_t WS_H     = WS_MOD   + alup((size_t)NL * 9 * 6144 * 4);
constexpr size_t WS_G     = WS_H     + alup((size_t)T * 1024 * 2);
constexpr size_t WS_PJ    = WS_G     + alup((size_t)T * 4096 * 2);
constexpr size_t WS_DTR   = WS_PJ    + alup((size_t)T * PJW * 2);
constexpr size_t WS_DT    = WS_DTR   + alup((size_t)T * 16 * 4);
constexpr size_t WS_VT    = WS_DT    + alup((size_t)T * 16 * 4);
constexpr size_t WS_VTC   = WS_VT    + alup((size_t)2048 * 8192 * 2);
constexpr size_t WS_YC    = WS_VTC   + alup((size_t)2048 * 8192 * 2);
constexpr size_t WS_XBN   = WS_YC    + alup((size_t)T * YCW * 2);
constexpr size_t WS_XST   = WS_XBN   + alup((size_t)T * 1024 * 2);
constexpr size_t WS_XSTC  = WS_XST   + alup((size_t)8 * 768 * 4096 * 2);
constexpr size_t WS_VVT   = WS_XSTC  + alup((size_t)8 * 768 * 256 * 2);
constexpr size_t WS_VVTC  = WS_VVT   + alup((size_t)8 * 256 * 4096 * 2);
constexpr size_t WS_CVT   = WS_VVTC  + alup((size_t)8 * 256 * 256 * 2);
constexpr size_t WS_CVTC  = WS_CVT   + alup((size_t)8 * 256 * 4096 * 4);
constexpr size_t WS_ST    = WS_CVTC  + alup((size_t)8 * 256 * 256 * 4);
constexpr size_t WS_HENT  = WS_ST    + alup((size_t)8 * 2 * 4 * 2 * NCH * 8192 * 4);
constexpr size_t WS_ACT   = WS_HENT  + alup((size_t)8 * 2 * 4 * 2 * NCH * 8192 * 2);
constexpr size_t WS_YD    = WS_ACT   + alup((size_t)8 * 2 * 4 * 2 * NCH * 4);
constexpr size_t WS_SSQ   = WS_YD    + alup((size_t)T * 512 * 4);
constexpr size_t WS_MG    = WS_SSQ   + alup((size_t)T * 8 * 4);
constexpr size_t WS_X1    = WS_MG    + alup((size_t)T * 1024 * 2);
constexpr size_t WS_XC    = WS_X1    + alup((size_t)T * 1024 * 4);
constexpr size_t WS_H2    = WS_XC    + alup((size_t)T * 1024 * 4);
constexpr size_t WS_TKE   = WS_H2    + alup((size_t)T * 1024 * 2);
constexpr size_t WS_TKW   = WS_TKE   + alup((size_t)T * 4 * 4);
constexpr size_t WS_BCNT  = WS_TKW   + alup((size_t)T * 4 * 4);
constexpr size_t WS_RTOK  = WS_BCNT  + alup((size_t)1024 * 32 * 4);
constexpr size_t WS_RPAIR = WS_RTOK  + alup((size_t)RMAX * 4);
constexpr size_t WS_RW    = WS_RPAIR + alup((size_t)RMAX * 4);
constexpr size_t WS_META  = WS_RW    + alup((size_t)RMAX * 4);
constexpr size_t WS_ACTB  = WS_META  + alup(256);
constexpr size_t WS_YP    = WS_ACTB  + alup((size_t)RMAX * 1024 * 2);
constexpr size_t WS_WRT   = WS_YP    + alup((size_t)T * 4 * 1024 * 2);
constexpr size_t WS_ACSG  = WS_WRT   + alup((size_t)NL * 2 * 32 * 1024 * 2);
constexpr size_t WS_END   = WS_ACSG  + alup((size_t)NB * 2 * NCH * 1024 * 4);

constexpr int LDS_BYTES = 155648;
constexpr int LDS_XB = LDS_BYTES - 64;

__device__ __forceinline__ unsigned cvt_pk_bf16(float lo, float hi) { typedef __bf16 bf2_t __attribute__((ext_vector_type(2))); const bf2_t v = {(__bf16)lo, (__bf16)hi}; return __builtin_bit_cast(unsigned, v); }
__device__ __forceinline__ bf16_t f2bf(float f) { return (bf16_t)(cvt_pk_bf16(f, 0.f) & 0xffffu); }
__device__ __forceinline__ float bf2f(bf16_t b) { return __uint_as_float(((unsigned)b) << 16); }
__device__ __forceinline__ float bflo(unsigned u) { return __uint_as_float(u << 16); }
__device__ __forceinline__ float bfhi(unsigned u) { return __uint_as_float(u & 0xffff0000u); }
template <int X> __device__ __forceinline__ float swz_xor(float v) { return __int_as_float(__builtin_amdgcn_ds_swizzle(__float_as_int(v), (X << 10) | 0x1f)); }
__device__ __forceinline__ float xor32_sum(float v) {
    typedef unsigned u2 __attribute__((ext_vector_type(2)));
    const u2 r = __builtin_amdgcn_permlane32_swap(__float_as_uint(v), __float_as_uint(v), false, false);
    return __uint_as_float(r[0]) + __uint_as_float(r[1]);
}
__device__ __forceinline__ float wave_sum(float v) {
    v += swz_xor<1>(v); v += swz_xor<2>(v); v += swz_xor<4>(v); v += swz_xor<8>(v); v += swz_xor<16>(v);
    return xor32_sum(v);
}
extern __shared__ __attribute__((aligned(16))) unsigned char dyn_smem[];
__device__ __forceinline__ LAS unsigned char* fresh_lds() { unsigned o = 0; asm volatile("" : "+s"(o)); return (LAS unsigned char*)dyn_smem + o; }
__device__ __forceinline__ unsigned char* fresh_smem() { return (unsigned char*)fresh_lds(); }
__device__ __forceinline__ int otid() { int t = threadIdx.x; asm volatile("" : "+v"(t)); return t; }
__device__ __forceinline__ int obid() { int t = blockIdx.x; asm volatile("" : "+s"(t)); return t; }
__device__ __forceinline__ int ouni(int t) { asm volatile("" : "+s"(t)); return t; }
__device__ __forceinline__ float fsigmoid(float x) { return __builtin_amdgcn_rcpf(1.f + __expf(-x)); }
__device__ __forceinline__ float fsilu(float x) { return x * fsigmoid(x); }
__device__ __forceinline__ float fsoftplus(float x) { return x > 20.f ? x : log1pf(expf(x)); }

#define XB_TMO      128
#define XB_XCNT(j)  (256  + 64 * (j))
#define XB_XSUB(j)  (1280 + 64 * (j))
#define XB_XGEN(j)  (2304 + 64 * (j))
#define XB_TOP      3328
#define XB_TOPGEN   3392
#define XCD_BAR_WORDS 3456
#define XB_SPIN_CAP (1u << 22)
__device__ __forceinline__ unsigned xb_ld(unsigned* p)              { return __hip_atomic_load(p, __ATOMIC_RELAXED, __HIP_MEMORY_SCOPE_AGENT); }
__device__ __forceinline__ unsigned xb_add(unsigned* p, unsigned v) { return __hip_atomic_fetch_add(p, v, __ATOMIC_RELAXED, __HIP_MEMORY_SCOPE_AGENT); }
__device__ __forceinline__ unsigned xb_xcc_id() { return (unsigned)__builtin_amdgcn_s_getreg((3 << 11) | 20) & 0xFu; }
#define XB_SPIN(cond, bar) do { unsigned _sp = 0; while (cond) { __builtin_amdgcn_s_sleep(1); \
    if ((++_sp & 255u) == 0u) { if (xb_ld(&(bar)[XB_TMO])) break; if (_sp > XB_SPIN_CAP) { atomicAdd(&(bar)[XB_TMO], 1u); break; } } } } while (0)
struct XcdBarrier { unsigned* bar; unsigned x; volatile LAS unsigned* st; };
__device__ __forceinline__ XcdBarrier xcd_barrier_post(unsigned* bar, volatile LAS unsigned* st) {
    XcdBarrier b; b.bar = bar; b.x = xb_xcc_id(); b.st = st;
    if (threadIdx.x == 0) (void)xb_add(&bar[XB_XCNT(b.x)], 1u);
    return b;
}
__device__ __forceinline__ void xcd_barrier_complete(unsigned* bar, unsigned x, unsigned& nloc, unsigned& nx) {
    const unsigned G = gridDim.x * gridDim.y * gridDim.z;
    unsigned sum, cnt, mine, sp = 0u;
    for (;;) {
        sum = 0u; cnt = 0u; mine = 0u;
#pragma unroll
        for (unsigned j = 0; j < 16; ++j) { const unsigned c = xb_ld(&bar[XB_XCNT(j)]); sum += c; cnt += (c > 0u) ? 1u : 0u; mine = (j == x) ? c : mine; }
        if (sum == G) break;
        __builtin_amdgcn_s_sleep(1);
        if ((++sp & 255u) == 0u) { if (xb_ld(&bar[XB_TMO])) break; if (sp > XB_SPIN_CAP) { atomicAdd(&bar[XB_TMO], 1u); break; } }
    }
    nloc = mine > 0u ? mine : 1u; nx = cnt > 0u ? cnt : 1u;
}
__device__ __forceinline__ void xcd_barrier(const XcdBarrier& b) {
    asm volatile("s_waitcnt vmcnt(0)" ::: "memory");
    __syncthreads();
    if (threadIdx.x == 0) {
        unsigned* bar = b.bar;
        __builtin_amdgcn_s_waitcnt(0);
        unsigned nloc = b.st[0], nx = b.st[1];
        if (nloc == 0u) { xcd_barrier_complete(bar, b.x, nloc, nx); b.st[0] = nloc; b.st[1] = nx; }
        const unsigned old = xb_add(&bar[XB_XSUB(b.x)], 1u);
        const unsigned gen = old / nloc;
        if (old + 1u == (gen + 1u) * nloc) {
            __builtin_amdgcn_fence(__ATOMIC_RELEASE, "agent");
            asm volatile("s_waitcnt vmcnt(0)" ::: "memory");
            const unsigned og = xb_add(&bar[XB_TOP], 1u);
            const unsigned tg = og / nx;
            if (og + 1u == (tg + 1u) * nx) xb_add(&bar[XB_TOPGEN], 1u);
            else XB_SPIN(xb_ld(&bar[XB_TOPGEN]) == tg, bar);
            __builtin_amdgcn_fence(__ATOMIC_ACQUIRE, "agent");
            xb_add(&bar[XB_XGEN(b.x)], 1u);
            asm volatile("s_waitcnt vmcnt(0)" ::: "memory");
        } else {
            XB_SPIN(xb_ld(&bar[XB_XGEN(b.x)]) == gen, bar);
            __builtin_amdgcn_fence(__ATOMIC_ACQUIRE, "agent");
            asm volatile("s_waitcnt vmcnt(0)" ::: "memory");
        }
    }
    __syncthreads();
}

namespace pg8 {
constexpr int BM = 256, BK = 64, HALF = 128, HTB = HALF * BK * 2, STAGE_BYTES = 8 * HTB, NXCD = 8, WGM = 8;
__host__ __device__ __forceinline__ int lds_byte(int r, int c) { const int st = (r >> 4) * 2 + (c >> 5), rr = r & 15, cc = c & 31, ob = rr * 64 + cc * 2; return st * 1024 + (ob ^ (((ob >> 9) & 1) << 5)); }
__host__ __device__ __forceinline__ void stage_rc(int b, int& R, int& C) { const int st = b / 1024, sb = b % 1024, swz = sb ^ (((sb >> 9) & 1) << 5); R = (st >> 1) * 16 + swz / 64; C = (st & 1) * 32 + (swz % 64) / 2; }
__host__ __device__ __forceinline__ int perm32(int rho) { const int n = rho >> 4, i = rho & 15; return 8 * (i >> 2) + 4 * n + (i & 3); }

__device__ __forceinline__ void remap_tile(int L, int nM, int nN, int& pm, int& pn) {
    const int nwg = nM * nN; int wgid = L;
    { const int q = nwg / NXCD, r = nwg % NXCD, xcd = wgid % NXCD, off = wgid / NXCD; wgid = (xcd < r ? xcd * (q + 1) : r * (q + 1) + (xcd - r) * q) + off; }
    const int nig = WGM * nN, gid = wgid / nig, fm = gid * WGM, gsz = (nM - fm) < WGM ? (nM - fm) : WGM;
    pm = fm + ((wgid % nig) % gsz); pn = (wgid % nig) / gsz;
}

struct GUnit { const char* a0; const char* a1; const char* b0; const char* b1; const int* gidx; int nt, pm, pn, kind, e; };

template <bool GATHER, class Src, class Epi>
__device__ __forceinline__ void gemm_phase(LAS unsigned char* lds, const Src& S, const Epi& E, const int lda, const int ldb) {
    const int tid = otid(), wid = __builtin_amdgcn_readfirstlane(tid >> 6), lane = tid & 63, wr = wid >> 2, wc = wid & 3, fr = lane & 15, fq = lane >> 4;
    unsigned voffA[2], voffB[2];
#pragma unroll
    for (int i = 0; i < 2; ++i) { int R, C; stage_rc(tid * 16 + i * 8192, R, C); const int Rb = (R & ~31) + perm32(R & 31);
        voffA[i] = (unsigned)(R * lda + C) * 2u; voffB[i] = (unsigned)(Rb * ldb + C) * 2u; }
    const size_t kstep = (size_t)(BK * 2);
    const unsigned ldsw = (unsigned)wid * 1024u;
    const int aoff = lds_byte(wr * 64 + fr, fq * 8), boff = lds_byte(wc * 32 + fr, fq * 8);
#define PG8_SA(b, h) (((b) * 2 + (h)) * HTB)
#define PG8_SB(b, h) ((4 + (b) * 2 + (h)) * HTB)
#define PG8_STAGE(bufoff, gbase, voff) do { _Pragma("unroll") for (int _i = 0; _i < 2; ++_i) \
        __builtin_amdgcn_global_load_lds((const unsigned*)((const char*)(gbase) + (voff)[_i]), (LAS unsigned*)(lds + (bufoff) + ldsw + _i * 8192), 16, 0, 0); } while (0)
#define PG8_LDA(dst, b, h) do { _Pragma("unroll") for (int m = 0; m < 4; ++m) _Pragma("unroll") for (int k = 0; k < 2; ++k) dst[m][k] = *(const LAS bf16x8*)(lds + PG8_SA(b, h) + aoff + m * 2048 + k * 1024); } while (0)
#define PG8_LDB(dst, b, h) do { _Pragma("unroll") for (int n = 0; n < 2; ++n) _Pragma("unroll") for (int k = 0; k < 2; ++k) dst[n][k] = *(const LAS bf16x8*)(lds + PG8_SB(b, h) + boff + n * 2048 + k * 1024); } while (0)
#define PG8_MMA(ai, bj, At, Bt) do { __builtin_amdgcn_s_setprio(1); _Pragma("unroll") for (int m = 0; m < 4; ++m) _Pragma("unroll") for (int n = 0; n < 2; ++n) _Pragma("unroll") for (int k = 0; k < 2; ++k) \
        acc[ai][bj][m][n] = __builtin_amdgcn_mfma_f32_16x16x32_bf16(Bt[n][k], At[m][k], acc[ai][bj][m][n], 0, 0, 0); __builtin_amdgcn_s_setprio(0); } while (0)
#define PG8_WAIT_V(n) asm volatile("s_waitcnt vmcnt(" #n ")" ::: "memory")
#define PG8_WAIT_L(n) asm volatile("s_waitcnt lgkmcnt(" #n ")" ::: "memory")
#define PG8_BAR __builtin_amdgcn_s_barrier()
#define PG8_SCHED __builtin_amdgcn_sched_barrier(0)
#define PG8_LOADV(u, v) do { int _tt = tid; asm volatile("" : "+v"(_tt)); _Pragma("unroll") for (int _i = 0; _i < 2; ++_i) { int _R, _C; stage_rc(_tt * 16 + _i * 8192, _R, _C); \
        _Pragma("unroll") for (int _h = 0; _h < 2; ++_h) { if constexpr (GATHER) v[_h][_i] = (unsigned)((u).gidx[_h * 128 + _R] * lda + _C) * 2u; else v[_h][_i] = voffA[_i]; } } } while (0)
    GUnit cur, nxt; int ui = 0;
    if (!S.get(0, cur)) return;
    f32x4 acc[2][2][4][2];
#pragma unroll
    for (int a = 0; a < 2; ++a)
#pragma unroll
        for (int b = 0; b < 2; ++b)
#pragma unroll
            for (int m = 0; m < 4; ++m)
#pragma unroll
                for (int n = 0; n < 2; ++n) acc[a][b][m][n] = (f32x4){0.f, 0.f, 0.f, 0.f};
    bf16x8 At[4][2], B0[2][2], B1[2][2];
    unsigned va[2][2];
    PG8_LOADV(cur, va);
    const char* cA0 = cur.a0; const char* cA1 = cur.a1; const char* cB0 = cur.b0; const char* cB1 = cur.b1;
    PG8_STAGE(PG8_SB(0, 0), cB0, voffB); PG8_STAGE(PG8_SA(0, 0), cA0, va[0]); PG8_STAGE(PG8_SB(0, 1), cB1, voffB); PG8_STAGE(PG8_SA(0, 1), cA1, va[1]);
    if (wr == 1) PG8_BAR;
    PG8_WAIT_V(4); PG8_BAR;
    PG8_STAGE(PG8_SB(1, 0), cB0 + kstep, voffB); PG8_STAGE(PG8_SA(1, 0), cA0 + kstep, va[0]); PG8_STAGE(PG8_SB(1, 1), cB1 + kstep, voffB);
    PG8_WAIT_V(6); PG8_BAR;
    for (;;) {
        const bool has_next = S.get(ui + 1, nxt);
        const char* nA0 = has_next ? nxt.a0 : cA0; const char* nA1 = has_next ? nxt.a1 : cA1;
        const char* nB0 = has_next ? nxt.b0 : cB0; const char* nB1 = has_next ? nxt.b1 : cB1;
        const int nt = cur.nt;
        for (int t = 0; t < nt; t += 2) {
            const bool last = (t == nt - 2);
            const char* a1h1 = cA1 + (size_t)(t + 1) * kstep;
            const char* a2h0 = last ? nA0 : cA0 + (size_t)(t + 2) * kstep; const char* a2h1 = last ? nA1 : cA1 + (size_t)(t + 2) * kstep;
            const char* b2h0 = last ? nB0 : cB0 + (size_t)(t + 2) * kstep; const char* b2h1 = last ? nB1 : cB1 + (size_t)(t + 2) * kstep;
            const char* a3h0 = a2h0 + kstep; const char* b3h0 = b2h0 + kstep; const char* b3h1 = b2h1 + kstep;
            PG8_LDB(B0, 0, 0); PG8_SCHED; PG8_LDA(At, 0, 0); PG8_STAGE(PG8_SA(1, 1), a1h1, va[1]);
            if constexpr (GATHER) { if (last && has_next) { PG8_LOADV(nxt, va); } }
            PG8_WAIT_L(8); PG8_BAR; PG8_WAIT_L(0); PG8_MMA(0, 0, At, B0); PG8_BAR; PG8_SCHED;
            PG8_LDB(B1, 0, 1); PG8_STAGE(PG8_SB(0, 0), b2h0, voffB);
            PG8_BAR; PG8_WAIT_L(0); PG8_MMA(0, 1, At, B1); PG8_BAR;
            PG8_LDA(At, 0, 1); PG8_STAGE(PG8_SA(0, 0), a2h0, va[0]);
            PG8_BAR; PG8_WAIT_L(0); PG8_MMA(1, 0, At, B0); PG8_BAR; PG8_SCHED;
            PG8_STAGE(PG8_SB(0, 1), b2h1, voffB);
            PG8_WAIT_V(6); PG8_BAR; PG8_MMA(1, 1, At, B1); PG8_BAR;
            PG8_LDB(B0, 1, 0); PG8_SCHED; PG8_LDA(At, 1, 0); PG8_STAGE(PG8_SA(0, 1), a2h1, va[1]);
            PG8_WAIT_L(8); PG8_BAR; PG8_WAIT_L(0); PG8_MMA(0, 0, At, B0); PG8_BAR; PG8_SCHED;
            PG8_LDB(B1, 1, 1); PG8_STAGE(PG8_SB(1, 0), b3h0, voffB);
            PG8_BAR; PG8_WAIT_L(0); PG8_MMA(0, 1, At, B1); PG8_BAR;
            PG8_LDA(At, 1, 1); PG8_STAGE(PG8_SA(1, 0), a3h0, va[0]);
            PG8_BAR; PG8_WAIT_L(0); PG8_MMA(1, 0, At, B0); PG8_BAR; PG8_SCHED;
            PG8_STAGE(PG8_SB(1, 1), b3h1, voffB);
            PG8_WAIT_V(6); PG8_BAR; PG8_MMA(1, 1, At, B1); PG8_BAR;
        }
        E(acc, cur, wr, wc, fr, fq);
        if (!has_next) break;
#pragma unroll
        for (int a = 0; a < 2; ++a)
#pragma unroll
            for (int b = 0; b < 2; ++b)
#pragma unroll
                for (int m = 0; m < 4; ++m)
#pragma unroll
                    for (int n = 0; n < 2; ++n) acc[a][b][m][n] = (f32x4){0.f, 0.f, 0.f, 0.f};
        cur = nxt; cA0 = nA0; cA1 = nA1; cB0 = nB0; cB1 = nB1; ++ui;
    }
    PG8_WAIT_V(0);
    if (wr == 0) PG8_BAR;
    PG8_BAR;
#undef PG8_SA
#undef PG8_SB
#undef PG8_STAGE
#undef PG8_LDA
#undef PG8_LDB
#undef PG8_MMA
#undef PG8_WAIT_V
#undef PG8_WAIT_L
#undef PG8_BAR
#undef PG8_SCHED
#undef PG8_LOADV
}
}
using pg8::GUnit;

struct Params { const float* in[35]; float* out; unsigned char* ws; };
typedef const Params __attribute__((address_space(4))) CParams;
__device__ __forceinline__ CParams* kparams() { CParams* p = (CParams*)__builtin_amdgcn_kernarg_segment_ptr(); asm volatile("" : "+s"(p)); return p; }
enum { I_X = 0, I_C, I_CTX, I_CCTX, I_WMOD, I_BMOD, I_NMIX, I_NFFN, I_WIN, I_HCW, I_HCB, I_HW1, I_HB1, I_HW2, I_HB2, I_HW3, I_HBIAS, I_PW, I_PS,
       I_SCW, I_SCB, I_SDTB, I_SALOG, I_SD, I_SNORM, I_WBR, I_WGATE, I_WOUT, I_RW, I_RB, I_WUP, I_BUP, I_WDN, I_BDN, I_NFIN };

__device__ __forceinline__ int tok_modj(int t) { return t < TL ? (t >> 12) : 8; }

struct TJob { const float* src; size_t ld_src; int K, N; bf16_t* dst; size_t ld_dst; int nmat; size_t src_ms, dst_ms; const float* kscale; };
__device__ __forceinline__ TJob make_tjob(CParams& P, int l, int j) {
    unsigned char* ws = P.ws; TJob J;
    bf16_t* W1T = (bf16_t*)(ws + WS_W1T) + (size_t)l * N1 * 1024;
    bf16_t* WBRT = (bf16_t*)(ws + WS_WBRT) + (size_t)l * 1024 * YCW;
    const float* wbr = P.in[I_WBR] + (size_t)l * 1280 * 1024;
    J.kscale = nullptr; J.nmat = 1; J.src_ms = 0; J.dst_ms = 0; J.ld_src = 1024; J.K = 1024; J.N = 1024; J.ld_dst = 1024;
    if (j == 0) { J.src = P.in[I_WGATE] + (size_t)l * 4 * 1024 * 1024; J.dst = W1T; J.nmat = 4; J.src_ms = (size_t)1024 * 1024; J.dst_ms = (size_t)1024 * 1024; }
    else if (j == 1) { J.src = P.in[I_WIN] + (size_t)l * 1024 * INW + 256; J.ld_src = INW; J.N = 2576; J.dst = W1T + (size_t)4096 * 1024; }
    else if (j == 2) { J.src = wbr; J.K = 256; J.dst = WBRT; J.ld_dst = YCW; }
    else if (j == 3) { J.src = wbr; J.K = 256; J.dst = WBRT + 256; J.ld_dst = YCW; }
    else if (j == 4) { J.src = wbr + (size_t)256 * 1024; J.K = 256; J.dst = WBRT + 512; J.ld_dst = YCW; }
    else if (j == 5) { J.src = wbr + (size_t)768 * 1024; J.K = 512; J.dst = WBRT + 1024; J.ld_dst = YCW; J.kscale = P.in[I_SNORM] + l * 512; }
    else if (j == 6) { J.src = P.in[I_WOUT] + (size_t)l * 1024 * 1024; J.dst = (bf16_t*)(ws + WS_WOUTT) + (size_t)l * 1024 * 1024; }
    else if (j == 7) { J.src = P.in[I_WUP] + (size_t)l * 32 * 1024 * 2048; J.ld_src = 2048; J.N = 2048; J.dst = (bf16_t*)(ws + WS_WUPT) + (size_t)l * 32 * 2048 * 1024; J.nmat = 32; J.src_ms = (size_t)1024 * 2048; J.dst_ms = (size_t)2048 * 1024; }
    else { J.src = P.in[I_WDN] + (size_t)l * 32 * 1024 * 1024; J.dst = (bf16_t*)(ws + WS_WDNT) + (size_t)l * 32 * 1024 * 1024; J.nmat = 32; J.src_ms = (size_t)1024 * 1024; J.dst_ms = (size_t)1024 * 1024; }
    return J;
}
constexpr int MOE_TILES_P0 = 640;
constexpr int TILES_DENSE = 256 + 176 + 16 + 16 + 16 + 32 + 64, TILES_PER_LAYER = TILES_DENSE + 4096 + 2048;
struct TRef { const float* sr; bf16_t* d; size_t ld_dst; int nval; float sc; };
__device__ __forceinline__ TRef tile_locate(CParams& P, int g, int tid) {
    constexpr int PER_L = 256 + 176 + 16 + 16 + 16 + 32 + 64 + 4096 + 2048;
    const int l = g / PER_L; int r = g % PER_L, j = 0;
    const int cnt[9] = {256, 176, 16, 16, 16, 32, 64, 4096, 2048};
#pragma unroll
    for (int q = 0; q < 8; ++q) { if (j == q && r >= cnt[q]) { r -= cnt[q]; j = q + 1; } }
    const TJob J = make_tjob(P, l, j);
    const int ktiles = J.K / 64, ntiles = (J.N + 255) / 256, per = ktiles * ntiles;
    const int mat = r / per, rr = r % per, nt = rr / ktiles, kt = rr % ktiles;
    TRef T; const int row = tid >> 3;
    T.sr = J.src + (size_t)mat * J.src_ms + (size_t)(kt * 64 + row) * J.ld_src + nt * 256;
    T.d = J.dst + (size_t)mat * J.dst_ms + (size_t)(nt * 256) * J.ld_dst + kt * 64; T.ld_dst = J.ld_dst;
    T.nval = (J.N - nt * 256) < 256 ? (J.N - nt * 256) : 256;
    T.sc = J.kscale ? J.kscale[kt * 64 + row] : 1.f;
    return T;
}
__device__ __forceinline__ void p0_transposes(CParams& P, unsigned char* smem, int lo, int hi, int part, int nparts) {
    float* tile = (float*)smem;
    const int tid = otid(); const int G = nparts, TOTAL = hi;
    const int row = tid >> 3, c0 = (tid & 7) * 4;
    int g = lo + part; bool have = g < TOTAL;
    TRef T = tile_locate(P, have ? g : lo, tid);
    f32x4 v[8];
#pragma unroll
    for (int j = 0; j < 8; ++j) { const int c = c0 + 32 * j; v[j] = (have && c < T.nval) ? *(const f32x4*)(T.sr + c) : (f32x4){0.f, 0.f, 0.f, 0.f}; }
#pragma unroll 1
    while (have) {
        const int gn = g + G; const bool hasn = gn < TOTAL;
        __syncthreads();
#pragma unroll
        for (int j = 0; j < 8; ++j) { float* tp = tile + row * 257 + c0 + 32 * j; tp[0] = v[j][0] * T.sc; tp[1] = v[j][1] * T.sc; tp[2] = v[j][2] * T.sc; tp[3] = v[j][3] * T.sc; }
        bf16_t* d = T.d; const size_t ldd = T.ld_dst; const int nval = T.nval;
        if (hasn) { T = tile_locate(P, gn, tid);
#pragma unroll
            for (int j = 0; j < 8; ++j) { const int c = c0 + 32 * j; v[j] = (c < T.nval) ? *(const f32x4*)(T.sr + c) : (f32x4){0.f, 0.f, 0.f, 0.f}; } }
        __syncthreads();
        { const int n = tid >> 1, kh = (tid & 1) * 32;
          if (n < nval) {
#pragma unroll
              for (int q = 0; q < 4; ++q) { u32x4 o;
#pragma unroll
                  for (int e = 0; e < 4; ++e) o[e] = cvt_pk_bf16(tile[(kh + q * 8 + 2 * e) * 257 + n], tile[(kh + q * 8 + 2 * e + 1) * 257 + n]);
                  *(u32x4*)(d + (size_t)n * ldd + kh + q * 8) = o; } } }
        g = gn; have = hasn;
    }
    __syncthreads();
}

__device__ __forceinline__ void p0_prep(CParams& P, unsigned char* smem) {
    const int G = gridDim.x, tid = otid(), bid = obid();
    unsigned char* ws = P.ws;
    for (int l = 0; l < NL; ++l) p0_transposes(P, smem, l * TILES_PER_LAYER, l * TILES_PER_LAYER + TILES_DENSE + MOE_TILES_P0, bid, G);
    {
        float* wt = (float*)smem;
        float* ctab = wt + 64 * 65; float* stab = ctab + 64;
        if (tid < 64) { float s, c; sincospif((float)tid / 32.f, &s, &c); ctab[tid] = c * 0.125f; stab[tid] = s * 0.125f; }
        for (int it = bid; it < NL * 4 * 16; it += G) {
            const int l = it / 64, g = (it / 16) & 3, kb = it & 15;
            __syncthreads();
            { const int row = tid >> 3, c0 = (tid & 7) * 8; const float* sr = P.in[I_WIN] + ((size_t)l * 1024 + kb * 64 + row) * INW + g * 64 + c0;
#pragma unroll
              for (int j = 0; j < 8; ++j) wt[row * 65 + c0 + j] = sr[j]; }
            __syncthreads();
            const int rp = tid >> 2, kq = tid & 3, half = rp >> 6, cp = rp & 63;
            const float* tab = half ? stab : ctab;
            float o[16];
#pragma unroll
            for (int kk = 0; kk < 16; ++kk) o[kk] = 0.f;
            for (int c = 0; c < 64; ++c) { const float tv = tab[(c * cp) & 63];
#pragma unroll
                for (int kk = 0; kk < 16; ++kk) o[kk] += wt[(kq * 16 + kk) * 65 + c] * tv; }
            bf16_t* d = (bf16_t*)(ws + WS_WFT) + ((size_t)l * 512 + (g * 2 + half) * 64 + cp) * 1024 + kb * 64 + kq * 16;
            u32x4 o0, o1;
#pragma unroll
            for (int e = 0; e < 4; ++e) { o0[e] = cvt_pk_bf16(o[2 * e], o[2 * e + 1]); o1[e] = cvt_pk_bf16(o[8 + 2 * e], o[8 + 2 * e + 1]); }
            *(u32x4*)d = o0; *(u32x4*)(d + 8) = o1;
        }
        __syncthreads();
    }
    {
        float* pw = (float*)smem;
        float* wb = pw + 64 * 65;
        for (int it = bid; it < NL * 4 * 4; it += G) {
            const int l = it / 16, g = (it / 4) & 3, nb = it & 3;
            __syncthreads();
            for (int e = tid; e < 4096; e += NTH) { const int c = e >> 6, d = e & 63;
                pw[c * 65 + d] = P.in[I_PW][(((size_t)l * 4 + g) * 64 + c) * 64 + d] * P.in[I_PS][l * 256 + g * 64 + d]; }
            for (int e = tid; e < 64 * 256; e += NTH) { const int d = e >> 8, n = e & 255;
                wb[d * 257 + n] = P.in[I_WBR][((size_t)l * 1280 + 512 + g * 64 + d) * 1024 + nb * 256 + n]; }
            __syncthreads();
            const int n = tid & 255, ch = tid >> 8;
            bf16_t* d0 = (bf16_t*)(ws + WS_WBRT) + ((size_t)l * 1024 + nb * 256 + n) * YCW + 768 + g * 64 + ch * 32;
            float o[32];
#pragma unroll
            for (int e = 0; e < 32; ++e) o[e] = 0.f;
#pragma unroll 1
            for (int d = 0; d < 64; ++d) { const float wv = wb[d * 257 + n];
#pragma unroll
                for (int e = 0; e < 32; ++e) o[e] += pw[(ch * 32 + e) * 65 + d] * wv; }
#pragma unroll
            for (int q = 0; q < 4; ++q) { u32x4 ov;
#pragma unroll
                for (int e = 0; e < 4; ++e) ov[e] = cvt_pk_bf16(o[q * 8 + 2 * e], o[q * 8 + 2 * e + 1]);
                *(u32x4*)(d0 + q * 8) = ov; }
        }
        __syncthreads();
    }
    {
        bf16_t* D4C = (bf16_t*)(ws + WS_D4C); bf16_t* D4S = (bf16_t*)(ws + WS_D4S); bf16_t* D256 = (bf16_t*)(ws + WS_D256);
        const int gth = bid * NTH + tid, nth = G * NTH;
        for (int ch = gth; ch < 2048 * 512; ch += nth) {
            const int pp = ch >> 9, p0 = (ch & 511) * 8;
            u32x4 oc, os; float cv[8], sv[8];
#pragma unroll
            for (int e = 0; e < 8; ++e) { const int j = (pp * (p0 + e)) & 4095; float s, c; sincospif((float)j / 2048.f, &s, &c); cv[e] = c * (1.f / 64.f); sv[e] = -s * (1.f / 64.f); }
#pragma unroll
            for (int e = 0; e < 4; ++e) { oc[e] = cvt_pk_bf16(cv[2 * e], cv[2 * e + 1]); os[e] = cvt_pk_bf16(sv[2 * e], sv[2 * e + 1]); }
            *(u32x4*)(D4C + (size_t)pp * 4096 + p0) = oc; *(u32x4*)(D4S + (size_t)pp * 4096 + p0) = os;
        }
        for (int ch = gth; ch < 256 * 64; ch += nth) {
            const int pp = ch >> 6, k0 = (ch & 63) * 8; u32x4 o; float v[8];
#pragma unroll
            for (int e = 0; e < 8; ++e) { const int k = k0 + e; const int j = (pp * (k & 255)) & 255; float s, c; sincospif((float)j / 128.f, &s, &c); v[e] = (k < 256 ? c : -s) * (1.f / 16.f); }
#pragma unroll
            for (int e = 0; e < 4; ++e) o[e] = cvt_pk_bf16(v[2 * e], v[2 * e + 1]);
            *(u32x4*)(D256 + (size_t)pp * 4096 + k0) = o;
        }
    }
    {
        float* feats = (float*)smem;
        float* h1 = feats + 64 * 33;
        float* h2 = h1 + 64 * 65;
        const float dmin = 4.605170185988091f / 1.5f, dmax = 4.605170185988091f / 0.3f;
        for (int it = bid; it < NL * 68; it += G) {
            const int l = it / 68, r = it % 68, cfg = r < 64 ? 0 : 1, tile = cfg ? r - 64 : r, n = cfg ? 256 : 4096;
            __syncthreads();
            for (int e = tid; e < 64 * 33; e += NTH) { const int i = e / 33, f = e % 33; const int pos = tile * 64 + i;
                float v;
                if (f == 0) v = (float)pos / (float)(n - 1);
                else { const int j = (f - 1) & 15; const float fr = 1e-4f + (float)j * ((15.f - 1e-4f) / 15.f);
                       const float ang = 6.283185307179586f * (float)pos / (float)n * fr; v = (f <= 16) ? cosf(ang) : -sinf(ang); }
                feats[e] = v; }
            __syncthreads();
            { const int j = tid & 63, pg = tid >> 6; const float* w1 = P.in[I_HW1] + (size_t)l * 33 * 64; const float b = P.in[I_HB1][l * 64 + j];
              for (int q = 0; q < 8; ++q) { const int i = pg * 8 + q; float s = b; for (int f = 0; f < 33; ++f) s += feats[i * 33 + f] * w1[f * 64 + j]; h1[i * 65 + j] = sinf(s); } }
            __syncthreads();
            { const int j = tid & 63, pg = tid >> 6; const float* w2 = P.in[I_HW2] + (size_t)l * 64 * 64; const float b = P.in[I_HB2][l * 64 + j];
              for (int q = 0; q < 8; ++q) { const int i = pg * 8 + q; float s = b; for (int f = 0; f < 64; ++f) s += h1[i * 65 + f] * w2[f * 64 + j]; h2[i * 65 + j] = sinf(s); } }
            __syncthreads();
            { const int o = tid, c = o & 255, dir = o >> 8; const float* w3 = P.in[I_HW3] + (size_t)l * 64 * 512;
              float w[64];
#pragma unroll
              for (int f = 0; f < 64; ++f) w[f] = w3[f * 512 + o];
              const float delta = dmin + (float)c * ((dmax - dmin) / 255.f);
              float* kst = h2 + 64 * 65;
              float* kt = (float*)(ws + WS_KRAW) + ((size_t)l * 2 + cfg) * 512 * 4096 + tile * 64;
              float asum = 0.f;
#pragma unroll 1
              for (int i0 = 0; i0 < 64; i0 += 16) {
#pragma unroll 1
                  for (int ii = 0; ii < 16; ++ii) { const int i = i0 + ii; float s = 0.f;
#pragma unroll
                      for (int f = 0; f < 64; ++f) s += h2[i * 65 + f] * w[f];
                      const int pos = tile * 64 + i; const float tt = (float)pos / (float)(n - 1);
                      s *= expf(-tt * delta);
                      kst[o * 17 + ii] = s;
                      if (!(dir == 1 && pos == 0)) asum += fabsf(s); }
                  __syncthreads();
#pragma unroll
                  for (int q = 0; q < 4; ++q) { const int ch = tid + q * NTH, oo = ch >> 2, j = (ch & 3) * 4; const float* sp = kst + oo * 17 + j;
                      *(f32x4*)(kt + (size_t)oo * 4096 + i0 + j) = (f32x4){sp[0], sp[1], sp[2], sp[3]}; }
                  __syncthreads();
              }
              ((float*)(ws + WS_KPART))[(((size_t)l * 2 + cfg) * 64 + tile) * 512 + o] = asum; }
        }
        __syncthreads();
    }
    for (int e = bid * NTH + tid; e < NL * 32 * 1024; e += G * NTH) { const int l = e >> 15, ex = (e >> 10) & 31, k = e & 1023;
        const float wv = P.in[I_RW][((size_t)l * 1024 + k) * 32 + ex]; const bf16_t hi = f2bf(wv); const bf16_t lo = f2bf(wv - bf2f(hi));
        bf16_t* d = (bf16_t*)(ws + WS_WRT) + (size_t)l * 2 * 32 * 1024 + (size_t)ex * 1024 + k; d[0] = hi; d[32 * 1024] = lo; }
    {
        float* sc = (float*)smem;
        float* red = sc + 9 * 1024;
        for (int it = bid; it < NL * 24; it += G) {
            const int l = it / 24, nb = it % 24;
            __syncthreads();
            for (int e = tid; e < 9 * 1024; e += NTH) { const int j = e >> 10, k = e & 1023; const float v = j < 8 ? P.in[I_C][j * 1024 + k] : P.in[I_CCTX][k]; sc[e] = fsilu(v); }
            __syncthreads();
            const int n = nb * 256 + (tid & 255), kh = tid >> 8;
            const float* w = P.in[I_WMOD] + (size_t)l * 1024 * 6144 + n;
            float a[9];
#pragma unroll
            for (int j = 0; j < 9; ++j) a[j] = 0.f;
#pragma unroll 8
            for (int k = kh * 512; k < kh * 512 + 512; ++k) { const float wv = w[(size_t)k * 6144];
#pragma unroll
                for (int j = 0; j < 9; ++j) a[j] += sc[j * 1024 + k] * wv; }
            if (kh == 1) {
#pragma unroll
                for (int j = 0; j < 9; ++j) red[(tid & 255) * 9 + j] = a[j]; }
            __syncthreads();
            if (kh == 0) { const float b = P.in[I_BMOD][l * 6144 + n];
#pragma unroll
                for (int j = 0; j < 9; ++j) ((float*)(ws + WS_MOD))[((size_t)l * 9 + j) * 6144 + n] = a[j] + red[(tid & 255) * 9 + j] + b; }
        }
        __syncthreads();
    }
}

__device__ __forceinline__ void norm_row_store(const f32x4 (&v)[4], const float* gain, const float* sc, const float* sh, bf16_t* dst, int lane) {
    float ss = 0.f;
#pragma unroll
    for (int q = 0; q < 4; ++q) ss += v[q][0] * v[q][0] + v[q][1] * v[q][1] + v[q][2] * v[q][2] + v[q][3] * v[q][3];
    ss = wave_sum(ss);
    const float rs = rsqrtf(ss * (1.f / 1024.f) + EPSN);
#pragma unroll
    for (int q = 0; q < 4; ++q) { const int c = q * 256 + lane * 4;
        const f32x4 g = *(const f32x4*)(gain + c), a = *(const f32x4*)(sc + c), b = *(const f32x4*)(sh + c);
        u32x2 o; o[0] = cvt_pk_bf16(v[q][0] * rs * g[0] * (1.f + a[0]) + b[0], v[q][1] * rs * g[1] * (1.f + a[1]) + b[1]);
        o[1] = cvt_pk_bf16(v[q][2] * rs * g[2] * (1.f + a[2]) + b[2], v[q][3] * rs * g[3] * (1.f + a[3]) + b[3]);
        *(u32x2*)(dst + c) = o; }
}
__device__ __forceinline__ void p1_norm0(CParams& P) {
    const int tid_ = otid(), lane = tid_ & 63, w = (obid() * NTH + tid_) >> 6, nw = gridDim.x * (NTH / 64);
    bf16_t* H = (bf16_t*)(P.ws + WS_H); const float* MOD = (const float*)(P.ws + WS_MOD);
    for (int t = w; t < T; t += nw) {
        const float* src = t < TL ? P.in[I_X] + (size_t)t * 1024 : P.in[I_CTX] + (size_t)(t - TL) * 1024;
        f32x4 v[4];
#pragma unroll
        for (int q = 0; q < 4; ++q) v[q] = *(const f32x4*)(src + q * 256 + lane * 4);
        const float* md = MOD + (size_t)tok_modj(t) * 6144;
        norm_row_store(v, P.in[I_NMIX], md + 1024, md, H + (size_t)t * 1024, lane);
    }
}

#ifndef EXP_P3
#define EXP_P3 0
#endif
struct TileGeo { int tok0, b, pos0, slen, isctx; };
__device__ __forceinline__ TileGeo tile_geo(int tt) {
    TileGeo g; g.tok0 = tt * 64;
    if (g.tok0 < TL) { g.isctx = 0; g.b = g.tok0 >> 12; g.pos0 = g.tok0 & 4095; g.slen = 4096; }
    else { g.isctx = 1; const int r = g.tok0 - TL; g.b = r >> 8; g.pos0 = r & 255; g.slen = 256; }
    return g;
}
__device__ __forceinline__ void unpack4(u32x2 u, float (&o)[4]) { o[0] = bflo(u[0]); o[1] = bfhi(u[0]); o[2] = bflo(u[1]); o[3] = bfhi(u[1]); }
__device__ __forceinline__ void unpack8(u32x4 u, float (&o)[8]) {
#pragma unroll
    for (int e = 0; e < 4; ++e) { o[2 * e] = bflo(u[e]); o[2 * e + 1] = bfhi(u[e]); } }

__device__ __forceinline__ void p3_prep(CParams& P, unsigned char* smem, int l) {
    const int G = gridDim.x, tid = otid(), bid = obid();
    unsigned char* ws = P.ws;
    const bf16_t* PJ = (const bf16_t*)(ws + WS_PJ);
    if (!(EXP_P3 & 1)) {
        bf16_t* vvL = (bf16_t*)smem;
        const int c4 = tid & 63, tq = tid >> 6;
        const float* cw = P.in[I_HCW] + (size_t)l * 3 * 768; const float* cb = P.in[I_HCB] + (size_t)l * 768;
        float wx[3][4], wv[3][4], bx[4], bv[4];
#pragma unroll
        for (int e = 0; e < 4; ++e) { bx[e] = cb[256 + 4 * c4 + e]; bv[e] = cb[512 + 4 * c4 + e];
#pragma unroll
            for (int k = 0; k < 3; ++k) { wx[k][e] = cw[k * 768 + 256 + 4 * c4 + e]; wv[k][e] = cw[k * 768 + 512 + 4 * c4 + e]; } }
        u32x2 xq[10], vq[10]; bool okq[10];
#define P3A_REQ(ttx) do { const TileGeo g_ = tile_geo(ttx); const int p0_ = g_.pos0 + tq * 8; const bf16_t* rowp_ = PJ + (size_t)(g_.tok0 + tq * 8) * PJW; \
            _Pragma("unroll") for (int j = 0; j < 10; ++j) { const int pp = p0_ + j - 1; okq[j] = (pp >= 0 && pp < g_.slen); const bf16_t* rp = rowp_ + (ptrdiff_t)(okq[j] ? j - 1 : 0) * PJW; \
                xq[j] = *(const u32x2*)(rp + 256 + 4 * c4); vq[j] = *(const u32x2*)(rp + 512 + 4 * c4); } } while (0)
        int tt = bid;
        if (tt < T / 64) P3A_REQ(tt);
#pragma unroll 1
        for (; tt < T / 64; tt += G) {
            const TileGeo g = tile_geo(tt);
            float rx[3][4], rv[3][4], vva[8][4];
#define P3A_ROW(k, j) do { unpack4(xq[j], rx[k]); unpack4(vq[j], rv[k]); _Pragma("unroll") for (int e = 0; e < 4; ++e) { rx[k][e] = okq[j] ? rx[k][e] : 0.f; rv[k][e] = okq[j] ? rv[k][e] : 0.f; } } while (0)
            P3A_ROW(0, 0); P3A_ROW(1, 1);
#pragma unroll
            for (int j = 0; j < 8; ++j) {
                P3A_ROW(2, j + 2);
#pragma unroll
                for (int e = 0; e < 4; ++e) {
                    const float x2 = wx[0][e] * rx[0][e] + wx[1][e] * rx[1][e] + wx[2][e] * rx[2][e] + bx[e];
                    const float vv = wv[0][e] * rv[0][e] + wv[1][e] * rv[1][e] + wv[2][e] * rv[2][e] + bv[e];
                    vva[j][e] = x2 * vv;
                    rx[0][e] = rx[1][e]; rx[1][e] = rx[2][e]; rv[0][e] = rv[1][e]; rv[1][e] = rv[2][e]; }
            }
#undef P3A_ROW
#pragma unroll
            for (int e = 0; e < 4; ++e) { u32x4 o4;
#pragma unroll
                for (int p = 0; p < 4; ++p) o4[p] = cvt_pk_bf16(vva[2 * p][e], vva[2 * p + 1][e]);
                *(u32x4*)(vvL + (4 * c4 + e) * 72 + ((tq + (c4 & 7)) & 7) * 8) = o4; }
            if (tt + G < T / 64) P3A_REQ(tt + G);
            __syncthreads();
            { const int c = tid >> 1, hf = tid & 1;
              bf16_t* d = g.isctx ? (bf16_t*)(ws + WS_VVTC) + ((size_t)g.b * 256 + c) * 256 + g.pos0 + hf * 32
                                  : (bf16_t*)(ws + WS_VVT) + ((size_t)g.b * 256 + c) * 4096 + g.pos0 + hf * 32;
#pragma unroll
              for (int q = 0; q < 4; ++q) *(u32x4*)(d + q * 8) = *(const u32x4*)(vvL + c * 72 + (((hf * 4 + q) + ((c >> 2) & 7)) & 7) * 8); }
            __syncthreads();
        }
#undef P3A_REQ
    }
    if (!(EXP_P3 & 2)) {
        bf16_t* YC = (bf16_t*)(ws + WS_YC);
        const int c8 = tid & 31, ts = tid >> 5;
        const int gi = c8 >> 3, hw = 1 << gi;
        for (int tt = (bid + 85) % G; tt < T / 64; tt += G) {
            const TileGeo g = tile_geo(tt);
            const int rlen = g.isctx ? 256 : 64;
            const int tl0 = ts * 4, rpos0 = (g.pos0 + tl0) % rlen;
            const bf16_t* base = PJ + (size_t)(g.tok0 + tl0 - rpos0) * PJW + 768 + 8 * c8;
            float sm4[4][8], self[4][8];
#pragma unroll
            for (int q = 0; q < 4; ++q)
#pragma unroll
                for (int e = 0; e < 8; ++e) sm4[q][e] = 0.f;
            u32x4 rw[19];
#pragma unroll
            for (int dj = -8; dj < 11; ++dj) { int j = rpos0 + dj; j = j < 0 ? 0 : (j >= rlen ? rlen - 1 : j); rw[dj + 8] = *(const u32x4*)(base + (size_t)j * PJW); }
#pragma unroll
            for (int dj = -8; dj < 11; ++dj) {
                const int j = rpos0 + dj; const bool inrow = (j >= 0 && j < rlen);
                float v[8]; unpack8(rw[dj + 8], v);
#pragma unroll
                for (int q = 0; q < 4; ++q) {
                    const bool inw = inrow && dj >= q - hw && dj < q + hw;
#pragma unroll
                    for (int e = 0; e < 8; ++e) sm4[q][e] += inw ? v[e] : 0.f;
                    if (dj == q) {
#pragma unroll
                        for (int e = 0; e < 8; ++e) self[q][e] = v[e]; } }
            }
#pragma unroll
            for (int q = 0; q < 4; ++q) {
                const int rpos = rpos0 + q; int lo = rpos - hw; lo = lo < 0 ? 0 : lo; int hi = rpos + hw; hi = hi > rlen ? rlen : hi;
                const float inv = 1.f / (float)(hi - lo);
                u32x4 o;
#pragma unroll
                for (int e = 0; e < 4; ++e) o[e] = cvt_pk_bf16(sm4[q][2 * e] * inv - self[q][2 * e], sm4[q][2 * e + 1] * inv - self[q][2 * e + 1]);
                *(u32x4*)(YC + (size_t)(g.tok0 + tl0 + q) * YCW + 768 + 8 * c8) = o;
            }
        }
    }
    if (!(EXP_P3 & 4)) {
        bf16_t* xsL = (bf16_t*)smem;
        bf16_t* XBN = (bf16_t*)(ws + WS_XBN);
        const int c8 = tid & 127, tq = tid >> 7;
        const float* cw = P.in[I_SCW] + (size_t)l * 3 * 1024; const float* cb = P.in[I_SCB] + (size_t)l * 1024;
        float w[3][8], bb[8];
#pragma unroll
        for (int e = 0; e < 8; ++e) { bb[e] = cb[8 * c8 + e];
#pragma unroll
            for (int k = 0; k < 3; ++k) w[k][e] = cw[k * 1024 + 8 * c8 + e]; }
        u32x4 rw[18]; bool okr[18];
#define P3C_REQ(ttx) do { const TileGeo g_ = tile_geo(ttx); const int p0_ = g_.pos0 + tq * 16; const bf16_t* rowp_ = PJ + (size_t)(g_.tok0 + tq * 16) * PJW + 1536 + 8 * c8; \
            _Pragma("unroll") for (int j = 0; j < 18; ++j) { const int pp = p0_ + j - 1; okr[j] = (pp >= 0 && pp < g_.slen); rw[j] = *(const u32x4*)(rowp_ + (ptrdiff_t)(okr[j] ? j - 1 : 0) * PJW); } } while (0)
        int tt = (bid + 170) % G;
        if (tt < T / 64) P3C_REQ(tt);
#pragma unroll 1
        for (; tt < T / 64; tt += G) {
            const TileGeo g = tile_geo(tt);
            float r0[8], r1[8], r2[8]; u32x4 oall[16];
            unpack8(rw[0], r0); unpack8(rw[1], r1);
#pragma unroll
            for (int e = 0; e < 8; ++e) { r0[e] = okr[0] ? r0[e] : 0.f; r1[e] = okr[1] ? r1[e] : 0.f; }
#pragma unroll
            for (int j = 0; j < 16; ++j) {
                unpack8(rw[j + 2], r2);
#pragma unroll
                for (int e = 0; e < 8; ++e) r2[e] = okr[j + 2] ? r2[e] : 0.f;
                float o[8];
#pragma unroll
                for (int e = 0; e < 8; ++e) { o[e] = fsilu(w[0][e] * r0[e] + w[1][e] * r1[e] + w[2][e] * r2[e] + bb[e]); r0[e] = r1[e]; r1[e] = r2[e]; }
                u32x4 ov;
#pragma unroll
                for (int e = 0; e < 4; ++e) ov[e] = cvt_pk_bf16(o[2 * e], o[2 * e + 1]);
                *(u32x4*)(XBN + (size_t)(g.tok0 + tq * 16 + j) * 1024 + 8 * c8) = ov;
                oall[j] = ov;
            }
            if (c8 < 96) {
#pragma unroll
                for (int e = 0; e < 8; ++e) { u32x4 lo4, hi4;
#pragma unroll
                    for (int p = 0; p < 4; ++p) {
                        lo4[p] = __builtin_amdgcn_perm(oall[2 * p + 1][e >> 1], oall[2 * p][e >> 1], (e & 1) ? 0x07060302u : 0x05040100u);
                        hi4[p] = __builtin_amdgcn_perm(oall[2 * p + 9][e >> 1], oall[2 * p + 8][e >> 1], (e & 1) ? 0x07060302u : 0x05040100u); }
                    bf16_t* rowb = xsL + (8 * c8 + e) * 72; const int rot = c8 & 7;
                    *(u32x4*)(rowb + (((tq * 2) + rot) & 7) * 8) = lo4; *(u32x4*)(rowb + (((tq * 2 + 1) + rot) & 7) * 8) = hi4; }
            }
            if (tt + G < T / 64) P3C_REQ(tt + G);
            __syncthreads();
            for (int ch = tid; ch < 768 * 8; ch += NTH) { const int c = ch >> 3, q = ch & 7;
                bf16_t* d = g.isctx ? (bf16_t*)(ws + WS_XSTC) + ((size_t)g.b * 768 + c) * 256 + g.pos0 + q * 8
                                    : (bf16_t*)(ws + WS_XST) + ((size_t)g.b * 768 + c) * 4096 + g.pos0 + q * 8;
                *(u32x4*)d = *(const u32x4*)(xsL + c * 72 + ((q + ((c >> 3) & 7)) & 7) * 8); }
            __syncthreads();
        }
#undef P3C_REQ
        const float* dtr = (const float*)(ws + WS_DTR); float* dt = (float*)(ws + WS_DT);
        for (int e = bid * NTH + tid; e < T * 16; e += G * NTH) dt[e] = fsoftplus(dtr[e] + P.in[I_SDTB][l * 16 + (e & 15)]);
    }
}

#define EPI_ROWS_BEGIN _Pragma("unroll") for (int ai = 0; ai < 2; ++ai) { _Pragma("unroll") for (int m = 0; m < 4; ++m) { const int rl = ai * 128 + wr * 64 + m * 16 + fr;
#define EPI_ROWS_END } }
#ifndef EXP_BR
#define EXP_BR 0
#endif
typedef f32x4 acc_t[2][2][4][2];
__device__ __forceinline__ u32x4 pack8(const f32x4& a, const f32x4& b) { u32x4 o; o[0] = cvt_pk_bf16(a[0], a[1]); o[1] = cvt_pk_bf16(a[2], a[3]); o[2] = cvt_pk_bf16(b[0], b[1]); o[3] = cvt_pk_bf16(b[2], b[3]); return o; }

struct Src1 {
    const char* H; const char* W1T; const char* WFT; int G, c;
    __device__ __forceinline__ bool get(int i, GUnit& u) const {
        const int L = i * G + c; constexpr int NU1 = (T / 256) * (N1 / 256);
        if (L < NU1) { int pm, pn; pg8::remap_tile(L, T / 256, N1 / 256, pm, pn);
            u.a0 = H + (size_t)pm * 256 * 2048; u.a1 = u.a0 + (size_t)128 * 2048; u.b0 = W1T + (size_t)pn * 256 * 2048; u.b1 = u.b0 + (size_t)128 * 2048;
            u.nt = 16; u.pm = pm; u.pn = pn; u.kind = pn < 16 ? 0 : (pn < 26 ? 1 : 2); u.gidx = nullptr; u.e = 0; return true; }
        const int j = L - NU1; if (j >= 2 * (T / 256)) return false;
        const int pm = j & 1, pn = j >> 1;
        u.a0 = WFT + (size_t)pm * 256 * 2048; u.a1 = u.a0 + (size_t)128 * 2048; u.b0 = H + (size_t)pn * 256 * 2048; u.b1 = u.b0 + (size_t)128 * 2048;
        u.nt = 16; u.pm = pm; u.pn = pn; u.kind = 3; u.gidx = nullptr; u.e = 0; return true;
    }
};
struct Epi1 {
    bf16_t* Gt; bf16_t* PJ; float* DTR; bf16_t* VT; bf16_t* VTC;
    __device__ __forceinline__ void operator()(const acc_t& acc, const GUnit& u, int wr, int wc, int fr, int fq) const {
        const int cl = wc * 32 + 8 * fq;
        if (u.kind == 0) {
            EPI_ROWS_BEGIN { bf16_t* rp = Gt + (size_t)(u.pm * 256 + rl) * 4096 + u.pn * 256 + cl;
#pragma unroll
                for (int bj = 0; bj < 2; ++bj) { f32x4 a = acc[ai][bj][m][0], b = acc[ai][bj][m][1];
#pragma unroll
                    for (int e = 0; e < 4; ++e) { a[e] = fsigmoid(a[e]); b[e] = fsigmoid(b[e]); }
                    *(u32x4*)(rp + bj * 128) = pack8(a, b); } } EPI_ROWS_END
        } else if (u.kind == 1) {
            EPI_ROWS_BEGIN { bf16_t* rp = PJ + (size_t)(u.pm * 256 + rl) * PJW + (u.pn - 16) * 256 + cl;
#pragma unroll
                for (int bj = 0; bj < 2; ++bj) *(u32x4*)(rp + bj * 128) = pack8(acc[ai][bj][m][0], acc[ai][bj][m][1]); } EPI_ROWS_END
        } else if (u.kind == 2) {
            if (wc == 0 && fq < 2) {
                EPI_ROWS_BEGIN { float* rp = DTR + (size_t)(u.pm * 256 + rl) * 16 + 8 * fq; *(f32x4*)rp = acc[ai][0][m][0]; *(f32x4*)(rp + 4) = acc[ai][0][m][1]; } EPI_ROWS_END
            }
        } else {
#pragma unroll
            for (int bj = 0; bj < 2; ++bj) {
                const int tok = u.pn * 256 + bj * 128 + cl;
                bf16_t* cb;
                if (tok < TL) { const int b = tok >> 12, p = tok & 4095; cb = VT + ((size_t)b * 256) * 8192 + p; }
                else { const int r = tok - TL, b = r >> 8, q = r & 255; cb = VTC + ((size_t)b * 256) * 8192 + q; }
                const int hoff = tok < TL ? 4096 : 256;
                EPI_ROWS_BEGIN { const int r = u.pm * 256 + rl, g = r >> 7, half = (r >> 6) & 1, cp = r & 63;
                    *(u32x4*)(cb + (size_t)(g * 64 + cp) * 8192 + half * hoff) = pack8(acc[ai][bj][m][0], acc[ai][bj][m][1]); } EPI_ROWS_END
            }
        }
    }
};

struct SrcDft {
    const char* D4C; const char* D4S; const char* D256; const char* VT; const char* VTC; int first, step;
    __device__ __forceinline__ bool get(int i, GUnit& u) const {
        const int L = first + i * step; u.gidx = nullptr; u.e = 0;
        if (L < 0 || L >= 136) return false;
        if (L < 128) { const int sc = L >> 6, r = L & 63, pm = r & 7, pn = r >> 3;
            u.a0 = (sc ? D4S : D4C) + (size_t)pm * 256 * 8192; u.a1 = u.a0 + (size_t)128 * 8192;
            u.b0 = VT + (size_t)pn * 256 * 16384 + (size_t)sc * 8192; u.b1 = u.b0 + (size_t)128 * 16384;
            u.nt = 64; u.pm = pm; u.pn = pn; u.kind = sc; return true; }
        const int pn = L - 128;
        u.a0 = D256; u.a1 = u.a0 + (size_t)128 * 8192; u.b0 = VTC + (size_t)pn * 256 * 16384; u.b1 = u.b0 + (size_t)128 * 16384;
        u.nt = 8; u.pm = 0; u.pn = pn; u.kind = 2; return true;
    }
};
struct EpiDft {
    bf16_t* YC;
    __device__ __forceinline__ void operator()(const acc_t& acc, const GUnit& u, int wr, int wc, int fr, int fq) const {
        const int cl = wc * 32 + 8 * fq;
        if (u.kind == 2) {
            EPI_ROWS_BEGIN { bf16_t* rp = YC + (size_t)(TL + u.pn * 256 + rl) * YCW + cl;
#pragma unroll
                for (int bj = 0; bj < 2; ++bj) { const u32x4 o = pack8(acc[ai][bj][m][0] * 0.5f, acc[ai][bj][m][1] * 0.5f); *(u32x4*)(rp + bj * 128) = o; *(u32x4*)(rp + 256 + bj * 128) = o; } } EPI_ROWS_END
        } else {
            const int coff = u.kind == 1 ? 256 : 0; const float msign = u.kind == 1 ? -1.f : 1.f;
            EPI_ROWS_BEGIN { const int pp = u.pm * 256 + rl;
                bf16_t* rp = YC + (size_t)(u.pn * 4096 + pp) * YCW + coff + cl;
                bf16_t* rm = YC + (size_t)(u.pn * 4096 + ((4096 - pp) & 4095)) * YCW + coff + cl;
#pragma unroll
                for (int bj = 0; bj < 2; ++bj) { *(u32x4*)(rp + bj * 128) = pack8(acc[ai][bj][m][0], acc[ai][bj][m][1]);
                    if (pp != 0) *(u32x4*)(rm + bj * 128) = pack8(acc[ai][bj][m][0] * msign, acc[ai][bj][m][1] * msign); } } EPI_ROWS_END
        }
    }
};
__device__ __forceinline__ void dft_nyquist(const bf16_t* VT, bf16_t* YC, int row0, int nrows) {
    const int tid = otid(), lane = tid & 63, w = tid >> 6;
    for (int vr = row0 + w; vr < row0 + nrows && vr < 2048; vr += NTH / 64) {
        const bf16_t* src = VT + (size_t)vr * 8192;
        float s = 0.f;
#pragma unroll
        for (int q = 0; q < 8; ++q) { float v[8]; unpack8(*(const u32x4*)(src + q * 512 + lane * 8), v);
            s += (v[0] - v[1]) + (v[2] - v[3]) + (v[4] - v[5]) + (v[6] - v[7]); }
        s = wave_sum(s) * (1.f / 64.f);
        if (lane == 0) { const int b = vr >> 8, gc = vr & 255; bf16_t* d = YC + (size_t)(b * 4096 + 2048) * YCW + gc; d[0] = f2bf(s); d[256] = (bf16_t)0; }
    }
}

struct SrcBr {
    const char* YC; const char* WBRT; int G, c, nM;
    __device__ __forceinline__ bool get(int i, GUnit& u) const {
        const int k = i & 3, L = (i >> 2) * G + c; if (L >= nM * 4) return false;
        int pm, pn; pg8::remap_tile(L, nM, 4, pm, pn);
        const int koff = k == 0 ? 0 : (k == 1 ? 512 : (k == 2 ? 768 : 1024));
        u.a0 = YC + ((size_t)pm * 256 * YCW + koff) * 2; u.a1 = u.a0 + (size_t)128 * YCW * 2;
        u.b0 = WBRT + ((size_t)pn * 256 * YCW + koff) * 2; u.b1 = u.b0 + (size_t)128 * YCW * 2;
        u.nt = (k == 0 || k == 3) ? 8 : 4; u.pm = pm; u.pn = pn; u.kind = k; u.gidx = nullptr; u.e = 0; return true;
    }
};
struct EpiBr {
    const bf16_t* Gt; bf16_t* MG; const float* SSQ;
    __device__ __forceinline__ void operator()(const acc_t& acc, const GUnit& u, int wr, int wc, int fr, int fq) const {
        if (EXP_BR >= 2) return;
        const int cl = wc * 32 + 8 * fq, k = u.kind;
        const size_t row0 = (size_t)u.pm * 256 + wr * 64 + fr;
        const int colb = u.pn * 256 + cl;
        float rs[8];
#pragma unroll
        for (int i = 0; i < 8; ++i) rs[i] = 1.f;
        if (k == 3) {
            f32x4 s0[8], s1[8];
#pragma unroll
            for (int i = 0; i < 8; ++i) { const size_t row = row0 + (i >> 2) * 128 + (i & 3) * 16; s0[i] = *(const f32x4*)(SSQ + row * 8); s1[i] = *(const f32x4*)(SSQ + row * 8 + 4); }
#pragma unroll
            for (int i = 0; i < 8; ++i) rs[i] = rsqrtf((s0[i][0] + s0[i][1] + s0[i][2] + s0[i][3] + s1[i][0] + s1[i][1] + s1[i][2] + s1[i][3]) * (1.f / 512.f) + EPSN);
        }
#pragma unroll
        for (int ai = 0; ai < 2; ++ai) {
            u32x4 gv[4][2], mv[4][2];
#pragma unroll
            for (int m = 0; m < 4; ++m)
#pragma unroll
                for (int bj = 0; bj < 2; ++bj) { const size_t row = row0 + ai * 128 + m * 16;
                    gv[m][bj] = EXP_BR >= 1 ? (u32x4){0x3f803f80u, 0x3f803f80u, 0x3f803f80u, 0x3f803f80u} : *(const u32x4*)(Gt + row * 4096 + k * 1024 + colb + bj * 128);
                    mv[m][bj] = (k == 0 || EXP_BR >= 1) ? (u32x4){0u, 0u, 0u, 0u} : *(const u32x4*)(MG + row * 1024 + colb + bj * 128); }
#pragma unroll
            for (int m = 0; m < 4; ++m)
#pragma unroll
                for (int bj = 0; bj < 2; ++bj) { const size_t row = row0 + ai * 128 + m * 16;
                    float gt[8], mg[8]; unpack8(gv[m][bj], gt); unpack8(mv[m][bj], mg);
                    f32x4 a = acc[ai][bj][m][0], b = acc[ai][bj][m][1]; const float r = rs[ai * 4 + m];
#pragma unroll
                    for (int e = 0; e < 4; ++e) { a[e] = mg[e] + gt[e] * a[e] * r; b[e] = mg[4 + e] + gt[4 + e] * b[e] * r; }
                    *(u32x4*)(MG + row * 1024 + colb + bj * 128) = pack8(a, b); }
        }
    }
};

struct SrcOut {
    const char* MG; const char* WOUTT; int G, c, nM;
    __device__ __forceinline__ bool get(int i, GUnit& u) const {
        const int L = i * G + c; if (L >= nM * 4) return false;
        int pm, pn; pg8::remap_tile(L, nM, 4, pm, pn);
        u.a0 = MG + (size_t)pm * 256 * 2048; u.a1 = u.a0 + (size_t)128 * 2048; u.b0 = WOUTT + (size_t)pn * 256 * 2048; u.b1 = u.b0 + (size_t)128 * 2048;
        u.nt = 16; u.pm = pm; u.pn = pn; u.kind = 0; u.gidx = nullptr; u.e = 0; return true;
    }
};
template <bool F32IN> struct EpiOut {
    const void* xlat; const void* xctx; bf16_t* X1; const float* MODL;
    __device__ __forceinline__ void operator()(const acc_t& acc, const GUnit& u, int wr, int wc, int fr, int fq) const {
        const int cl = wc * 32 + 8 * fq;
        const int mj = u.pm < TL / 256 ? (u.pm >> 4) : 8;
        const size_t xoff = u.pm < TL / 256 ? (size_t)u.pm * 256 * 1024 : (size_t)(u.pm - TL / 256) * 256 * 1024;
        const void* xb = u.pm < TL / 256 ? xlat : xctx;
        const float* g1 = MODL + (size_t)mj * 6144 + 2048 + u.pn * 256 + cl;
        f32x4 gv[2][2];
#pragma unroll
        for (int bj = 0; bj < 2; ++bj) { gv[bj][0] = *(const f32x4*)(g1 + bj * 128); gv[bj][1] = *(const f32x4*)(g1 + bj * 128 + 4); }
#pragma unroll
        for (int ai = 0; ai < 2; ++ai) {
            f32x4 xv[4][2][2];
#pragma unroll
            for (int m = 0; m < 4; ++m)
#pragma unroll
                for (int bj = 0; bj < 2; ++bj) { const size_t o = xoff + (size_t)(ai * 128 + wr * 64 + m * 16 + fr) * 1024 + u.pn * 256 + cl + bj * 128;
                    if constexpr (F32IN) { const float* xr = (const float*)xb + o; xv[m][bj][0] = *(const f32x4*)xr; xv[m][bj][1] = *(const f32x4*)(xr + 4); }
                    else { float t[8]; unpack8(*(const u32x4*)((const bf16_t*)xb + o), t); xv[m][bj][0] = (f32x4){t[0], t[1], t[2], t[3]}; xv[m][bj][1] = (f32x4){t[4], t[5], t[6], t[7]}; } }
#pragma unroll
            for (int m = 0; m < 4; ++m)
#pragma unroll
                for (int bj = 0; bj < 2; ++bj) { bf16_t* orow = X1 + ((size_t)u.pm * 256 + ai * 128 + wr * 64 + m * 16 + fr) * 1024 + u.pn * 256 + cl + bj * 128;
                    *(u32x4*)orow = pack8(xv[m][bj][0] + gv[bj][0] * acc[ai][bj][m][0], xv[m][bj][1] + gv[bj][1] * acc[ai][bj][m][1]); }
        }
    }
};

struct SrcUp {
    const char* H2; const char* WUPT; const int* rtok; const int* meta; int G, c;
    __device__ __forceinline__ bool get(int i, GUnit& u) const {
        const int nu = meta[33]; int ru, j;
        if (G == 256) {
            const int x = c & 7, y = c >> 3; ru = i * 32 + (x >> 1) * 8 + (y & 7); j = (x & 1) * 4 + (y >> 3);
            if (i * 32 >= nu) return false;
            if (ru >= nu) { ru = nu - 1; j = -1; }
        } else { const int L = i * G + c; if (L >= nu * 8) return false; ru = L >> 3; j = L & 7; }
        if (j < 0) return false;
        int e = 0;
#pragma unroll
        for (int s = 16; s > 0; s >>= 1) if (meta[e + s] <= ru) e += s;
        u.a0 = H2; u.a1 = H2; u.gidx = rtok + (size_t)ru * 256;
        u.b0 = WUPT + ((size_t)e * 2048 + j * 128) * 2048; u.b1 = u.b0 + (size_t)1024 * 2048;
        u.nt = 16; u.pm = ru; u.pn = j; u.kind = 0; u.e = e; return true;
    }
};
struct EpiUp {
    bf16_t* ACT; const float* BUP;
    __device__ __forceinline__ void operator()(const acc_t& acc, const GUnit& u, int wr, int wc, int fr, int fq) const {
        const int cl = wc * 32 + 8 * fq, col = u.pn * 128 + cl;
        const float* bp = BUP + (size_t)u.e * 2048 + col;
        const f32x4 bg0 = *(const f32x4*)bp, bg1 = *(const f32x4*)(bp + 4), bl0 = *(const f32x4*)(bp + 1024), bl1 = *(const f32x4*)(bp + 1028);
        EPI_ROWS_BEGIN { f32x4 g0 = acc[ai][0][m][0] + bg0, g1 = acc[ai][0][m][1] + bg1, l0 = acc[ai][1][m][0] + bl0, l1 = acc[ai][1][m][1] + bl1;
#pragma unroll
            for (int e = 0; e < 4; ++e) {
                float a = fminf(g0[e], 7.f), b = fminf(fmaxf(l0[e], -7.f), 7.f); g0[e] = a * fsigmoid(1.702f * a) * (b + 1.f);
                a = fminf(g1[e], 7.f); b = fminf(fmaxf(l1[e], -7.f), 7.f); g1[e] = a * fsigmoid(1.702f * a) * (b + 1.f); }
            *(u32x4*)(ACT + ((size_t)u.pm * 256 + rl) * 1024 + col) = pack8(g0, g1); } EPI_ROWS_END
    }
};
struct SrcDn {
    const char* ACT; const char* WDNT; const int* meta; int G, c;
    __device__ __forceinline__ bool get(int i, GUnit& u) const {
        const int nu = meta[33]; int ru, j;
        if (G == 256) {
            const int x = c & 7, y = c >> 3; ru = i * 64 + x * 8 + (y & 7); j = y >> 3;
            if (i * 64 >= nu || ru >= nu) return false;
        } else { const int L = i * G + c; if (L >= nu * 4) return false; ru = L >> 2; j = L & 3; }
        int e = 0;
#pragma unroll
        for (int s = 16; s > 0; s >>= 1) if (meta[e + s] <= ru) e += s;
        u.a0 = ACT + (size_t)ru * 256 * 2048; u.a1 = u.a0 + (size_t)128 * 2048;
        u.b0 = WDNT + ((size_t)e * 1024 + j * 256) * 2048; u.b1 = u.b0 + (size_t)128 * 2048;
        u.nt = 16; u.pm = ru; u.pn = j; u.kind = 0; u.e = e; u.gidx = nullptr; return true;
    }
};
struct EpiDn {
    bf16_t* YP; const float* BDN; const int* rpair; const float* rw;
    __device__ __forceinline__ void operator()(const acc_t& acc, const GUnit& u, int wr, int wc, int fr, int fq) const {
        const int cl = wc * 32 + 8 * fq;
        const float* bp = BDN + (size_t)u.e * 1024 + u.pn * 256 + cl;
        f32x4 bv[2][2];
#pragma unroll
        for (int bj = 0; bj < 2; ++bj) { bv[bj][0] = *(const f32x4*)(bp + bj * 128); bv[bj][1] = *(const f32x4*)(bp + bj * 128 + 4); }
        int pr[8]; float wv[8];
#pragma unroll
        for (int i = 0; i < 8; ++i) { const int prow = u.pm * 256 + (i >> 2) * 128 + wr * 64 + (i & 3) * 16 + fr; pr[i] = rpair[prow]; wv[i] = rw[prow]; }
#pragma unroll
        for (int ai = 0; ai < 2; ++ai)
#pragma unroll
            for (int m = 0; m < 4; ++m) { const int pair = pr[ai * 4 + m];
                if (pair >= 0) { const float w = wv[ai * 4 + m]; bf16_t* op = YP + (size_t)pair * 1024 + u.pn * 256 + cl;
#pragma unroll
                    for (int bj = 0; bj < 2; ++bj) *(u32x4*)(op + bj * 128) = pack8((acc[ai][bj][m][0] + bv[bj][0]) * w, (acc[ai][bj][m][1] + bv[bj][1]) * w); } }
    }
};

constexpr int HY_FC = 0, HY_VI = 65536, HY_VRS = 8512, HY_YRS = 4116;
__device__ __forceinline__ void hyena_conv_channel(CParams& P, unsigned char* smem, LAS unsigned char* lds, int l, int c) {
    const int tid = otid(), lane = tid & 63, wid = __builtin_amdgcn_readfirstlane(tid >> 6);
    unsigned char* ws = P.ws;
    const float* KT = (const float*)(ws + WS_KRAW) + (size_t)l * 2 * 512 * 4096;
    const float* KPART = (const float*)(ws + WS_KPART) + (size_t)l * 2 * 64 * 512;
    {
        __syncthreads();
        float* red = (float*)(smem + 140000);
        if (tid < 64) { float s = KPART[(size_t)tid * 512 + c] + KPART[(size_t)tid * 512 + 256 + c]; s = wave_sum(s); if (tid == 0) red[0] = 1.f / s; }
        const f32x4 f0 = *(const f32x4*)(KT + (size_t)c * 4096 + tid * 8), f1 = *(const f32x4*)(KT + (size_t)c * 4096 + tid * 8 + 4);
        const f32x4 g0 = *(const f32x4*)(KT + (size_t)(256 + c) * 4096 + tid * 8), g1 = *(const f32x4*)(KT + (size_t)(256 + c) * 4096 + tid * 8 + 4);
        {
            if (tid < 4) ((unsigned*)(smem + HY_VI + 8 * HY_VRS))[tid] = 0u;
            const bf16_t* vsrc = (const bf16_t*)(ws + WS_VVT) + (size_t)c * 4096;
#pragma unroll
            for (int q = 0; q < 8; ++q) { const int ch = tid + q * NTH, b = ch >> 9, s = (ch & 511) * 8;
                *(u32x4*)(smem + HY_VI + b * HY_VRS + s * 2 + 16 * (s >> 8)) = *(const u32x4*)(vsrc + (size_t)b * 256 * 4096 + s); }
        }
        __syncthreads();
        const float inv = red[0];
        bf16_t* fc = (bf16_t*)(smem + HY_FC);
        const float fw[8] = {f0[0], f0[1], f0[2], f0[3], f1[0], f1[1], f1[2], f1[3]}, bw[8] = {g0[0], g0[1], g0[2], g0[3], g1[0], g1[1], g1[2], g1[3]};
#pragma unroll
        for (int e = 0; e < 8; ++e) { const int lag = tid * 8 + e; const bf16_t fv = f2bf(fw[e] * inv), bv = f2bf(bw[e] * inv);
#pragma unroll
            for (int q = 0; q < 4; ++q) { fc[q * 8192 + q + 4096 - lag] = fv;
                const int ib = q + 4096 + lag; if (lag >= 1 && ib < 8192) fc[q * 8192 + ib] = bv; } }
        if (tid < 4) { for (int i = 0; i <= tid; ++i) fc[tid * 8192 + i] = (bf16_t)0; }
        __syncthreads();
        {
            const int t0 = wid, q = t0 & 3, a = t0 >> 2, rho = lane & 31, h = lane >> 5, col = lane & 31, b = col >> 2, i = col & 3;
            f32x16 acc[4];
#pragma unroll
            for (int ct = 0; ct < 4; ++ct)
#pragma unroll
                for (int e = 0; e < 16; ++e) acc[ct][e] = 0.f;
            const LAS unsigned char* fq_ = lds + HY_FC + q * 16384;
            const LAS unsigned char* vi = lds + HY_VI + b * HY_VRS;
            const int ebase = 4096 - 8 * (rho - h) - 4 * a;
            const int sb0 = 256 * i + 8 * h;
#define HY_LDA(dl_) __builtin_shufflevector(*(const LAS bf16x4*)(fq_ + 2 * (ebase - (dl_))), *(const LAS bf16x4*)(fq_ + 2 * (ebase - (dl_)) + 8), 0, 1, 2, 3, 4, 5, 6, 7)
#define HY_LDB(dst, dl_, ct) do { const int s_ = 1024 * (ct) + sb0 - (dl_); const bool ok_ = (unsigned)s_ < 4096u; \
                dst = *(const LAS bf16x8*)(ok_ ? vi + s_ * 2 + 16 * (s_ >> 8) : zchunk); } while (0)
#define HY_VALID(dl_, ct) ((dl_) >= 1024 * (ct) - 4080 && (dl_) <= 1024 * (ct) + 768)
#define HY_LOADS(AF, BF, dl_, MASK) do { AF = HY_LDA(dl_); _Pragma("unroll") for (int ct = 0; ct < 4; ++ct) if ((MASK >> ct) & 1) HY_LDB(BF[ct], dl_, ct); } while (0)
#define HY_MMAS(AF, BF, MASK) do { _Pragma("unroll") for (int ct = 0; ct < 4; ++ct) if ((MASK >> ct) & 1) acc[ct] = __builtin_amdgcn_mfma_f32_32x32x16_bf16(AF, BF[ct], acc[ct], 0, 0, 0); } while (0)
#define HY_SEGMENT(LO, HI, MASK) do { HY_LOADS(a0, b0, LO, MASK); HY_LOADS(a1, b1, (LO) + 16, MASK); _Pragma("unroll 1") for (int dl = (LO); dl <= (HI); dl += 64) { \
                HY_LOADS(a2, b2, dl + 32, MASK); HY_LOADS(a3, b3, dl + 48, MASK); HY_MMAS(a0, b0, MASK); HY_MMAS(a1, b1, MASK); \
                if (dl + 64 <= (HI)) { HY_LOADS(a0, b0, dl + 64, MASK); HY_LOADS(a1, b1, dl + 80, MASK); } HY_MMAS(a2, b2, MASK); HY_MMAS(a3, b3, MASK); } } while (0)
            const LAS unsigned char* zchunk = lds + HY_VI + 8 * HY_VRS;
            bf16x8 a0, a1, a2, a3, b0[4], b1[4], b2[4], b3[4];
#pragma unroll
            for (int ct = 0; ct < 4; ++ct) { b0[ct] = (bf16x8){0, 0, 0, 0, 0, 0, 0, 0}; b1[ct] = b0[ct]; b2[ct] = b0[ct]; b3[ct] = b0[ct]; }
            HY_SEGMENT(-4080, -3072, 1); HY_SEGMENT(-3056, -2048, 3); HY_SEGMENT(-2032, -1024, 7); HY_SEGMENT(-1008, 768, 15);
            HY_SEGMENT(784, 1792, 14); HY_SEGMENT(1808, 2816, 12); HY_SEGMENT(2832, 3840, 8);
#undef HY_LOADS
#undef HY_MMAS
#undef HY_SEGMENT
#undef HY_LDA
#undef HY_LDB
#undef HY_VALID
            __syncthreads();
            float* Y = (float*)smem;
#pragma unroll
            for (int ct = 0; ct < 4; ++ct)
#pragma unroll
                for (int r = 0; r < 16; ++r) { const int rr = (r & 3) + 8 * (r >> 2) + 4 * h; const int t = 1024 * ct + 256 * i + t0 + 8 * rr;
                    Y[b * HY_YRS + t + (t >> 8)] = acc[ct][r]; }
        }
        __syncthreads();
        {
            const float* Y = (const float*)smem; bf16_t* dst = (bf16_t*)(ws + WS_CVT) + (size_t)c * 4096; const int tid2 = otid();
#pragma unroll 2
            for (int q = 0; q < 8; ++q) { const int ch = tid2 + q * NTH, b = ch >> 9, t = (ch & 511) * 8; const float* yp = Y + b * HY_YRS + t + (t >> 8);
                u32x4 ov; ov[0] = cvt_pk_bf16(yp[0], yp[1]); ov[1] = cvt_pk_bf16(yp[2], yp[3]); ov[2] = cvt_pk_bf16(yp[4], yp[5]); ov[3] = cvt_pk_bf16(yp[6], yp[7]);
                *(u32x4*)(dst + (size_t)b * 256 * 4096 + t) = ov; }
        }
        __syncthreads();
        {
            float* fl = (float*)smem;
            float* vc = fl + 520;
            const float* KT1 = KT + (size_t)512 * 4096; const float* KP1 = KPART + (size_t)64 * 512;
            if (tid < 64) { float s = tid < 4 ? KP1[(size_t)tid * 512 + c] + KP1[(size_t)tid * 512 + 256 + c] : 0.f; s = wave_sum(s); if (tid == 0) red[0] = 1.f / s; }
            { const int lag = tid - 256; float v; if (lag <= -256) v = 0.f; else if (lag >= 0) v = KT1[(size_t)c * 4096 + lag]; else v = KT1[(size_t)(256 + c) * 4096 - lag]; fl[tid + 3] = v; }
            if (tid < 3) { fl[tid] = 0.f; fl[515 + tid] = 0.f; }
            for (int e = tid; e < 2048; e += NTH) { const int b = e >> 8, s = e & 255; vc[e + 8] = bf2f(((const bf16_t*)(ws + WS_VVTC))[((size_t)b * 256 + c) * 256 + s]); }
            __syncthreads();
            const float inv1 = red[0];
            const int b = tid >> 6, tl = tid & 63; float o[4] = {0.f, 0.f, 0.f, 0.f};
#pragma unroll 4
            for (int s4 = 0; s4 < 64; ++s4) {
                const f32x4 vv = *(const f32x4*)(vc + 8 + b * 256 + 4 * s4);
                const f32x4 t0 = *(const f32x4*)(fl + 4 * (tl - s4) + 256), t1 = *(const f32x4*)(fl + 4 * (tl - s4) + 260);
                const float tp[8] = {t0[0], t0[1], t0[2], t0[3], t1[0], t1[1], t1[2], t1[3]};
#pragma unroll
                for (int j = 0; j < 4; ++j)
#pragma unroll
                    for (int k = 0; k < 4; ++k) o[j] += tp[j - k + 3] * vv[k]; }
            *(f32x4*)((float*)(ws + WS_CVTC) + ((size_t)b * 256 + c) * 256 + 4 * tl) = (f32x4){o[0] * inv1, o[1] * inv1, o[2] * inv1, o[3] * inv1};
        }
    }
    __syncthreads();
}

__device__ __forceinline__ void hyena_finish(CParams& P, unsigned char* smem, int l, int tlo, int thi) {
    const int tid = otid();
    unsigned char* ws = P.ws;
    const bf16_t* PJ = (const bf16_t*)(ws + WS_PJ); bf16_t* YC = (bf16_t*)(ws + WS_YC);
    float* cvL = (float*)smem;
    const int c4 = tid & 63, tq = tid >> 6;
    const float* cw = P.in[I_HCW] + (size_t)l * 3 * 768; const float* cb = P.in[I_HCB] + (size_t)l * 768;
    float w1[3][4], wx[3][4], wv[3][4], b1[4], bx[4], bv[4], hb[4];
#pragma unroll
    for (int e = 0; e < 4; ++e) { b1[e] = cb[4 * c4 + e]; bx[e] = cb[256 + 4 * c4 + e]; bv[e] = cb[512 + 4 * c4 + e]; hb[e] = P.in[I_HBIAS][l * 256 + 4 * c4 + e];
#pragma unroll
        for (int k = 0; k < 3; ++k) { w1[k][e] = cw[k * 768 + 4 * c4 + e]; wx[k][e] = cw[k * 768 + 256 + 4 * c4 + e]; wv[k][e] = cw[k * 768 + 512 + 4 * c4 + e]; } }
#pragma unroll 1
    for (int tt = tlo; tt < thi; ++tt) {
        const TileGeo g = tile_geo(tt);
        __syncthreads();
        if (g.isctx) { const float* src = (const float*)(ws + WS_CVTC) + (size_t)g.b * 256 * 256 + g.pos0;
#pragma unroll
          for (int q = 0; q < 8; ++q) { const int ch = tid + q * NTH, c = ch >> 4, j = (ch & 15) * 4; const f32x4 v = *(const f32x4*)(src + (size_t)c * 256 + j);
              float* d = cvL + c * 68 + j; d[0] = v[0]; d[1] = v[1]; d[2] = v[2]; d[3] = v[3]; } }
        else { const bf16_t* src = (const bf16_t*)(ws + WS_CVT) + (size_t)g.b * 256 * 4096 + g.pos0;
          u32x4 v[4];
#pragma unroll
          for (int q = 0; q < 4; ++q) { const int ch = tid + q * NTH, c = ch >> 3, j = (ch & 7) * 8; v[q] = *(const u32x4*)(src + (size_t)c * 4096 + j); }
#pragma unroll
          for (int q = 0; q < 4; ++q) { const int ch = tid + q * NTH, c = ch >> 3, j = (ch & 7) * 8; float f[8]; unpack8(v[q], f);
              float* d = cvL + c * 68 + j;
#pragma unroll
              for (int e = 0; e < 8; ++e) d[e] = f[e]; } }
        __syncthreads();
        const int p0 = g.pos0 + tq * 8;
        const bf16_t* rowp = PJ + (size_t)(g.tok0 + tq * 8) * PJW;
        float r1[3][4], rx[3][4], rv[3][4];
#define LD_FROW(k, dp) do { const int pp = p0 + (dp); const bool ok_ = (pp >= 0 && pp < g.slen); const bf16_t* rp = rowp + (ptrdiff_t)(ok_ ? (dp) : 0) * PJW; \
            unpack4(*(const u32x2*)(rp + 4 * c4), r1[k]); unpack4(*(const u32x2*)(rp + 256 + 4 * c4), rx[k]); unpack4(*(const u32x2*)(rp + 512 + 4 * c4), rv[k]); \
            _Pragma("unroll") for (int e = 0; e < 4; ++e) { r1[k][e] = ok_ ? r1[k][e] : 0.f; rx[k][e] = ok_ ? rx[k][e] : 0.f; rv[k][e] = ok_ ? rv[k][e] : 0.f; } } while (0)
        LD_FROW(0, -1); LD_FROW(1, 0);
#pragma unroll
        for (int j = 0; j < 8; ++j) {
            LD_FROW(2, j + 1);
            float o[4];
#pragma unroll
            for (int e = 0; e < 4; ++e) {
                const float x1 = w1[0][e] * r1[0][e] + w1[1][e] * r1[1][e] + w1[2][e] * r1[2][e] + b1[e];
                const float x2 = wx[0][e] * rx[0][e] + wx[1][e] * rx[1][e] + wx[2][e] * rx[2][e] + bx[e];
                const float vv = wv[0][e] * rv[0][e] + wv[1][e] * rv[1][e] + wv[2][e] * rv[2][e] + bv[e];
                const float xv = x2 * vv;
                o[e] = x1 * (cvL[(4 * c4 + e) * 68 + tq * 8 + j] + xv * hb[e]);
                r1[0][e] = r1[1][e]; r1[1][e] = r1[2][e]; rx[0][e] = rx[1][e]; rx[1][e] = rx[2][e]; rv[0][e] = rv[1][e]; rv[1][e] = rv[2][e]; }
            u32x2 ov; ov[0] = cvt_pk_bf16(o[0], o[1]); ov[1] = cvt_pk_bf16(o[2], o[3]);
            *(u32x2*)(YC + (size_t)(g.tok0 + tq * 8 + j) * YCW + 512 + 4 * c4) = ov;
        }
#undef LD_FROW
    }
    __syncthreads();
}

constexpr int SS_LD = 136;
__device__ __forceinline__ int ssd_tokbase(int b, int cc) { return cc < 2 ? TL + b * 256 + cc * 128 : b * 4096 + (cc - 2) * 128; }
__device__ __forceinline__ const bf16_t* ssd_trow(const unsigned char* ws, int b, int cc, int row) {
    return cc < 2 ? (const bf16_t*)(ws + WS_XSTC) + ((size_t)b * 768 + row) * 256 + cc * 128 : (const bf16_t*)(ws + WS_XST) + ((size_t)b * 768 + row) * 4096 + (cc - 2) * 128;
}
__device__ __forceinline__ void ssd_dt_arrays(CParams& P, float* sm, int l, int b, int g, int cc, int un) {
    const int tid = otid(), lane = tid & 63, w = __builtin_amdgcn_readfirstlane(tid >> 6), dir = w >> 2, r = w & 3, c = dir * 8 + g * 4 + r;
    const float* DT = (const float*)(P.ws + WS_DT); const int tb = ssd_tokbase(b, cc);
    const float d0 = DT[(size_t)(tb + 2 * lane) * 16 + c], d1 = DT[(size_t)(tb + 2 * lane + 1) * 16 + c];
    const float a = -expf(P.in[I_SALOG][l * 16 + c]);
    const float v0 = d0 * a, v1 = d1 * a, p = v0 + v1;
    float inc = p;
#pragma unroll
    for (int d = 1; d < 64; d <<= 1) { const float y = __int_as_float(__builtin_amdgcn_ds_bpermute((lane - d) * 4, __float_as_int(inc))); inc += (lane >= d) ? y : 0.f; }
    const float E = inc - p, tot = __int_as_float(__builtin_amdgcn_readlane(__float_as_int(inc), 63));
    const float s0 = dir ? tot - E : E + v0, s1 = dir ? tot - E - v0 : inc;
    const int o = dir * 512 + (2 * lane) * 4 + r;
    sm[o] = d0; sm[o + 4] = d1; sm[1024 + o] = s0; sm[1024 + o + 4] = s1;
    float* ag = (float*)(P.ws + WS_ACSG) + (size_t)un * 1024; ag[o] = s0; ag[o + 4] = s1;
    { const float sref = dir ? s0 : s1;
      const float ref = __int_as_float(__builtin_amdgcn_ds_bpermute((dir ? (lane & ~7) : (lane | 7)) * 4, __float_as_int(sref)));
      f32x2 wl; wl[0] = d0 * __expf(ref - s0); wl[1] = d1 * __expf(ref - s1); *(f32x2*)(sm + 3072 + dir * 512 + r * 128 + 2 * lane) = wl; }
    { f32x2 wv; wv[0] = d0 * __expf(tot - s0); wv[1] = d1 * __expf(tot - s1); *(f32x2*)(sm + 2048 + dir * 512 + r * 128 + 2 * lane) = wv; }
}
#define SS_FRAG(base, row, k0) (*(const LAS bf16x8*)((base) + ((row) * SS_LD + (k0) + 8 * fq) * 2))

__device__ __forceinline__ void ssd_a_unit(CParams& P, unsigned char* smem, LAS unsigned char* lds, int l, int un) {
    const int tid = otid(), lane = tid & 63, w = __builtin_amdgcn_readfirstlane(tid >> 6), fr = lane & 15, fq = lane >> 4;
    unsigned char* ws = P.ws;
    constexpr int R0 = 0, R1 = 34816, R2 = 69632, R3 = 104448, RS = 121856;
    float* sm = (float*)(smem + RS); float* dtf = sm; float* dtb = sm + 512; float* acf = sm + 1024; float* acb = sm + 1536;
    const bf16_t* XBN = (const bf16_t*)(ws + WS_XBN);
    const int b = un / (2 * NCH), g = (un / NCH) & 1, cc = un % NCH, tb = ssd_tokbase(b, cc);
    __syncthreads();
    u32x4 cv[4], bv[4], tv[4], xv[2];
#pragma unroll
    for (int q = 0; q < 4; ++q) { const int ch = tid + q * NTH, row = ch >> 4, k8 = (ch & 15) * 8;
        cv[q] = *(const u32x4*)(XBN + (size_t)(tb + row) * 1024 + 768 + g * 128 + k8); bv[q] = *(const u32x4*)(XBN + (size_t)(tb + row) * 1024 + 512 + g * 128 + k8);
        tv[q] = *(const u32x4*)(ssd_trow(ws, b, cc, 512 + g * 128 + row) + k8); }
#pragma unroll
    for (int q = 0; q < 2; ++q) { const int ch = tid + q * NTH, row = ch >> 4, k8 = (ch & 15) * 8; xv[q] = *(const u32x4*)(ssd_trow(ws, b, cc, g * 256 + row) + k8); }
    ssd_dt_arrays(P, sm, l, b, g, cc, un);
#pragma unroll
    for (int q = 0; q < 4; ++q) { const int ch = tid + q * NTH, row = ch >> 4, k8 = (ch & 15) * 8;
        *(u32x4*)(smem + R0 + (row * SS_LD + k8) * 2) = cv[q]; *(u32x4*)(smem + R1 + (row * SS_LD + k8) * 2) = bv[q]; *(u32x4*)(smem + R2 + (row * SS_LD + k8) * 2) = tv[q]; }
    __syncthreads();
    f32x4 S[8];
#pragma unroll
    for (int nt = 0; nt < 8; ++nt) S[nt] = (f32x4){0.f, 0.f, 0.f, 0.f};
#pragma unroll
    for (int k0 = 0; k0 < 128; k0 += 32) { const bf16x8 af = SS_FRAG(lds + R0, 16 * w + fr, k0);
#pragma unroll
        for (int nt = 0; nt < 8; ++nt) S[nt] = __builtin_amdgcn_mfma_f32_16x16x32_bf16(SS_FRAG(lds + R1, 16 * nt + fr, k0), af, S[nt], 0, 0, 0); }
#pragma unroll 1
    for (int r = 0; r < 4; ++r) {
        __syncthreads();
#pragma unroll
        for (int q = 0; q < 2; ++q) { const int ch = tid + q * NTH, row = ch >> 4, k8 = (ch & 15) * 8; *(u32x4*)(smem + R3 + (row * SS_LD + k8) * 2) = xv[q]; }
        if (r < 3) {
#pragma unroll
            for (int q = 0; q < 2; ++q) { const int ch = tid + q * NTH, row = ch >> 4, k8 = (ch & 15) * 8; xv[q] = *(const u32x4*)(ssd_trow(ws, b, cc, g * 256 + (r + 1) * 64 + row) + k8); } }
        { const int i = 16 * w + fr; const float afi = acf[i * 4 + r], abi = acb[i * 4 + r], dfi = dtf[i * 4 + r];
#pragma unroll
          for (int nt = 0; nt < 8; ++nt) { float o[4];
              if (nt == w) {
#pragma unroll
                  for (int e = 0; e < 4; ++e) { const int j = 16 * nt + 4 * fq + e;
                      const bool fw = j < i; const float* ap = fw ? acf : acb; const float* dp = fw ? dtf : dtb;
                      float wgt = __expf((fw ? afi : abi) - ap[j * 4 + r]) * dp[j * 4 + r];
                      wgt += (j == i) ? dfi : 0.f;
                      o[e] = S[nt][e] * wgt; }
              } else {
                  const bool fw = nt < w;
                  const float E = __expf(fw ? afi - acf[(16 * nt + 15) * 4 + r] : abi - acb[(16 * nt) * 4 + r]);
                  const f32x4 wv = *(const f32x4*)(sm + 3072 + (fw ? 0 : 512) + r * 128 + 16 * nt + 4 * fq);
#pragma unroll
                  for (int e = 0; e < 4; ++e) o[e] = S[nt][e] * (E * wv[e]);
              }
              u32x2 ov; ov[0] = cvt_pk_bf16(o[0], o[1]); ov[1] = cvt_pk_bf16(o[2], o[3]);
              *(u32x2*)(smem + R0 + (i * SS_LD + 16 * nt + 4 * fq) * 2) = ov; } }
        __syncthreads();
        { const int p = tid >> 3, j0 = (tid & 7) * 16; const float* wf = sm + 2048 + r * 128 + j0; const float* wb = wf + 512;
#pragma unroll
          for (int h2 = 0; h2 < 2; ++h2) { float v[8]; unpack8(*(const u32x4*)(smem + R3 + (p * SS_LD + j0 + 8 * h2) * 2), v); u32x4 of, ob; float vf[8], vb[8];
              const f32x4 f0 = *(const f32x4*)(wf + 8 * h2), f1 = *(const f32x4*)(wf + 8 * h2 + 4), b0 = *(const f32x4*)(wb + 8 * h2), b1 = *(const f32x4*)(wb + 8 * h2 + 4);
#pragma unroll
              for (int e = 0; e < 4; ++e) { vf[e] = v[e] * f0[e]; vf[e + 4] = v[e + 4] * f1[e]; vb[e] = v[e] * b0[e]; vb[e + 4] = v[e + 4] * b1[e]; }
#pragma unroll
              for (int e = 0; e < 4; ++e) { of[e] = cvt_pk_bf16(vf[2 * e], vf[2 * e + 1]); ob[e] = cvt_pk_bf16(vb[2 * e], vb[2 * e + 1]); }
              *(u32x4*)(smem + R1 + (p * SS_LD + j0 + 8 * h2) * 2) = of; *(u32x4*)(smem + R1 + 17408 + (p * SS_LD + j0 + 8 * h2) * 2) = ob; } }
        { f32x4 yd[4];
#pragma unroll
          for (int nt = 0; nt < 4; ++nt) yd[nt] = (f32x4){0.f, 0.f, 0.f, 0.f};
#pragma unroll
          for (int k0 = 0; k0 < 128; k0 += 32) { const bf16x8 af = SS_FRAG(lds + R0, 16 * w + fr, k0);
#pragma unroll
              for (int nt = 0; nt < 4; ++nt) yd[nt] = __builtin_amdgcn_mfma_f32_16x16x32_bf16(SS_FRAG(lds + R3, 16 * nt + fr, k0), af, yd[nt], 0, 0, 0); }
          bf16_t* yp = (bf16_t*)(ws + WS_YD) + (size_t)(tb + 16 * w + fr) * 512 + g * 256 + r * 64 + 4 * fq;
#pragma unroll
          for (int nt = 0; nt < 4; ++nt) { u32x2 ov; ov[0] = cvt_pk_bf16(yd[nt][0], yd[nt][1]); ov[1] = cvt_pk_bf16(yd[nt][2], yd[nt][3]); *(u32x2*)(yp + 16 * nt) = ov; } }
        __syncthreads();
#pragma unroll
        for (int dir = 0; dir < 2; ++dir) {
            const int pt = w & 3, nt0 = (w >> 2) * 4;
            f32x4 st[4];
#pragma unroll
            for (int q = 0; q < 4; ++q) st[q] = (f32x4){0.f, 0.f, 0.f, 0.f};
#pragma unroll
            for (int k0 = 0; k0 < 128; k0 += 32) { const bf16x8 af = SS_FRAG(lds + R1 + dir * 17408, 16 * pt + fr, k0);
#pragma unroll
                for (int q = 0; q < 4; ++q) st[q] = __builtin_amdgcn_mfma_f32_16x16x32_bf16(SS_FRAG(lds + R2, 16 * (nt0 + q) + fr, k0), af, st[q], 0, 0, 0); }
            bf16_t* sp = (bf16_t*)(ws + WS_ST) + ((((size_t)(b * 2 + g) * 4 + r) * 2 + dir) * NCH + cc) * 8192 + (16 * pt + fr) * 128 + 4 * fq;
#pragma unroll
            for (int q = 0; q < 4; ++q) { u32x2 ov; ov[0] = cvt_pk_bf16(st[q][0], st[q][1]); ov[1] = cvt_pk_bf16(st[q][2], st[q][3]); *(u32x2*)(sp + 16 * (nt0 + q)) = ov; }
        }
    }
    if (tid < 8) { const int dir = tid >> 2, r = tid & 3; ((float*)(ws + WS_ACT))[(((size_t)(b * 2 + g) * 4 + r) * 2 + dir) * NCH + cc] = dir ? acb[r] : acf[127 * 4 + r]; }
    __syncthreads();
}

__device__ __forceinline__ void ssd_phase_b(CParams& P) {
    unsigned char* ws = P.ws;
    const bf16_t* ST = (const bf16_t*)(ws + WS_ST); const float* ACTS = (const float*)(ws + WS_ACT); bf16_t* HENT = (bf16_t*)(ws + WS_HENT);
    for (int it = obid() * NTH + otid(); it < NB * 2 * 4 * 2 * 2048; it += gridDim.x * NTH) {
        const int hd = it >> 11, e4 = (it & 2047) * 4, dir = hd & 1;
        f32x4 h = (f32x4){0.f, 0.f, 0.f, 0.f};
#pragma unroll
        for (int hf = 0; hf < 2; ++hf) {
            u32x2 sv[17]; float dv[17];
#pragma unroll
            for (int s = 0; s < 17; ++s) { const int st = hf * 17 + s; const int cc = dir == 0 ? st : (st < 2 ? 1 - st : NCH + 1 - st);
                sv[s] = *(const u32x2*)(ST + ((size_t)hd * NCH + cc) * 8192 + e4); dv[s] = ACTS[(size_t)hd * NCH + cc]; }
#pragma unroll
            for (int s = 0; s < 17; ++s) { const int st = hf * 17 + s; const int cc = dir == 0 ? st : (st < 2 ? 1 - st : NCH + 1 - st);
                u32x2 ov; ov[0] = cvt_pk_bf16(h[0], h[1]); ov[1] = cvt_pk_bf16(h[2], h[3]); *(u32x2*)(HENT + ((size_t)hd * NCH + cc) * 8192 + e4) = ov;
                h = h * __expf(dv[s]) + (f32x4){bflo(sv[s][0]), bfhi(sv[s][0]), bflo(sv[s][1]), bfhi(sv[s][1])}; }
        }
    }
}

__device__ __forceinline__ void ssd_phase_c(CParams& P, unsigned char* smem, LAS unsigned char* lds, int l) {
    const int G = gridDim.x, tid = otid(), bid = obid(), lane = tid & 63, w = __builtin_amdgcn_readfirstlane(tid >> 6), fr = lane & 15, fq = lane >> 4;
    unsigned char* ws = P.ws;
    constexpr int R0 = 0, R1 = 34816, R2 = 52224, RS = 69632;
    float* sm = (float*)(smem + RS); float* acf = sm + 1024; float* acb = sm + 1536;
    const bf16_t* XBN = (const bf16_t*)(ws + WS_XBN); const bf16_t* PJ = (const bf16_t*)(ws + WS_PJ); const bf16_t* HENT = (const bf16_t*)(ws + WS_HENT);
    bf16_t* YC = (bf16_t*)(ws + WS_YC); const bf16_t* YD = (const bf16_t*)(ws + WS_YD); float* SSQ = (float*)(ws + WS_SSQ); const float* DT = (const float*)(ws + WS_DT);
    constexpr int NIT = NB * 2 * NCH * 4;
    const int it0 = (int)((unsigned)(bid * NIT) / (unsigned)G), it1 = (int)((unsigned)((bid + 1) * NIT) / (unsigned)G);
    const int i = 16 * w + fr;
    u32x4 hv[4], cvn[4]; u32x2 ydn[4], xrn[4], zrn[4]; float acn[2];
#define SC_REQ(itx, newunit) do { const int un_ = (itx) >> 2, r_ = (itx) & 3, b_ = un_ / (2 * NCH), g_ = (un_ / NCH) & 1, cc_ = un_ % NCH, tb_ = ssd_tokbase(b_, cc_); \
        const size_t tok_ = (size_t)tb_ + i; const int hc_ = g_ * 256 + r_ * 64 + 4 * fq; \
        _Pragma("unroll") for (int q = 0; q < 4; ++q) { const int ch = tid + q * NTH, dir = ch >> 10, hrow = (ch >> 4) & 63, k8 = (ch & 15) * 8; \
            hv[q] = *(const u32x4*)(HENT + ((((size_t)(b_ * 2 + g_) * 4 + r_) * 2 + dir) * NCH + cc_) * 8192 + hrow * 128 + k8); } \
        _Pragma("unroll") for (int nt = 0; nt < 4; ++nt) { ydn[nt] = *(const u32x2*)(YD + tok_ * 512 + hc_ + 16 * nt); xrn[nt] = *(const u32x2*)(XBN + tok_ * 1024 + hc_ + 16 * nt); zrn[nt] = *(const u32x2*)(PJ + tok_ * PJW + 1024 + hc_ + 16 * nt); } \
        if (newunit) { \
            _Pragma("unroll") for (int q = 0; q < 4; ++q) { const int ch = tid + q * NTH, row = ch >> 4, k8 = (ch & 15) * 8; cvn[q] = *(const u32x4*)(XBN + (size_t)(tb_ + row) * 1024 + 768 + g_ * 128 + k8); } \
            _Pragma("unroll") for (int q = 0; q < 2; ++q) acn[q] = ((const float*)(ws + WS_ACSG))[(size_t)un_ * 1024 + tid + q * NTH]; } \
        } while (0)
    if (it0 < it1) SC_REQ(it0, true);
    int cur_un = -1;
#pragma unroll 1
    for (int it = it0; it < it1; ++it) {
        const int un = it >> 2, r = it & 3, b = un / (2 * NCH), g = (un / NCH) & 1, cc = un % NCH, tb = ssd_tokbase(b, cc);
        const size_t tok = (size_t)tb + i; const int hc = g * 256 + r * 64 + 4 * fq;
        __syncthreads();
        if (un != cur_un) {
            cur_un = un;
#pragma unroll
            for (int q = 0; q < 2; ++q) sm[1024 + tid + q * NTH] = acn[q];
#pragma unroll
            for (int q = 0; q < 4; ++q) { const int ch = tid + q * NTH, row = ch >> 4, k8 = (ch & 15) * 8; *(u32x4*)(smem + R0 + (row * SS_LD + k8) * 2) = cvn[q]; }
        }
#pragma unroll
        for (int q = 0; q < 4; ++q) { const int ch = tid + q * NTH, dir = ch >> 10, hrow = (ch >> 4) & 63, k8 = (ch & 15) * 8; *(u32x4*)(smem + (dir ? R2 : R1) + (hrow * SS_LD + k8) * 2) = hv[q]; }
        u32x2 ydv[4], xr[4], zr[4];
#pragma unroll
        for (int nt = 0; nt < 4; ++nt) { ydv[nt] = ydn[nt]; xr[nt] = xrn[nt]; zr[nt] = zrn[nt]; }
        if (it + 1 < it1) { const bool nu_ = ((it + 1) >> 2) != un; SC_REQ(it + 1, nu_); }
        __syncthreads();
        f32x4 yf[4], yb[4];
#pragma unroll
        for (int nt = 0; nt < 4; ++nt) { yf[nt] = (f32x4){0.f, 0.f, 0.f, 0.f}; yb[nt] = (f32x4){0.f, 0.f, 0.f, 0.f}; }
#pragma unroll
        for (int k0 = 0; k0 < 128; k0 += 32) { const bf16x8 af = SS_FRAG(lds + R0, 16 * w + fr, k0);
#pragma unroll
            for (int nt = 0; nt < 4; ++nt) { yf[nt] = __builtin_amdgcn_mfma_f32_16x16x32_bf16(SS_FRAG(lds + R1, 16 * nt + fr, k0), af, yf[nt], 0, 0, 0);
                                             yb[nt] = __builtin_amdgcn_mfma_f32_16x16x32_bf16(SS_FRAG(lds + R2, 16 * nt + fr, k0), af, yb[nt], 0, 0, 0); } }
        const float ef = __expf(acf[i * 4 + r]), eb = __expf(acb[i * 4 + r]), dsk = P.in[I_SD][l * 8 + g * 4 + r];
        float ssq = 0.f;
#pragma unroll
        for (int nt = 0; nt < 4; ++nt) {
            float xv[4], zv[4], yv[4]; unpack4(xr[nt], xv); unpack4(zr[nt], zv); unpack4(ydv[nt], yv);
            float o[4];
#pragma unroll
            for (int e = 0; e < 4; ++e) { o[e] = (yv[e] + ef * yf[nt][e] + eb * yb[nt][e] + xv[e] * dsk) * fsilu(zv[e]); ssq += o[e] * o[e]; }
            u32x2 ov; ov[0] = cvt_pk_bf16(o[0], o[1]); ov[1] = cvt_pk_bf16(o[2], o[3]);
            *(u32x2*)(YC + tok * YCW + 1024 + hc + 16 * nt) = ov; }
        ssq += swz_xor<16>(ssq); ssq = xor32_sum(ssq);
        if (fq == 0) SSQ[tok * 8 + g * 4 + r] = ssq;
    }
#undef SC_REQ
    __syncthreads();
}

__device__ __forceinline__ void p7a_route(CParams& P, unsigned char* smem, LAS unsigned char* lds, int l, const int TT) {
    const int G = gridDim.x, tid = otid(), bid = obid(), lane = tid & 63, w = __builtin_amdgcn_readfirstlane(tid >> 6), fr = lane & 15, fq = lane >> 4;
    unsigned char* ws = P.ws;
    constexpr int HLD = 1032, OFF_HI = 0, OFF_LO = 16 * HLD * 2, OFF_PART = 2 * 16 * HLD * 2, OFF_LG = OFF_PART + 8 * 16 * 32 * 4, OFF_HIST = OFF_LG + 16 * 32 * 4;
    float* part = (float*)(smem + OFF_PART); float* lg = (float*)(smem + OFF_LG); int* hist = (int*)(smem + OFF_HIST);
    const bf16_t* X1 = (const bf16_t*)(ws + WS_X1); bf16_t* H2 = (bf16_t*)(ws + WS_H2);
    const float* MODL = (const float*)(ws + WS_MOD) + (size_t)l * 9 * 6144;
    const float* nf = P.in[I_NFFN] + (size_t)l * 1024;
    bf16x8 wh[2][4], wl[2][4];
    { const bf16_t* wr = (const bf16_t*)(ws + WS_WRT) + (size_t)l * 2 * 32 * 1024;
#pragma unroll
      for (int nt = 0; nt < 2; ++nt)
#pragma unroll
          for (int ks = 0; ks < 4; ++ks) { const size_t o = (size_t)(16 * nt + fr) * 1024 + 128 * w + 32 * ks + 8 * fq;
              wh[nt][ks] = *(const bf16x8*)(wr + o); wl[nt][ks] = *(const bf16x8*)(wr + 32 * 1024 + o); } }
    if (tid < 32) hist[tid] = 0;
    f32x4 gn[4];
#pragma unroll
    for (int q = 0; q < 4; ++q) gn[q] = *(const f32x4*)(nf + q * 256 + lane * 4);
    const int nit = (TT / 16 + G - 1) / G;
    f32x4 v[2][4];
    { const int t0 = bid * 16;
#pragma unroll
      for (int j = 0; j < 2; ++j)
#pragma unroll
          for (int q = 0; q < 4; ++q) { float t_[4] = {0.f, 0.f, 0.f, 0.f}; if (t0 < TT) unpack4(*(const u32x2*)(X1 + (size_t)(t0 + 2 * w + j) * 1024 + q * 256 + lane * 4), t_); v[j][q] = (f32x4){t_[0], t_[1], t_[2], t_[3]}; } }
    for (int it = 0; it < nit; ++it) {
        const int t0 = (it * G + bid) * 16;
        __syncthreads();
        if (t0 < TT) {
            f32x4 av[4], bv[4];
            { const float* md = MODL + (size_t)tok_modj(t0) * 6144;
#pragma unroll
              for (int q = 0; q < 4; ++q) { av[q] = *(const f32x4*)(md + 4096 + q * 256 + lane * 4); bv[q] = *(const f32x4*)(md + 3072 + q * 256 + lane * 4); } }
#pragma unroll
            for (int j = 0; j < 2; ++j) {
                const int t = t0 + 2 * w + j;
                float ss = 0.f;
#pragma unroll
                for (int q = 0; q < 4; ++q) ss += v[j][q][0] * v[j][q][0] + v[j][q][1] * v[j][q][1] + v[j][q][2] * v[j][q][2] + v[j][q][3] * v[j][q][3];
                ss = wave_sum(ss); const float rs = rsqrtf(ss * (1.f / 1024.f) + EPSN);
#pragma unroll
                for (int q = 0; q < 4; ++q) { const int c = q * 256 + lane * 4;
                    const f32x4 g = gn[q], a = av[q], b = bv[q];
                    float o[4], lo[4];
#pragma unroll
                    for (int e = 0; e < 4; ++e) o[e] = v[j][q][e] * rs * g[e] * (1.f + a[e]) + b[e];
                    u32x2 ov; ov[0] = cvt_pk_bf16(o[0], o[1]); ov[1] = cvt_pk_bf16(o[2], o[3]);
                    *(u32x2*)(H2 + (size_t)t * 1024 + c) = ov;
                    lo[0] = o[0] - bflo(ov[0]); lo[1] = o[1] - bfhi(ov[0]); lo[2] = o[2] - bflo(ov[1]); lo[3] = o[3] - bfhi(ov[1]);
                    u32x2 lv; lv[0] = cvt_pk_bf16(lo[0], lo[1]); lv[1] = cvt_pk_bf16(lo[2], lo[3]);
                    *(u32x2*)(smem + OFF_HI + ((2 * w + j) * HLD + c) * 2) = ov; *(u32x2*)(smem + OFF_LO + ((2 * w + j) * HLD + c) * 2) = lv; }
            }
        }
        { const int tn = ((it + 1) * G + bid) * 16;
          if (it + 1 < nit && tn < TT) {
#pragma unroll
              for (int j = 0; j < 2; ++j)
#pragma unroll
                  for (int q = 0; q < 4; ++q) { float t_[4]; unpack4(*(const u32x2*)(X1 + (size_t)(tn + 2 * w + j) * 1024 + q * 256 + lane * 4), t_); v[j][q] = (f32x4){t_[0], t_[1], t_[2], t_[3]}; } } }
        __syncthreads();
        if (t0 < TT) {
            f32x4 acc[2] = {(f32x4){0.f, 0.f, 0.f, 0.f}, (f32x4){0.f, 0.f, 0.f, 0.f}};
#pragma unroll
            for (int ks = 0; ks < 4; ++ks) {
                const bf16x8 ah = *(const LAS bf16x8*)(lds + OFF_HI + (fr * HLD + 128 * w + 32 * ks + 8 * fq) * 2), al = *(const LAS bf16x8*)(lds + OFF_LO + (fr * HLD + 128 * w + 32 * ks + 8 * fq) * 2);
#pragma unroll
                for (int nt = 0; nt < 2; ++nt) { acc[nt] = __builtin_amdgcn_mfma_f32_16x16x32_bf16(wh[nt][ks], ah, acc[nt], 0, 0, 0);
                    acc[nt] = __builtin_amdgcn_mfma_f32_16x16x32_bf16(wl[nt][ks], ah, acc[nt], 0, 0, 0); acc[nt] = __builtin_amdgcn_mfma_f32_16x16x32_bf16(wh[nt][ks], al, acc[nt], 0, 0, 0); } }
#pragma unroll
            for (int nt = 0; nt < 2; ++nt) *(f32x4*)(part + (w * 16 + fr) * 32 + 16 * nt + 4 * fq) = acc[nt];
        }
        __syncthreads();
        if (t0 < TT) {
            const int tk = tid >> 5, e = tid & 31; float x = P.in[I_RB][l * 32 + e];
#pragma unroll
            for (int q = 0; q < 8; ++q) x += part[(q * 16 + tk) * 32 + e];
            float vv[4]; int ix[4];
#pragma unroll
            for (int k = 0; k < 4; ++k) {
                float m = x; m = fmaxf(m, swz_xor<1>(m)); m = fmaxf(m, swz_xor<2>(m)); m = fmaxf(m, swz_xor<4>(m)); m = fmaxf(m, swz_xor<8>(m)); m = fmaxf(m, swz_xor<16>(m));
                const unsigned long long bm = __ballot(x == m); const unsigned hm = (unsigned)(bm >> (lane & 32));
                const int bi = __builtin_ctz(hm);
                vv[k] = m; ix[k] = bi; if (e == bi) x = -3.0e38f; }
            if (e == 0) {
                const int t = t0 + tk; float ex[4], sum = 0.f;
#pragma unroll
                for (int k = 0; k < 4; ++k) { ex[k] = expf(vv[k] - vv[0]); sum += ex[k]; }
                const float inv = 1.f / sum;
#pragma unroll
                for (int k = 0; k < 4; ++k) { ((int*)(ws + WS_TKE))[(size_t)t * 4 + k] = ix[k]; ((float*)(ws + WS_TKW))[(size_t)t * 4 + k] = ex[k] * inv; atomicAdd(&hist[ix[k]], 1); }
            }
        }
    }
    __syncthreads();
    if (tid < 32) ((int*)(ws + WS_BCNT))[bid * 32 + tid] = hist[tid];
}
__device__ __forceinline__ void p7b_scatter(CParams& P, unsigned char* smem, const int TT) {
    const int G = gridDim.x, tid = otid(), bid = obid();
    unsigned char* ws = P.ws;
    int* cur = (int*)smem; int* tot = cur + 32; int* rst = tot + 32; int* ust = rst + 32;
    const int* BC = (const int*)(ws + WS_BCNT);
    __syncthreads();
    int* ptot = ust + 40; int* pbef = ptot + 512;
    { const int e = tid & 31, pr = tid >> 5; int before = 0, total = 0;
      for (int b = pr; b < G; b += 16) { const int c = BC[b * 32 + e]; total += c; before += (b < bid) ? c : 0; }
      ptot[pr * 32 + e] = total; pbef[pr * 32 + e] = before; }
    __syncthreads();
    if (tid < 32) { int before = 0, total = 0;
#pragma unroll
        for (int pr = 0; pr < 16; ++pr) { total += ptot[pr * 32 + tid]; before += pbef[pr * 32 + tid]; }
        tot[tid] = total; cur[tid] = before; }
    __syncthreads();
    if (tid == 0) { int u = 0; for (int e = 0; e < 32; ++e) { ust[e] = u; rst[e] = u * 256; u += (tot[e] + 255) >> 8; } ust[32] = u; }
    __syncthreads();
    if (tid < 32) cur[tid] += rst[tid];
    if (bid == 0 && tid < 33) ((int*)(ws + WS_META))[tid] = ust[tid];
    if (bid == 0 && tid == 33) ((int*)(ws + WS_META))[33] = ust[32];
    __syncthreads();
    int* RTOK = (int*)(ws + WS_RTOK); int* RPAIR = (int*)(ws + WS_RPAIR); float* RW = (float*)(ws + WS_RW);
    const int nit = (TT / 16 + G - 1) / G;
    for (int pi = tid; pi < nit * 64; pi += NTH) {
        const int it = pi >> 6, wq = (pi >> 2) & 15, k = pi & 3, t = (it * G + bid) * 16 + wq;
        if (t < TT) { const int e = ((const int*)(ws + WS_TKE))[(size_t)t * 4 + k]; const int pos = atomicAdd(&cur[e], 1);
            RTOK[pos] = t; RPAIR[pos] = t * 4 + k; RW[pos] = ((const float*)(ws + WS_TKW))[(size_t)t * 4 + k]; }
    }
    for (int e = bid; e < 32; e += G) { const int lo = rst[e] + tot[e], hi = rst[e] + (((tot[e] + 255) >> 8) << 8);
        for (int r = lo + tid; r < hi; r += NTH) { RTOK[r] = 0; RPAIR[r] = -1; RW[r] = 0.f; } }
    __syncthreads();
}

__device__ __forceinline__ void p10_combine(CParams& P, int l) {
    const int tid_ = otid(), lane = tid_ & 63, gw = (obid() * NTH + tid_) >> 6, nw = gridDim.x * (NTH / 64);
    unsigned char* ws = P.ws;
    const bf16_t* X1 = (const bf16_t*)(ws + WS_X1); const bf16_t* YP = (const bf16_t*)(ws + WS_YP);
    const float* MODL = (const float*)(ws + WS_MOD) + (size_t)l * 9 * 6144;
    const int TT = (l == NL - 1) ? TL : T;
    const int per = (TT + nw - 1) / nw, tb = gw * per, te = (tb + per < TT) ? tb + per : TT;
    if (tb >= te) return;
    f32x4 gain[4], g2v[4], scv[4], shv[4]; int curj = -1;
    u32x2 xn[4], yn[4][4];
#define P10_REQ(tx) do { _Pragma("unroll") for (int q = 0; q < 4; ++q) { const int c = q * 256 + lane * 4; xn[q] = *(const u32x2*)(X1 + (size_t)(tx) * 1024 + c); \
        _Pragma("unroll") for (int k = 0; k < 4; ++k) yn[q][k] = *(const u32x2*)(YP + ((size_t)(tx) * 4 + k) * 1024 + c); } } while (0)
    P10_REQ(tb);
#pragma unroll
    for (int q = 0; q < 4; ++q) gain[q] = (l < NL - 1) ? *(const f32x4*)(P.in[I_NMIX] + (size_t)(l + 1) * 1024 + q * 256 + lane * 4) : *(const f32x4*)(P.in[I_NFIN] + q * 256 + lane * 4);
#pragma unroll 1
    for (int t = tb; t < te; ++t) {
        const int mj = tok_modj(t);
        if (mj != curj) { curj = mj; const float* md = MODL + (size_t)mj * 6144; const float* mdn = md + (size_t)9 * 6144;
#pragma unroll
            for (int q = 0; q < 4; ++q) { const int c = q * 256 + lane * 4; g2v[q] = *(const f32x4*)(md + 5120 + c);
                if (l < NL - 1) { scv[q] = *(const f32x4*)(mdn + 1024 + c); shv[q] = *(const f32x4*)(mdn + c); } } }
        f32x4 v[4];
#pragma unroll
        for (int q = 0; q < 4; ++q) { f32x4 s = (f32x4){0.f, 0.f, 0.f, 0.f};
#pragma unroll
            for (int k = 0; k < 4; ++k) { float y[4]; unpack4(yn[q][k], y); s[0] += y[0]; s[1] += y[1]; s[2] += y[2]; s[3] += y[3]; }
            float x1_[4]; unpack4(xn[q], x1_);
            v[q] = (f32x4){x1_[0], x1_[1], x1_[2], x1_[3]} + g2v[q] * s; }
        if (t + 1 < te) P10_REQ(t + 1);
        float ss = 0.f;
#pragma unroll
        for (int q = 0; q < 4; ++q) ss += v[q][0] * v[q][0] + v[q][1] * v[q][1] + v[q][2] * v[q][2] + v[q][3] * v[q][3];
        ss = wave_sum(ss); const float rs = rsqrtf(ss * (1.f / 1024.f) + EPSN);
        if (l < NL - 1) {
#pragma unroll
            for (int q = 0; q < 4; ++q) { const int c = q * 256 + lane * 4;
                u32x2 o_; o_[0] = cvt_pk_bf16(v[q][0], v[q][1]); o_[1] = cvt_pk_bf16(v[q][2], v[q][3]); *(u32x2*)((bf16_t*)(ws + WS_XC) + (size_t)t * 1024 + c) = o_;
                u32x2 h_; h_[0] = cvt_pk_bf16(v[q][0] * rs * gain[q][0] * (1.f + scv[q][0]) + shv[q][0], v[q][1] * rs * gain[q][1] * (1.f + scv[q][1]) + shv[q][1]);
                h_[1] = cvt_pk_bf16(v[q][2] * rs * gain[q][2] * (1.f + scv[q][2]) + shv[q][2], v[q][3] * rs * gain[q][3] * (1.f + scv[q][3]) + shv[q][3]);
                *(u32x2*)((bf16_t*)(ws + WS_H) + (size_t)t * 1024 + c) = h_; }
        } else {
#pragma unroll
            for (int q = 0; q < 4; ++q) { const int c = q * 256 + lane * 4; *(f32x4*)(P.out + (size_t)t * 1024 + c) = v[q] * rs * gain[q]; }
        }
    }
#undef P10_REQ
}

#ifndef PROBE_ID
#define PROBE_ID 0
#endif
template <class Tsrc> __device__ __forceinline__ void probe_dump(const Tsrc* src, size_t n, float* out) {
    const size_t nout = (size_t)TL * 1024; const size_t gth = (size_t)blockIdx.x * NTH + threadIdx.x, nth = (size_t)gridDim.x * NTH;
    for (size_t i = gth; i < nout; i += nth) { float v;
        if constexpr (sizeof(Tsrc) == 2) v = bf2f(((const bf16_t*)src)[i % n]); else v = (float)src[i % n];
        out[i] = v; }
}
#define PROBE_AT(id, type, off, n) do { if (PROBE_ID == (id) && l == 0) { GRID_BAR(); probe_dump((const type*)(WSP + (off)), (size_t)(n), kparams()->out); return; } } while (0)

template <class Tsrc> __device__ __forceinline__ void probe_max(const Tsrc* src, size_t lo, size_t hi, float* out, unsigned* word) {
    const size_t nout = (size_t)TL * 1024; const size_t gth = (size_t)blockIdx.x * NTH + threadIdx.x, nth = (size_t)gridDim.x * NTH;
    float m = 0.f;
    for (size_t i = lo + gth; i < hi; i += nth) { float v; if constexpr (sizeof(Tsrc) == 2) v = bf2f(((const bf16_t*)src)[i]); else v = (float)src[i]; m = fmaxf(m, fabsf(v)); }
    atomicMax(word, __float_as_uint(m));
    for (size_t i = gth; i < nout; i += nth) out[i] = 0.f;
}
#define PROBE_MAX(id, type, off, lo, hi) do { if (PROBE_ID == (id) && l == 0) { GRID_BAR(); unsigned* w_ = (unsigned*)(WSP + WS_CTL) + 3600; probe_max((const type*)(WSP + (off)), (size_t)(lo), (size_t)(hi), kparams()->out, w_); \
    GRID_BAR(); if (blockIdx.x == 0 && threadIdx.x == 0) kparams()->out[0] = __uint_as_float(__hip_atomic_load(w_, __ATOMIC_RELAXED, __HIP_MEMORY_SCOPE_AGENT)); return; } } while (0)

template <class Tsrc> __device__ __forceinline__ void probe_cnt(const Tsrc* src, size_t lo, size_t hi, float thr, float* out, unsigned* word) {
    const size_t nout = (size_t)TL * 1024; const size_t gth = (size_t)blockIdx.x * NTH + threadIdx.x, nth = (size_t)gridDim.x * NTH;
    unsigned m = 0;
    for (size_t i = lo + gth; i < hi; i += nth) { float v; if constexpr (sizeof(Tsrc) == 2) v = bf2f(((const bf16_t*)src)[i]); else v = (float)src[i]; m += (fabsf(v) > thr || v != v) ? 1u : 0u; }
    atomicAdd(word, m);
    for (size_t i = gth; i < nout; i += nth) out[i] = 0.f;
}
#define PROBE_CNT(id, type, off, lo, hi, thr) do { if (PROBE_ID == (id) && l == 0) { GRID_BAR(); unsigned* w_ = (unsigned*)(WSP + WS_CTL) + 3600; probe_cnt((const type*)(WSP + (off)), (size_t)(lo), (size_t)(hi), thr, kparams()->out, w_); \
    GRID_BAR(); if (blockIdx.x == 0 && threadIdx.x == 0) kparams()->out[0] = 100.f + (float)__hip_atomic_load(w_, __ATOMIC_RELAXED, __HIP_MEMORY_SCOPE_AGENT); return; } } while (0)

__device__ __forceinline__ void probe_cnt2(const bf16_t* src, int r0, int r1, int c0, int c1, int ld, float thr, float* out, unsigned* word) {
    const size_t nout = (size_t)TL * 1024; const size_t gth = (size_t)blockIdx.x * NTH + threadIdx.x, nth = (size_t)gridDim.x * NTH;
    unsigned m = 0; const size_t w = (size_t)(c1 - c0), n = (size_t)(r1 - r0) * w;
    for (size_t i = gth; i < n; i += nth) { const size_t r = r0 + i / w, c = c0 + i % w; const float v = bf2f(src[r * ld + c]); m += (fabsf(v) > thr || v != v) ? 1u : 0u; }
    atomicAdd(word, m);
    for (size_t i = gth; i < nout; i += nth) out[i] = 0.f;
}
#define PROBE_CNT2(id, off, r0, r1, c0, c1, ld, thr) do { if (PROBE_ID == (id) && l == 0) { GRID_BAR(); unsigned* w_ = (unsigned*)(WSP + WS_CTL) + 3600; probe_cnt2((const bf16_t*)(WSP + (off)), r0, r1, c0, c1, ld, thr, kparams()->out, w_); \
    GRID_BAR(); if (blockIdx.x == 0 && threadIdx.x == 0) kparams()->out[0] = 100.f + (float)__hip_atomic_load(w_, __ATOMIC_RELAXED, __HIP_MEMORY_SCOPE_AGENT); return; } } while (0)

#ifndef PROBE_TI
#define PROBE_TI -1
#endif
#ifndef PROBE_TJ
#define PROBE_TJ 0
#endif
__device__ __forceinline__ void tstamp(unsigned char* wsp, int slot) {
    if (PROBE_TI >= 0 && blockIdx.x == 0 && threadIdx.x == 0) {
        unsigned long long* tw = (unsigned long long*)(wsp + WS_CTL + 14400);
        const unsigned long long now = wall_clock64(); const unsigned long long prev = tw[0];
        if (slot >= 0) tw[1 + slot] += now - prev;
        tw[0] = now;
    }
}
__device__ __forceinline__ void tdump(unsigned char* wsp, float* out) {
    if (PROBE_TI >= 0 && blockIdx.x == 0 && threadIdx.x == 0) {
        const unsigned long long* tw = (const unsigned long long*)(wsp + WS_CTL + 14400);
        out[0] = 10.f * log2f((float)tw[1 + (PROBE_TI >= 0 ? PROBE_TI : 0)] * 0.01f + 1.f) - 25.f;
    }
}
constexpr int MOE_TILES_P5 = 3712;
#ifndef EXP_P4
#define EXP_P4 0
#endif
#ifndef DUP_MASK
#define DUP_MASK 0
#endif
#define smem fresh_smem()
#define lds fresh_lds()
#define bid obid()
#define LL l
#define P (*kparams())
#define WSP (kparams()->ws)
#define TS(slot) tstamp(WSP, slot)
#define GRID_BAR() do { XcdBarrier b_; b_.bar = (unsigned*)(kparams()->ws + WS_CTL); b_.x = xb_xcc_id(); b_.st = (volatile LAS unsigned*)(lds + LDS_XB); xcd_barrier(b_); } while (0)
template <int l> __device__ __forceinline__ void run_layer() {
    const int G = gridDim.x;
    constexpr int TT = (l == NL - 1) ? TL : T;
        for (int rep_ = 0; rep_ < ((DUP_MASK & 2) ? 2 : 1); ++rep_) {
        { Src1 S{(const char*)(WSP + WS_H), (const char*)(WSP + WS_W1T) + (size_t)LL * N1 * 2048, (const char*)(WSP + WS_WFT) + (size_t)LL * 512 * 2048, G, bid};
          Epi1 E{(bf16_t*)(WSP + WS_G), (bf16_t*)(WSP + WS_PJ), (float*)(WSP + WS_DTR), (bf16_t*)(WSP + WS_VT), (bf16_t*)(WSP + WS_VTC)};
          pg8::gemm_phase<false>(lds, S, E, 1024, 1024); }
        PROBE_AT(1, bf16_t, WS_PJ, (size_t)T * PJW);
        PROBE_AT(2, bf16_t, WS_G, (size_t)T * 4096);
        PROBE_MAX(20, bf16_t, WS_G, 0, (size_t)T * 4096);
        PROBE_MAX(21, bf16_t, WS_PJ, 0, (size_t)T * PJW);
        PROBE_CNT(23, bf16_t, WS_G, 0, (size_t)T * 4096, 1.001f);
        PROBE_CNT2(24, WS_G, 0, T, 0, 2048, 4096, 1.001f);
        PROBE_CNT2(25, WS_G, 0, T, 3840, 4096, 4096, 1.001f);
        PROBE_CNT2(26, WS_G, 0, 256, 0, 4096, 4096, 1.001f);
        PROBE_MAX(22, bf16_t, WS_H, 0, (size_t)T * 1024);
        GRID_BAR();
        }
        TS(2);
        for (int rep_ = 0; rep_ < ((DUP_MASK & (32 | 64)) ? 2 : 1); ++rep_) {
        p3_prep(P, smem, LL);
        GRID_BAR();
        }
        TS(3);
        for (int rep_ = 0; rep_ < ((DUP_MASK & 4) ? 2 : 1); ++rep_) {
        { dft_nyquist((const bf16_t*)(WSP + WS_VT), (bf16_t*)(WSP + WS_YC), bid * 8, 8);
          if (G < 256) for (int r0_ = G * 8; r0_ < 2048; r0_ += 8) dft_nyquist((const bf16_t*)(WSP + WS_VT), (bf16_t*)(WSP + WS_YC), r0_, 8);
          unsigned* wq_ = (unsigned*)(WSP + WS_CTL) + 3800 + l;
          unsigned* hyc_ = (unsigned*)(WSP + WS_CTL) + 3900 + 32 * l;
          constexpr int Q_FIN = 136 + 256 + NB * 2 * NCH, N_FIN = (T / 64 + 1) / 2;
#pragma unroll 1
          for (;;) {
              __syncthreads();
              if (threadIdx.x == 0) *(volatile LAS int*)(lds + LDS_XB + 32) = (int)__hip_atomic_fetch_add(wq_, 1u, __ATOMIC_RELAXED, __HIP_MEMORY_SCOPE_AGENT);
              __syncthreads();
              const int idx_ = __builtin_amdgcn_readfirstlane(*(volatile LAS int*)(lds + LDS_XB + 32));
              if (idx_ >= Q_FIN + N_FIN) break;
              if (idx_ < 136) { if (EXP_P4 & 1) continue;
                  SrcDft S{(const char*)(WSP + WS_D4C), (const char*)(WSP + WS_D4S), (const char*)(WSP + WS_D256), (const char*)(WSP + WS_VT), (const char*)(WSP + WS_VTC), idx_, 1000};
                  EpiDft E{(bf16_t*)(WSP + WS_YC)};
                  pg8::gemm_phase<false>(lds, S, E, 4096, 8192); }
              else if (idx_ < 136 + 256) { if (!(EXP_P4 & 2)) hyena_conv_channel(P, smem, lds, LL, idx_ - 136);
                  asm volatile("s_waitcnt vmcnt(0)" ::: "memory");
                  __syncthreads();
                  if (threadIdx.x == 0) { __builtin_amdgcn_fence(__ATOMIC_RELEASE, "agent"); asm volatile("s_waitcnt vmcnt(0)" ::: "memory"); (void)xb_add(hyc_, 1u); } }
              else if (idx_ < Q_FIN) { if (!(EXP_P4 & 4)) ssd_a_unit(P, smem, lds, LL, idx_ - 136 - 256); }
              else {
                  if (threadIdx.x == 0) { unsigned* bar_ = (unsigned*)(WSP + WS_CTL); XB_SPIN(xb_ld(hyc_) < 256u, bar_); __builtin_amdgcn_fence(__ATOMIC_ACQUIRE, "agent"); asm volatile("s_waitcnt vmcnt(0)" ::: "memory"); }
                  __syncthreads();
                  const int t0_ = 2 * (idx_ - Q_FIN);
                  hyena_finish(P, smem, LL, t0_, t0_ + 2 < T / 64 ? t0_ + 2 : T / 64); }
          }
          TS(16); }
        GRID_BAR();
        }
        TS(4);
        for (int rep_ = 0; rep_ < ((DUP_MASK & (32 | 128)) ? 2 : 1); ++rep_) {
        ssd_phase_b(P);
        GRID_BAR();
        }
        TS(5);
        for (int rep_ = 0; rep_ < ((DUP_MASK & (32 | 256)) ? 2 : 1); ++rep_) {
        ssd_phase_c(P, smem, lds, LL);
        PROBE_AT(3, bf16_t, WS_YC, (size_t)T * YCW);
        GRID_BAR();
        }
        TS(6);
        for (int rep_ = 0; rep_ < ((DUP_MASK & 16) ? 2 : 1); ++rep_) {
        { SrcBr S{(const char*)(WSP + WS_YC), (const char*)(WSP + WS_WBRT) + (size_t)LL * 1024 * YCW * 2, G, bid, TT / 256};
          EpiBr E{(const bf16_t*)(WSP + WS_G), (bf16_t*)(WSP + WS_MG), (const float*)(WSP + WS_SSQ)};
          pg8::gemm_phase<false>(lds, S, E, YCW, YCW); }
        {
            constexpr int NSU = (TT / 256) * 4; const int rem = NSU % G, b_ = bid;
            const int nearly = rem == 0 ? G : G - rem, part = rem == 0 ? b_ : b_ - rem;
            if (part >= 0) p0_transposes(P, smem, l * TILES_PER_LAYER + TILES_DENSE + MOE_TILES_P0, l * TILES_PER_LAYER + TILES_DENSE + MOE_TILES_P0 + MOE_TILES_P5, part, nearly); }
        GRID_BAR();
        }
        TS(7);
        for (int rep_ = 0; rep_ < ((DUP_MASK & 32768) ? 2 : 1); ++rep_) {
        PROBE_AT(6, bf16_t, WS_MG, (size_t)T * 1024);
        PROBE_AT(7, float, WS_SSQ, (size_t)T * 8);
        { SrcOut S{(const char*)(WSP + WS_MG), (const char*)(WSP + WS_WOUTT) + (size_t)LL * 1024 * 2048, G, bid, TT / 256};
          if constexpr (l == 0) { EpiOut<true> E{P.in[I_X], P.in[I_CTX], (bf16_t*)(WSP + WS_X1), (const float*)(WSP + WS_MOD) + (size_t)LL * 9 * 6144}; pg8::gemm_phase<false>(lds, S, E, 1024, 1024); }
          else { EpiOut<false> E{(const bf16_t*)(WSP + WS_XC), (const bf16_t*)(WSP + WS_XC) + (size_t)TL * 1024, (bf16_t*)(WSP + WS_X1), (const float*)(WSP + WS_MOD) + (size_t)LL * 9 * 6144}; pg8::gemm_phase<false>(lds, S, E, 1024, 1024); } }
        {
            constexpr int NSU = (TT / 256) * 4; const int rem = NSU % G, b_ = bid;
            const int nearly = rem == 0 ? G : G - rem, part = rem == 0 ? b_ : b_ - rem;
            if (part >= 0) p0_transposes(P, smem, l * TILES_PER_LAYER + TILES_DENSE + MOE_TILES_P0 + MOE_TILES_P5, (l + 1) * TILES_PER_LAYER, part, nearly); }
        GRID_BAR();
        }
        TS(8);
        for (int rep_ = 0; rep_ < ((DUP_MASK & (32 | 512)) ? 2 : 1); ++rep_) {
        PROBE_AT(4, bf16_t, WS_X1, (size_t)T * 1024);
        p7a_route(P, smem, lds, LL, TT);
        GRID_BAR();
        }
        TS(9);
        for (int rep_ = 0; rep_ < ((DUP_MASK & (32 | 1024)) ? 2 : 1); ++rep_) {
        p7b_scatter(P, smem, TT);
        GRID_BAR();
        if (DUP_MASK & 65536) { GRID_BAR(); GRID_BAR(); GRID_BAR(); GRID_BAR(); GRID_BAR(); GRID_BAR(); GRID_BAR(); GRID_BAR(); }
        }
        TS(10);
        for (int rep_ = 0; rep_ < ((DUP_MASK & 8) ? 2 : 1); ++rep_) {
        { SrcUp S{(const char*)(WSP + WS_H2), (const char*)(WSP + WS_WUPT) + (size_t)LL * 32 * 2048 * 2048, (const int*)(WSP + WS_RTOK), (const int*)(WSP + WS_META), G, bid};
          EpiUp E{(bf16_t*)(WSP + WS_ACTB), P.in[I_BUP] + (size_t)LL * 32 * 2048};
          pg8::gemm_phase<true>(lds, S, E, 1024, 1024); }
        GRID_BAR();
        }
        TS(11);
        for (int rep_ = 0; rep_ < ((DUP_MASK & 8) ? 2 : 1); ++rep_) {
        { SrcDn S{(const char*)(WSP + WS_ACTB), (const char*)(WSP + WS_WDNT) + (size_t)LL * 32 * 1024 * 2048, (const int*)(WSP + WS_META), G, bid};
          EpiDn E{(bf16_t*)(WSP + WS_YP), P.in[I_BDN] + (size_t)LL * 32 * 1024, (const int*)(WSP + WS_RPAIR), (const float*)(WSP + WS_RW)};
          pg8::gemm_phase<false>(lds, S, E, 1024, 1024); }
        GRID_BAR();
        }
        TS(12);
        for (int rep_ = 0; rep_ < ((DUP_MASK & (32 | 2048)) ? 2 : 1); ++rep_) {
        PROBE_AT(5, bf16_t, WS_YP, (size_t)T * 4 * 1024);
        p10_combine(P, LL);
        GRID_BAR();
        }
        TS(13);
}
__global__ void __launch_bounds__(NTH, 2) fwd_kernel(Params Pk) {
    const int tid = threadIdx.x, G = gridDim.x;
    if (tid < 4) ((volatile LAS unsigned*)(lds + LDS_XB))[tid] = 0u;
    __syncthreads();
    (void)xcd_barrier_post((unsigned*)(Pk.ws + WS_CTL), (volatile LAS unsigned*)(lds + LDS_XB));

    TS(-1);
    for (int rep_ = 0; rep_ < ((DUP_MASK & 1) ? 2 : 1); ++rep_) {
    p0_prep(P, smem);
    GRID_BAR();
    }
    TS(0);
    p1_norm0(P);
    GRID_BAR();
    TS(1);
    run_layer<0>(); run_layer<1>(); run_layer<2>(); run_layer<3>();
    if (PROBE_TI >= 0) { GRID_BAR(); tdump(WSP, kparams()->out); }
}
#undef bid
#undef LL
#undef smem
#undef lds
#undef GRID_BAR
#undef P
#undef WSP
#undef TS

extern "C" void kernel_launch(void* const* d_in, const int* in_sizes, int n_in, void* d_out, int out_size, void* d_ws, size_t ws_size, hipStream_t stream) {
    static int grid = 0;
    if (grid == 0) {
        if (n_in != 35 || ws_size < WS_END) { fprintf(stderr, "kernel_launch: need 35 inputs and %zu bytes of workspace (got %d, %zu)\n", (size_t)WS_END, n_in, ws_size); grid = -1; return; }
        int dev = 0, cus = 0, per_cu = 0;
        if (hipGetDevice(&dev) != hipSuccess || hipDeviceGetAttribute(&cus, hipDeviceAttributeMultiprocessorCount, dev) != hipSuccess) { grid = -1; return; }
        if (hipFuncSetAttribute((const void*)fwd_kernel, hipFuncAttributeMaxDynamicSharedMemorySize, LDS_BYTES) != hipSuccess) { fprintf(stderr, "kernel_launch: hipFuncSetAttribute failed\n"); grid = -1; return; }
        if (hipOccupancyMaxActiveBlocksPerMultiprocessor(&per_cu, (const void*)fwd_kernel, NTH, LDS_BYTES) != hipSuccess || per_cu < 1) { fprintf(stderr, "kernel_launch: occupancy query says %d\n", per_cu); }
        (void)hipGetLastError();
        grid = cus;
    }
    if (grid < 0) return;
    (void)in_sizes; (void)out_size;
    hipMemsetAsync((char*)d_ws + WS_CTL, 0, 16384, stream);
    Params p{};
    for (int i = 0; i < 35; ++i) p.in[i] = (const float*)d_in[i];
    p.out = (float*)d_out; p.ws = (unsigned char*)d_ws;
    hipLaunchKernelGGL(fwd_kernel, dim3(grid), dim3(NTH), LDS_BYTES, stream, p);
}
```

```cpp
#include <hip/hip_runtime.h>
#include <cstdio>
#include <cstdint>
#define LAS __attribute__((address_space(3)))
typedef unsigned short bf16_t;
typedef short bf16x8 __attribute__((ext_vector_type(8)));
typedef short bf16x4 __attribute__((ext_vector_type(4)));
typedef float f32x4 __attribute__((ext_vector_type(4)));
typedef float f32x2 __attribute__((ext_vector_type(2)));
typedef float f32x16 __attribute__((ext_vector_type(16)));
typedef unsigned u32x4 __attribute__((ext_vector_type(4)));
typedef unsigned u32x2 __attribute__((ext_vector_type(2)));

constexpr int DM = 1024, NB = 8, SEQ = 4096, CTXL = 256, NL = 4;
constexpr int TL = NB * SEQ, TC = NB * CTXL, T = TL + TC;
constexpr int NTH = 512;
constexpr int INW = 2832;
constexpr int N1 = 6912;
constexpr int PJW = 2560;
constexpr int YCW = 1536;
constexpr int NEXP = 32, EFF = 1024;
constexpr int NCH = 34;
constexpr int MAXU = 576;
constexpr int RMAX = MAXU * 256;
constexpr float EPSN = 1e-6f;

constexpr size_t alup(size_t x) { return (x + 255) & ~size_t(255); }
constexpr size_t WS_CTL   = 0;
constexpr size_t WS_W1T   = 16384;
constexpr size_t WS_WFT   = WS_W1T   + alup((size_t)NL * N1 * 1024 * 2);
constexpr size_t WS_WBRT  = WS_WFT   + alup((size_t)NL * 512 * 1024 * 2);
constexpr size_t WS_WOUTT = WS_WBRT  + alup((size_t)NL * 1024 * YCW * 2);
constexpr size_t WS_WUPT  = WS_WOUTT + alup((size_t)NL * 1024 * 1024 * 2);
constexpr size_t WS_WDNT  = WS_WUPT  + alup((size_t)NL * 32 * 2048 * 1024 * 2);
constexpr size_t WS_D4C   = WS_WDNT  + alup((size_t)NL * 32 * 1024 * 1024 * 2);
constexpr size_t WS_D4S   = WS_D4C   + alup((size_t)4096 * 4096 * 2);
constexpr size_t WS_D256  = WS_D4S   + alup((size_t)4096 * 4096 * 2);
constexpr size_t WS_KRAW  = WS_D256  + alup((size_t)256 * 4096 * 2);
constexpr size_t WS_KPART = WS_KRAW  + alup((size_t)NL * 2 * 4096 * 512 * 4);
constexpr size_t WS_MOD   = WS_KPART + alup((size_t)NL * 2 * 64 * 512 * 4);
constexpr size_t WS_H     = WS_MOD   + alup((size_t)NL * 9 * 6144 * 4);
constexpr size_t WS_G     = WS_H     + alup((size_t)T * 1024 * 2);
constexpr size_t WS_PJ    = WS_G     + alup((size_t)T * 4096 * 2);
constexpr size_t WS_DTR   = WS_PJ    + alup((size_t)T * PJW * 2);
constexpr size_t WS_DT    = WS_DTR   + alup((size_t)T * 16 * 4);
constexpr size_t WS_VT    = WS_DT    + alup((size_t)T * 16 * 4);
constexpr size_t WS_VTC   = WS_VT    + alup((size_t)2048 * 8192 * 2);
constexpr size_t WS_YC    = WS_VTC   + alup((size_t)2048 * 8192 * 2);
constexpr size_t WS_XBN   = WS_YC    + alup((size_t)T * YCW * 2);
constexpr size_t WS_XST   = WS_XBN   + alup((size_t)T * 1024 * 2);
constexpr size_t WS_XSTC  = WS_XST   + alup((size_t)8 * 768 * 4096 * 2);
constexpr size_t WS_VVT   = WS_XSTC  + alup((size_t)8 * 768 * 256 * 2);
constexpr size_t WS_VVTC  = WS_VVT   + alup((size_t)8 * 256 * 4096 * 2);
constexpr size_t WS_CVT   = WS_VVTC  + alup((size_t)8 * 256 * 256 * 2);
constexpr size_t WS_CVTC  = WS_CVT   + alup((size_t)8 * 256 * 4096 * 4);
constexpr size_t WS_ST    = WS_CVTC  + alup((size_t)8 * 256 * 256 * 4);
constexpr size_t WS_HENT  = WS_ST    + alup((size_t)8 * 2 * 4 * 2 * NCH * 8192 * 4);
constexpr size_t WS_ACT   = WS_HENT  + alup((size_t)8 * 2 * 4 * 2 * NCH * 8192 * 2);
constexpr size_t WS_YD    = WS_ACT   + alup((size_t)8 * 2 * 4 * 2 * NCH * 4);
constexpr size_t WS_SSQ   = WS_YD    + alup((size_t)T * 512 * 4);
constexpr size_t WS_MG    = WS_SSQ   + alup((size_t)T * 8 * 4);
constexpr size_t WS_X1    = WS_MG    + alup((size_t)T * 1024 * 2);
constexpr size_t WS_XC    = WS_X1    + alup((size_t)T * 1024 * 4);
constexpr size_t WS_H2    = WS_XC    + alup((size_t)T * 1024 * 4);
constexpr size_t WS_TKE   = WS_H2    + alup((size_t)T * 1024 * 2);
constexpr size_t WS_TKW   = WS_TKE   + alup((size_t)T * 4 * 4);
constexpr size_t WS_BCNT  = WS_TKW   + alup((size_t)T * 4 * 4);
constexpr size_t WS_RTOK  = WS_BCNT  + alup((size_t)1024 * 32 * 4);
constexpr size_t WS_RPAIR = WS_RTOK  + alup((size_t)RMAX * 4);
constexpr size_t WS_RW    = WS_RPAIR + alup((size_t)RMAX * 4);
constexpr size_t WS_META  = WS_RW    + alup((size_t)RMAX * 4);
constexpr size_t WS_ACTB  = WS_META  + alup(256);
constexpr size_t WS_YP    = WS_ACTB  + alup((size_t)RMAX * 1024 * 2);
constexpr size_t WS_WRT   = WS_YP    + alup((size_t)T * 4 * 1024 * 2);
constexpr size_t WS_ACSG  = WS_WRT   + alup((size_t)NL * 2 * 32 * 1024 * 2);
constexpr size_t WS_END   = WS_ACSG  + alup((size_t)NB * 2 * NCH * 1024 * 4);

constexpr int LDS_BYTES = 155648;
constexpr int LDS_XB = LDS_BYTES - 64;

__device__ __forceinline__ unsigned cvt_pk_bf16(float lo, float hi) { typedef __bf16 bf2_t __attribute__((ext_vector_type(2))); const bf2_t v = {(__bf16)lo, (__bf16)hi}; return __builtin_bit_cast(unsigned, v); }
__device__ __forceinline__ bf16_t f2bf(float f) { return (bf16_t)(cvt_pk_bf16(f, 0.f) & 0xffffu); }
__device__ __forceinline__ float bf2f(bf16_t b) { return __uint_as_float(((unsigned)b) << 16); }
__device__ __forceinline__ float bflo(unsigned u) { return __uint_as_float(u << 16); }
__device__ __forceinline__ float bfhi(unsigned u) { return __uint_as_float(u & 0xffff0000u); }
template <int X> __device__ __forceinline__ float swz_xor(float v) { return __int_as_float(__builtin_amdgcn_ds_swizzle(__float_as_int(v), (X << 10) | 0x1f)); }
__device__ __forceinline__ float xor32_sum(float v) {
    typedef unsigned u2 __attribute__((ext_vector_type(2)));
    const u2 r = __builtin_amdgcn_permlane32_swap(__float_as_uint(v), __float_as_uint(v), false, false);
    return __uint_as_float(r[0]) + __uint_as_float(r[1]);
}
__device__ __forceinline__ float wave_sum(float v) {
    v += swz_xor<1>(v); v += swz_xor<2>(v); v += swz_xor<4>(v); v += swz_xor<8>(v); v += swz_xor<16>(v);
    return xor32_sum(v);
}
extern __shared__ __attribute__((aligned(16))) unsigned char dyn_smem[];
__device__ __forceinline__ LAS unsigned char* fresh_lds() { unsigned o = 0; asm volatile("" : "+s"(o)); return (LAS unsigned char*)dyn_smem + o; }
__device__ __forceinline__ unsigned char* fresh_smem() { return (unsigned char*)fresh_lds(); }
__device__ __forceinline__ int otid() { int t = threadIdx.x; asm volatile("" : "+v"(t)); return t; }
__device__ __forceinline__ int obid() { int t = blockIdx.x; asm volatile("" : "+s"(t)); return t; }
__device__ __forceinline__ int ouni(int t) { asm volatile("" : "+s"(t)); return t; }
__device__ __forceinline__ float fsigmoid(float x) { return __builtin_amdgcn_rcpf(1.f + __expf(-x)); }
__device__ __forceinline__ float fsilu(float x) { return x * fsigmoid(x); }
__device__ __forceinline__ float fsoftplus(float x) { return x > 20.f ? x : log1pf(expf(x)); }

#define XB_TMO      128
#define XB_XCNT(j)  (256  + 64 * (j))
#define XB_XSUB(j)  (1280 + 64 * (j))
#define XB_XGEN(j)  (2304 + 64 * (j))
#define XB_TOP      3328
#define XB_TOPGEN   3392
#define XCD_BAR_WORDS 3456
#define XB_SPIN_CAP (1u << 22)
__device__ __forceinline__ unsigned xb_ld(unsigned* p)              { return __hip_atomic_load(p, __ATOMIC_RELAXED, __HIP_MEMORY_SCOPE_AGENT); }
__device__ __forceinline__ unsigned xb_add(unsigned* p, unsigned v) { return __hip_atomic_fetch_add(p, v, __ATOMIC_RELAXED, __HIP_MEMORY_SCOPE_AGENT); }
__device__ __forceinline__ unsigned xb_xcc_id() { return (unsigned)__builtin_amdgcn_s_getreg((3 << 11) | 20) & 0xFu; }
#define XB_SPIN(cond, bar) do { unsigned _sp = 0; while (cond) { __builtin_amdgcn_s_sleep(1); \
    if ((++_sp & 255u) == 0u) { if (xb_ld(&(bar)[XB_TMO])) break; if (_sp > XB_SPIN_CAP) { atomicAdd(&(bar)[XB_TMO], 1u); break; } } } } while (0)
struct XcdBarrier { unsigned* bar; unsigned x; volatile LAS unsigned* st; };
__device__ __forceinline__ XcdBarrier xcd_barrier_post(unsigned* bar, volatile LAS unsigned* st) {
    XcdBarrier b; b.bar = bar; b.x = xb_xcc_id(); b.st = st;
    if (threadIdx.x == 0) (void)xb_add(&bar[XB_XCNT(b.x)], 1u);
    return b;
}
__device__ __forceinline__ void xcd_barrier_complete(unsigned* bar, unsigned x, unsigned& nloc, unsigned& nx) {
    const unsigned G = gridDim.x * gridDim.y * gridDim.z;
    unsigned sum, cnt, mine, sp = 0u;
    for (;;) {
        sum = 0u; cnt = 0u; mine = 0u;
#pragma unroll
        for (unsigned j = 0; j < 16; ++j) { const unsigned c = xb_ld(&bar[XB_XCNT(j)]); sum += c; cnt += (c > 0u) ? 1u : 0u; mine = (j == x) ? c : mine; }
        if (sum == G) break;
        __builtin_amdgcn_s_sleep(1);
        if ((++sp & 255u) == 0u) { if (xb_ld(&bar[XB_TMO])) break; if (sp > XB_SPIN_CAP) { atomicAdd(&bar[XB_TMO], 1u); break; } }
    }
    nloc = mine > 0u ? mine : 1u; nx = cnt > 0u ? cnt : 1u;
}
__device__ __forceinline__ void xcd_barrier(const XcdBarrier& b) {
    asm volatile("s_waitcnt vmcnt(0)" ::: "memory");
    __syncthreads();
    if (threadIdx.x == 0) {
        unsigned* bar = b.bar;
        __builtin_amdgcn_s_waitcnt(0);
        unsigned nloc = b.st[0], nx = b.st[1];
        if (nloc == 0u) { xcd_barrier_complete(bar, b.x, nloc, nx); b.st[0] = nloc; b.st[1] = nx; }
        const unsigned old = xb_add(&bar[XB_XSUB(b.x)], 1u);
        const unsigned gen = old / nloc;
        if (old + 1u == (gen + 1u) * nloc) {
            __builtin_amdgcn_fence(__ATOMIC_RELEASE, "agent");
            asm volatile("s_waitcnt vmcnt(0)" ::: "memory");
            const unsigned og = xb_add(&bar[XB_TOP], 1u);
            const unsigned tg = og / nx;
            if (og + 1u == (tg + 1u) * nx) xb_add(&bar[XB_TOPGEN], 1u);
            else XB_SPIN(xb_ld(&bar[XB_TOPGEN]) == tg, bar);
            __builtin_amdgcn_fence(__ATOMIC_ACQUIRE, "agent");
            xb_add(&bar[XB_XGEN(b.x)], 1u);
            asm volatile("s_waitcnt vmcnt(0)" ::: "memory");
        } else {
            XB_SPIN(xb_ld(&bar[XB_XGEN(b.x)]) == gen, bar);
            __builtin_amdgcn_fence(__ATOMIC_ACQUIRE, "agent");
            asm volatile("s_waitcnt vmcnt(0)" ::: "memory");
        }
    }
    __syncthreads();
}

namespace pg8 {
constexpr int BM = 256, BK = 64, HALF = 128, HTB = HALF * BK * 2, STAGE_BYTES = 8 * HTB, NXCD = 8, WGM = 8;
__host__ __device__ __forceinline__ int lds_byte(int r, int c) { const int st = (r >> 4) * 2 + (c >> 5), rr = r & 15, cc = c & 31, ob = rr * 64 + cc * 2; return st * 1024 + (ob ^ (((ob >> 9) & 1) << 5)); }
__host__ __device__ __forceinline__ void stage_rc(int b, int& R, int& C) { const int st = b / 1024, sb = b % 1024, swz = sb ^ (((sb >> 9) & 1) << 5); R = (st >> 1) * 16 + swz / 64; C = (st & 1) * 32 + (swz % 64) / 2; }
__host__ __device__ __forceinline__ int perm32(int rho) { const int n = rho >> 4, i = rho & 15; return 8 * (i >> 2) + 4 * n + (i & 3); }

__device__ __forceinline__ void remap_tile(int L, int nM, int nN, int& pm, int& pn) {
    const int nwg = nM * nN; int wgid = L;
    { const int q = nwg / NXCD, r = nwg % NXCD, xcd = wgid % NXCD, off = wgid / NXCD; wgid = (xcd < r ? xcd * (q + 1) : r * (q + 1) + (xcd - r) * q) + off; }
    const int nig = WGM * nN, gid = wgid / nig, fm = gid * WGM, gsz = (nM - fm) < WGM ? (nM - fm) : WGM;
    pm = fm + ((wgid % nig) % gsz); pn = (wgid % nig) / gsz;
}

struct GUnit { const char* a0; const char* a1; const char* b0; const char* b1; const int* gidx; int nt, pm, pn, kind, e; };

template <bool GATHER, class Src, class Epi>
__device__ __forceinline__ void gemm_phase(LAS unsigned char* lds, const Src& S, const Epi& E, const int lda, const int ldb) {
    const int tid = otid(), wid = __builtin_amdgcn_readfirstlane(tid >> 6), lane = tid & 63, wr = wid >> 2, wc = wid & 3, fr = lane & 15, fq = lane >> 4;
    unsigned voffA[2], voffB[2];
#pragma unroll
    for (int i = 0; i < 2; ++i) { int R, C; stage_rc(tid * 16 + i * 8192, R, C); const int Rb = (R & ~31) + perm32(R & 31);
        voffA[i] = (unsigned)(R * lda + C) * 2u; voffB[i] = (unsigned)(Rb * ldb + C) * 2u; }
    const size_t kstep = (size_t)(BK * 2);
    const unsigned ldsw = (unsigned)wid * 1024u;
    const int aoff = lds_byte(wr * 64 + fr, fq * 8), boff = lds_byte(wc * 32 + fr, fq * 8);
#define PG8_SA(b, h) (((b) * 2 + (h)) * HTB)
#define PG8_SB(b, h) ((4 + (b) * 2 + (h)) * HTB)
#define PG8_STAGE(bufoff, gbase, voff) do { _Pragma("unroll") for (int _i = 0; _i < 2; ++_i) \
        __builtin_amdgcn_global_load_lds((const unsigned*)((const char*)(gbase) + (voff)[_i]), (LAS unsigned*)(lds + (bufoff) + ldsw + _i * 8192), 16, 0, 0); } while (0)
#define PG8_LDA(dst, b, h) do { _Pragma("unroll") for (int m = 0; m < 4; ++m) _Pragma("unroll") for (int k = 0; k < 2; ++k) dst[m][k] = *(const LAS bf16x8*)(lds + PG8_SA(b, h) + aoff + m * 2048 + k * 1024); } while (0)
#define PG8_LDB(dst, b, h) do { _Pragma("unroll") for (int n = 0; n < 2; ++n) _Pragma("unroll") for (int k = 0; k < 2; ++k) dst[n][k] = *(const LAS bf16x8*)(lds + PG8_SB(b, h) + boff + n * 2048 + k * 1024); } while (0)
#define PG8_MMA(ai, bj, At, Bt) do { __builtin_amdgcn_s_setprio(1); _Pragma("unroll") for (int m = 0; m < 4; ++m) _Pragma("unroll") for (int n = 0; n < 2; ++n) _Pragma("unroll") for (int k = 0; k < 2; ++k) \
        acc[ai][bj][m][n] = __builtin_amdgcn_mfma_f32_16x16x32_bf16(Bt[n][k], At[m][k], acc[ai][bj][m][n], 0, 0, 0); __builtin_amdgcn_s_setprio(0); } while (0)
#define PG8_WAIT_V(n) asm volatile("s_waitcnt vmcnt(" #n ")" ::: "memory")
#define PG8_WAIT_L(n) asm volatile("s_waitcnt lgkmcnt(" #n ")" ::: "memory")
#define PG8_BAR __builtin_amdgcn_s_barrier()
#define PG8_SCHED __builtin_amdgcn_sched_barrier(0)
#define PG8_LOADV(u, v) do { int _tt = tid; asm volatile("" : "+v"(_tt)); _Pragma("unroll") for (int _i = 0; _i < 2; ++_i) { int _R, _C; stage_rc(_tt * 16 + _i * 8192, _R, _C); \
        _Pragma("unroll") for (int _h = 0; _h < 2; ++_h) { if constexpr (GATHER) v[_h][_i] = (unsigned)((u).gidx[_h * 128 + _R] * lda + _C) * 2u; else v[_h][_i] = voffA[_i]; } } } while (0)
    GUnit cur, nxt; int ui = 0;
    if (!S.get(0, cur)) return;
    f32x4 acc[2][2][4][2];
#pragma unroll
    for (int a = 0; a < 2; ++a)
#pragma unroll
        for (int b = 0; b < 2; ++b)
#pragma unroll
            for (int m = 0; m < 4; ++m)
#pragma unroll
                for (int n = 0; n < 2; ++n) acc[a][b][m][n] = (f32x4){0.f, 0.f, 0.f, 0.f};
    bf16x8 At[4][2], B0[2][2], B1[2][2];
    unsigned va[2][2];
    PG8_LOADV(cur, va);
    const char* cA0 = cur.a0; const char* cA1 = cur.a1; const char* cB0 = cur.b0; const char* cB1 = cur.b1;
    PG8_STAGE(PG8_SB(0, 0), cB0, voffB); PG8_STAGE(PG8_SA(0, 0), cA0, va[0]); PG8_STAGE(PG8_SB(0, 1), cB1, voffB); PG8_STAGE(PG8_SA(0, 1), cA1, va[1]);
    if (wr == 1) PG8_BAR;
    PG8_WAIT_V(4); PG8_BAR;
    PG8_STAGE(PG8_SB(1, 0), cB0 + kstep, voffB); PG8_STAGE(PG8_SA(1, 0), cA0 + kstep, va[0]); PG8_STAGE(PG8_SB(1, 1), cB1 + kstep, voffB);
    PG8_WAIT_V(6); PG8_BAR;
    for (;;) {
        const bool has_next = S.get(ui + 1, nxt);
        const char* nA0 = has_next ? nxt.a0 : cA0; const char* nA1 = has_next ? nxt.a1 : cA1;
        const char* nB0 = has_next ? nxt.b0 : cB0; const char* nB1 = has_next ? nxt.b1 : cB1;
        const int nt = cur.nt;
        for (int t = 0; t < nt; t += 2) {
            const bool last = (t == nt - 2);
            const char* a1h1 = cA1 + (size_t)(t + 1) * kstep;
            const char* a2h0 = last ? nA0 : cA0 + (size_t)(t + 2) * kstep; const char* a2h1 = last ? nA1 : cA1 + (size_t)(t + 2) * kstep;
            const char* b2h0 = last ? nB0 : cB0 + (size_t)(t + 2) * kstep; const char* b2h1 = last ? nB1 : cB1 + (size_t)(t + 2) * kstep;
            const char* a3h0 = a2h0 + kstep; const char* b3h0 = b2h0 + kstep; const char* b3h1 = b2h1 + kstep;
            PG8_LDB(B0, 0, 0); PG8_SCHED; PG8_LDA(At, 0, 0); PG8_STAGE(PG8_SA(1, 1), a1h1, va[1]);
            if constexpr (GATHER) { if (last && has_next) { PG8_LOADV(nxt, va); } }
            PG8_WAIT_L(8); PG8_BAR; PG8_WAIT_L(0); PG8_MMA(0, 0, At, B0); PG8_BAR; PG8_SCHED;
            PG8_LDB(B1, 0, 1); PG8_STAGE(PG8_SB(0, 0), b2h0, voffB);
            PG8_BAR; PG8_WAIT_L(0); PG8_MMA(0, 1, At, B1); PG8_BAR;
            PG8_LDA(At, 0, 1); PG8_STAGE(PG8_SA(0, 0), a2h0, va[0]);
            PG8_BAR; PG8_WAIT_L(0); PG8_MMA(1, 0, At, B0); PG8_BAR; PG8_SCHED;
            PG8_STAGE(PG8_SB(0, 1), b2h1, voffB);
            PG8_WAIT_V(6); PG8_BAR; PG8_MMA(1, 1, At, B1); PG8_BAR;
            PG8_LDB(B0, 1, 0); PG8_SCHED; PG8_LDA(At, 1, 0); PG8_STAGE(PG8_SA(0, 1), a2h1, va[1]);
            PG8_WAIT_L(8); PG8_BAR; PG8_WAIT_L(0); PG8_MMA(0, 0, At, B0); PG8_BAR; PG8_SCHED;
            PG8_LDB(B1, 1, 1); PG8_STAGE(PG8_SB(1, 0), b3h0, voffB);
            PG8_BAR; PG8_WAIT_L(0); PG8_MMA(0, 1, At, B1); PG8_BAR;
            PG8_LDA(At, 1, 1); PG8_STAGE(PG8_SA(1, 0), a3h0, va[0]);
            PG8_BAR; PG8_WAIT_L(0); PG8_MMA(1, 0, At, B0); PG8_BAR; PG8_SCHED;
            PG8_STAGE(PG8_SB(1, 1), b3h1, voffB);
            PG8_WAIT_V(6); PG8_BAR; PG8_MMA(1, 1, At, B1); PG8_BAR;
        }
        E(acc, cur, wr, wc, fr, fq);
        if (!has_next) break;
#pragma unroll
        for (int a = 0; a < 2; ++a)
#pragma unroll
            for (int b = 0; b < 2; ++b)
#pragma unroll
                for (int m = 0; m < 4; ++m)
#pragma unroll
                    for (int n = 0; n < 2; ++n) acc[a][b][m][n] = (f32x4){0.f, 0.f, 0.f, 0.f};
        cur = nxt; cA0 = nA0; cA1 = nA1; cB0 = nB0; cB1 = nB1; ++ui;
    }
    PG8_WAIT_V(0);
    if (wr == 0) PG8_BAR;
    PG8_BAR;
#undef PG8_SA
#undef PG8_SB
#undef PG8_STAGE
#undef PG8_LDA
#undef PG8_LDB
#undef PG8_MMA
#undef PG8_WAIT_V
#undef PG8_WAIT_L
#undef PG8_BAR
#undef PG8_SCHED
#undef PG8_LOADV
}
}
using pg8::GUnit;

struct Params { const float* in[35]; float* out; unsigned char* ws; };
typedef const Params __attribute__((address_space(4))) CParams;
__device__ __forceinline__ CParams* kparams() { CParams* p = (CParams*)__builtin_amdgcn_kernarg_segment_ptr(); asm volatile("" : "+s"(p)); return p; }
enum { I_X = 0, I_C, I_CTX, I_CCTX, I_WMOD, I_BMOD, I_NMIX, I_NFFN, I_WIN, I_HCW, I_HCB, I_HW1, I_HB1, I_HW2, I_HB2, I_HW3, I_HBIAS, I_PW, I_PS,
       I_SCW, I_SCB, I_SDTB, I_SALOG, I_SD, I_SNORM, I_WBR, I_WGATE, I_WOUT, I_RW, I_RB, I_WUP, I_BUP, I_WDN, I_BDN, I_NFIN };

__device__ __forceinline__ int tok_modj(int t) { return t < TL ? (t >> 12) : 8; }

struct TJob { const float* src; size_t ld_src; int K, N; bf16_t* dst; size_t ld_dst; int nmat; size_t src_ms, dst_ms; const float* kscale; };
__device__ __forceinline__ TJob make_tjob(CParams& P, int l, int j) {
    unsigned char* ws = P.ws; TJob J;
    bf16_t* W1T = (bf16_t*)(ws + WS_W1T) + (size_t)l * N1 * 1024;
    bf16_t* WBRT = (bf16_t*)(ws + WS_WBRT) + (size_t)l * 1024 * YCW;
    const float* wbr = P.in[I_WBR] + (size_t)l * 1280 * 1024;
    J.kscale = nullptr; J.nmat = 1; J.src_ms = 0; J.dst_ms = 0; J.ld_src = 1024; J.K = 1024; J.N = 1024; J.ld_dst = 1024;
    if (j == 0) { J.src = P.in[I_WGATE] + (size_t)l * 4 * 1024 * 1024; J.dst = W1T; J.nmat = 4; J.src_ms = (size_t)1024 * 1024; J.dst_ms = (size_t)1024 * 1024; }
    else if (j == 1) { J.src = P.in[I_WIN] + (size_t)l * 1024 * INW + 256; J.ld_src = INW; J.N = 2576; J.dst = W1T + (size_t)4096 * 1024; }
    else if (j == 2) { J.src = wbr; J.K = 256; J.dst = WBRT; J.ld_dst = YCW; }
    else if (j == 3) { J.src = wbr; J.K = 256; J.dst = WBRT + 256; J.ld_dst = YCW; }
    else if (j == 4) { J.src = wbr + (size_t)256 * 1024; J.K = 256; J.dst = WBRT + 512; J.ld_dst = YCW; }
    else if (j == 5) { J.src = wbr + (size_t)768 * 1024; J.K = 512; J.dst = WBRT + 1024; J.ld_dst = YCW; J.kscale = P.in[I_SNORM] + l * 512; }
    else if (j == 6) { J.src = P.in[I_WOUT] + (size_t)l * 1024 * 1024; J.dst = (bf16_t*)(ws + WS_WOUTT) + (size_t)l * 1024 * 1024; }
    else if (j == 7) { J.src = P.in[I_WUP] + (size_t)l * 32 * 1024 * 2048; J.ld_src = 2048; J.N = 2048; J.dst = (bf16_t*)(ws + WS_WUPT) + (size_t)l * 32 * 2048 * 1024; J.nmat = 32; J.src_ms = (size_t)1024 * 2048; J.dst_ms = (size_t)2048 * 1024; }
    else { J.src = P.in[I_WDN] + (size_t)l * 32 * 1024 * 1024; J.dst = (bf16_t*)(ws + WS_WDNT) + (size_t)l * 32 * 1024 * 1024; J.nmat = 32; J.src_ms = (size_t)1024 * 1024; J.dst_ms = (size_t)1024 * 1024; }
    return J;
}
constexpr int MOE_TILES_P0 = 640;
constexpr int TILES_DENSE = 256 + 176 + 16 + 16 + 16 + 32 + 64, TILES_PER_LAYER = TILES_DENSE + 4096 + 2048;
struct TRef { const float* sr; bf16_t* d; size_t ld_dst; int nval; float sc; };
__device__ __forceinline__ TRef tile_locate(CParams& P, int g, int tid) {
    constexpr int PER_L = 256 + 176 + 16 + 16 + 16 + 32 + 64 + 4096 + 2048;
    const int l = g / PER_L; int r = g % PER_L, j = 0;
    const int cnt[9] = {256, 176, 16, 16, 16, 32, 64, 4096, 2048};
#pragma unroll
    for (int q = 0; q < 8; ++q) { if (j == q && r >= cnt[q]) { r -= cnt[q]; j = q + 1; } }
    const TJob J = make_tjob(P, l, j);
    const int ktiles = J.K / 64, ntiles = (J.N + 255) / 256, per = ktiles * ntiles;
    const int mat = r / per, rr = r % per, nt = rr / ktiles, kt = rr % ktiles;
    TRef T; const int row = tid >> 3;
    T.sr = J.src + (size_t)mat * J.src_ms + (size_t)(kt * 64 + row) * J.ld_src + nt * 256;
    T.d = J.dst + (size_t)mat * J.dst_ms + (size_t)(nt * 256) * J.ld_dst + kt * 64; T.ld_dst = J.ld_dst;
    T.nval = (J.N - nt * 256) < 256 ? (J.N - nt * 256) : 256;
    T.sc = J.kscale ? J.kscale[kt * 64 + row] : 1.f;
    return T;
}
__device__ __forceinline__ void p0_transposes(CParams& P, unsigned char* smem, int lo, int hi, int part, int nparts) {
    float* tile = (float*)smem;
    const int tid = otid(); const int G = nparts, TOTAL = hi;
    const int row = tid >> 3, c0 = (tid & 7) * 4;
    int g = lo + part; bool have = g < TOTAL;
    TRef T = tile_locate(P, have ? g : lo, tid);
    f32x4 v[8];
#pragma unroll
    for (int j = 0; j < 8; ++j) { const int c = c0 + 32 * j; v[j] = (have && c < T.nval) ? *(const f32x4*)(T.sr + c) : (f32x4){0.f, 0.f, 0.f, 0.f}; }
#pragma unroll 1
    while (have) {
        const int gn = g + G; const bool hasn = gn < TOTAL;
        __syncthreads();
#pragma unroll
        for (int j = 0; j < 8; ++j) { float* tp = tile + row * 257 + c0 + 32 * j; tp[0] = v[j][0] * T.sc; tp[1] = v[j][1] * T.sc; tp[2] = v[j][2] * T.sc; tp[3] = v[j][3] * T.sc; }
        bf16_t* d = T.d; const size_t ldd = T.ld_dst; const int nval = T.nval;
        if (hasn) { T = tile_locate(P, gn, tid);
#pragma unroll
            for (int j = 0; j < 8; ++j) { const int c = c0 + 32 * j; v[j] = (c < T.nval) ? *(const f32x4*)(T.sr + c) : (f32x4){0.f, 0.f, 0.f, 0.f}; } }
        __syncthreads();
        { const int n = tid >> 1, kh = (tid & 1) * 32;
          if (n < nval) {
#pragma unroll
              for (int q = 0; q < 4; ++q) { u32x4 o;
#pragma unroll
                  for (int e = 0; e < 4; ++e) o[e] = cvt_pk_bf16(tile[(kh + q * 8 + 2 * e) * 257 + n], tile[(kh + q * 8 + 2 * e + 1) * 257 + n]);
                  *(u32x4*)(d + (size_t)n * ldd + kh + q * 8) = o; } } }
        g = gn; have = hasn;
    }
    __syncthreads();
}

__device__ __forceinline__ void p0_prep(CParams& P, unsigned char* smem) {
    const int G = gridDim.x, tid = otid(), bid = obid();
    unsigned char* ws = P.ws;
    for (int l = 0; l < NL; ++l) p0_transposes(P, smem, l * TILES_PER_LAYER, l * TILES_PER_LAYER + TILES_DENSE + MOE_TILES_P0, bid, G);
    {
        float* wt = (float*)smem;
        float* ctab = wt + 64 * 65; float* stab = ctab + 64;
        if (tid < 64) { float s, c; sincospif((float)tid / 32.f, &s, &c); ctab[tid] = c * 0.125f; stab[tid] = s * 0.125f; }
        for (int it = bid; it < NL * 4 * 16; it += G) {
            const int l = it / 64, g = (it / 16) & 3, kb = it & 15;
            __syncthreads();
            { const int row = tid >> 3, c0 = (tid & 7) * 8; const float* sr = P.in[I_WIN] + ((size_t)l * 1024 + kb * 64 + row) * INW + g * 64 + c0;
#pragma unroll
              for (int j = 0; j < 8; ++j) wt[row * 65 + c0 + j] = sr[j]; }
            __syncthreads();
            const int rp = tid >> 2, kq = tid & 3, half = rp >> 6, cp = rp & 63;
            const float* tab = half ? stab : ctab;
            float o[16];
#pragma unroll
            for (int kk = 0; kk < 16; ++kk) o[kk] = 0.f;
            for (int c = 0; c < 64; ++c) { const float tv = tab[(c * cp) & 63];
#pragma unroll
                for (int kk = 0; kk < 16; ++kk) o[kk] += wt[(kq * 16 + kk) * 65 + c] * tv; }
            bf16_t* d = (bf16_t*)(ws + WS_WFT) + ((size_t)l * 512 + (g * 2 + half) * 64 + cp) * 1024 + kb * 64 + kq * 16;
            u32x4 o0, o1;
#pragma unroll
            for (int e = 0; e < 4; ++e) { o0[e] = cvt_pk_bf16(o[2 * e], o[2 * e + 1]); o1[e] = cvt_pk_bf16(o[8 + 2 * e], o[8 + 2 * e + 1]); }
            *(u32x4*)d = o0; *(u32x4*)(d + 8) = o1;
        }
        __syncthreads();
    }
    {
        float* pw = (float*)smem;
        float* wb = pw + 64 * 65;
        for (int it = bid; it < NL * 4 * 4; it += G) {
            const int l = it / 16, g = (it / 4) & 3, nb = it & 3;
            __syncthreads();
            for (int e = tid; e < 4096; e += NTH) { const int c = e >> 6, d = e & 63;
                pw[c * 65 + d] = P.in[I_PW][(((size_t)l * 4 + g) * 64 + c) * 64 + d] * P.in[I_PS][l * 256 + g * 64 + d]; }
            for (int e = tid; e < 64 * 256; e += NTH) { const int d = e >> 8, n = e & 255;
                wb[d * 257 + n] = P.in[I_WBR][((size_t)l * 1280 + 512 + g * 64 + d) * 1024 + nb * 256 + n]; }
            __syncthreads();
            const int n = tid & 255, ch = tid >> 8;
            bf16_t* d0 = (bf16_t*)(ws + WS_WBRT) + ((size_t)l * 1024 + nb * 256 + n) * YCW + 768 + g * 64 + ch * 32;
            float o[32];
#pragma unroll
            for (int e = 0; e < 32; ++e) o[e] = 0.f;
#pragma unroll 1
            for (int d = 0; d < 64; ++d) { const float wv = wb[d * 257 + n];
#pragma unroll
                for (int e = 0; e < 32; ++e) o[e] += pw[(ch * 32 + e) * 65 + d] * wv; }
#pragma unroll
            for (int q = 0; q < 4; ++q) { u32x4 ov;
#pragma unroll
                for (int e = 0; e < 4; ++e) ov[e] = cvt_pk_bf16(o[q * 8 + 2 * e], o[q * 8 + 2 * e + 1]);
                *(u32x4*)(d0 + q * 8) = ov; }
        }
        __syncthreads();
    }
    {
        bf16_t* D4C = (bf16_t*)(ws + WS_D4C); bf16_t* D4S = (bf16_t*)(ws + WS_D4S); bf16_t* D256 = (bf16_t*)(ws + WS_D256);
        const int gth = bid * NTH + tid, nth = G * NTH;
        for (int ch = gth; ch < 2048 * 512; ch += nth) {
            const int pp = ch >> 9, p0 = (ch & 511) * 8;
            u32x4 oc, os; float cv[8], sv[8];
#pragma unroll
            for (int e = 0; e < 8; ++e) { const int j = (pp * (p0 + e)) & 4095; float s, c; sincospif((float)j / 2048.f, &s, &c); cv[e] = c * (1.f / 64.f); sv[e] = -s * (1.f / 64.f); }
#pragma unroll
            for (int e = 0; e < 4; ++e) { oc[e] = cvt_pk_bf16(cv[2 * e], cv[2 * e + 1]); os[e] = cvt_pk_bf16(sv[2 * e], sv[2 * e + 1]); }
            *(u32x4*)(D4C + (size_t)pp * 4096 + p0) = oc; *(u32x4*)(D4S + (size_t)pp * 4096 + p0) = os;
        }
        for (int ch = gth; ch < 256 * 64; ch += nth) {
            const int pp = ch >> 6, k0 = (ch & 63) * 8; u32x4 o; float v[8];
#pragma unroll
            for (int e = 0; e < 8; ++e) { const int k = k0 + e; const int j = (pp * (k & 255)) & 255; float s, c; sincospif((float)j / 128.f, &s, &c); v[e] = (k < 256 ? c : -s) * (1.f / 16.f); }
#pragma unroll
            for (int e = 0; e < 4; ++e) o[e] = cvt_pk_bf16(v[2 * e], v[2 * e + 1]);
            *(u32x4*)(D256 + (size_t)pp * 4096 + k0) = o;
        }
    }
    {
        float* feats = (float*)smem;
        float* h1 = feats + 64 * 33;
        float* h2 = h1 + 64 * 65;
        const float dmin = 4.605170185988091f / 1.5f, dmax = 4.605170185988091f / 0.3f;
        for (int it = bid; it < NL * 68; it += G) {
            const int l = it / 68, r = it % 68, cfg = r < 64 ? 0 : 1, tile = cfg ? r - 64 : r, n = cfg ? 256 : 4096;
            __syncthreads();
            for (int e = tid; e < 64 * 33; e += NTH) { const int i = e / 33, f = e % 33; const int pos = tile * 64 + i;
                float v;
                if (f == 0) v = (float)pos / (float)(n - 1);
                else { const int j = (f - 1) & 15; const float fr = 1e-4f + (float)j * ((15.f - 1e-4f) / 15.f);
                       const float ang = 6.283185307179586f * (float)pos / (float)n * fr; v = (f <= 16) ? cosf(ang) : -sinf(ang); }
                feats[e] = v; }
            __syncthreads();
            { const int j = tid & 63, pg = tid >> 6; const float* w1 = P.in[I_HW1] + (size_t)l * 33 * 64; const float b = P.in[I_HB1][l * 64 + j];
              for (int q = 0; q < 8; ++q) { const int i = pg * 8 + q; float s = b; for (int f = 0; f < 33; ++f) s += feats[i * 33 + f] * w1[f * 64 + j]; h1[i * 65 + j] = sinf(s); } }
            __syncthreads();
            { const int j = tid & 63, pg = tid >> 6; const float* w2 = P.in[I_HW2] + (size_t)l * 64 * 64; const float b = P.in[I_HB2][l * 64 + j];
              for (int q = 0; q < 8; ++q) { const int i = pg * 8 + q; float s = b; for (int f = 0; f < 64; ++f) s += h1[i * 65 + f] * w2[f * 64 + j]; h2[i * 65 + j] = sinf(s); } }
            __syncthreads();
            { const int o = tid, c = o & 255, dir = o >> 8; const float* w3 = P.in[I_HW3] + (size_t)l * 64 * 512;
              float w[64];
#pragma unroll
              for (int f = 0; f < 64; ++f) w[f] = w3[f * 512 + o];
              const float delta = dmin + (float)c * ((dmax - dmin) / 255.f);
              float* kst = h2 + 64 * 65;
              float* kt = (float*)(ws + WS_KRAW) + ((size_t)l * 2 + cfg) * 512 * 4096 + tile * 64;
              float asum = 0.f;
#pragma unroll 1
              for (int i0 = 0; i0 < 64; i0 += 16) {
#pragma unroll 1
                  for (int ii = 0; ii < 16; ++ii) { const int i = i0 + ii; float s = 0.f;
#pragma unroll
                      for (int f = 0; f < 64; ++f) s += h2[i * 65 + f] * w[f];
                      const int pos = tile * 64 + i; const float tt = (float)pos / (float)(n - 1);
                      s *= expf(-tt * delta);
                      kst[o * 17 + ii] = s;
                      if (!(dir == 1 && pos == 0)) asum += fabsf(s); }
                  __syncthreads();
#pragma unroll
                  for (int q = 0; q < 4; ++q) { const int ch = tid + q * NTH, oo = ch >> 2, j = (ch & 3) * 4; const float* sp = kst + oo * 17 + j;
                      *(f32x4*)(kt + (size_t)oo * 4096 + i0 + j) = (f32x4){sp[0], sp[1], sp[2], sp[3]}; }
                  __syncthreads();
              }
              ((float*)(ws + WS_KPART))[(((size_t)l * 2 + cfg) * 64 + tile) * 512 + o] = asum; }
        }
        __syncthreads();
    }
    for (int e = bid * NTH + tid; e < NL * 32 * 1024; e += G * NTH) { const int l = e >> 15, ex = (e >> 10) & 31, k = e & 1023;
        const float wv = P.in[I_RW][((size_t)l * 1024 + k) * 32 + ex]; const bf16_t hi = f2bf(wv); const bf16_t lo = f2bf(wv - bf2f(hi));
        bf16_t* d = (bf16_t*)(ws + WS_WRT) + (size_t)l * 2 * 32 * 1024 + (size_t)ex * 1024 + k; d[0] = hi; d[32 * 1024] = lo; }
    {
        float* sc = (float*)smem;
        float* red = sc + 9 * 1024;
        for (int it = bid; it < NL * 24; it += G) {
            const int l = it / 24, nb = it % 24;
            __syncthreads();
            for (int e = tid; e < 9 * 1024; e += NTH) { const int j = e >> 10, k = e & 1023; const float v = j < 8 ? P.in[I_C][j * 1024 + k] : P.in[I_CCTX][k]; sc[e] = fsilu(v); }
            __syncthreads();
            const int n = nb * 256 + (tid & 255), kh = tid >> 8;
            const float* w = P.in[I_WMOD] + (size_t)l * 1024 * 6144 + n;
            float a[9];
#pragma unroll
            for (int j = 0; j < 9; ++j) a[j] = 0.f;
#pragma unroll 8
            for (int k = kh * 512; k < kh * 512 + 512; ++k) { const float wv = w[(size_t)k * 6144];
#pragma unroll
                for (int j = 0; j < 9; ++j) a[j] += sc[j * 1024 + k] * wv; }
            if (kh == 1) {
#pragma unroll
                for (int j = 0; j < 9; ++j) red[(tid & 255) * 9 + j] = a[j]; }
            __syncthreads();
            if (kh == 0) { const float b = P.in[I_BMOD][l * 6144 + n];
#pragma unroll
                for (int j = 0; j < 9; ++j) ((float*)(ws + WS_MOD))[((size_t)l * 9 + j) * 6144 + n] = a[j] + red[(tid & 255) * 9 + j] + b; }
        }
        __syncthreads();
    }
}

__device__ __forceinline__ void norm_row_store(const f32x4 (&v)[4], const float* gain, const float* sc, const float* sh, bf16_t* dst, int lane) {
    float ss = 0.f;
#pragma unroll
    for (int q = 0; q < 4; ++q) ss += v[q][0] * v[q][0] + v[q][1] * v[q][1] + v[q][2] * v[q][2] + v[q][3] * v[q][3];
    ss = wave_sum(ss);
    const float rs = rsqrtf(ss * (1.f / 1024.f) + EPSN);
#pragma unroll
    for (int q = 0; q < 4; ++q) { const int c = q * 256 + lane * 4;
        const f32x4 g = *(const f32x4*)(gain + c), a = *(const f32x4*)(sc + c), b = *(const f32x4*)(sh + c);
        u32x2 o; o[0] = cvt_pk_bf16(v[q][0] * rs * g[0] * (1.f + a[0]) + b[0], v[q][1] * rs * g[1] * (1.f + a[1]) + b[1]);
        o[1] = cvt_pk_bf16(v[q][2] * rs * g[2] * (1.f + a[2]) + b[2], v[q][3] * rs * g[3] * (1.f + a[3]) + b[3]);
        *(u32x2*)(dst + c) = o; }
}
__device__ __forceinline__ void p1_norm0(CParams& P) {
    const int tid_ = otid(), lane = tid_ & 63, w = (obid() * NTH + tid_) >> 6, nw = gridDim.x * (NTH / 64);
    bf16_t* H = (bf16_t*)(P.ws + WS_H); const float* MOD = (const float*)(P.ws + WS_MOD);
    for (int t = w; t < T; t += nw) {
        const float* src = t < TL ? P.in[I_X] + (size_t)t * 1024 : P.in[I_CTX] + (size_t)(t - TL) * 1024;
        f32x4 v[4];
#pragma unroll
        for (int q = 0; q < 4; ++q) v[q] = *(const f32x4*)(src + q * 256 + lane * 4);
        const float* md = MOD + (size_t)tok_modj(t) * 6144;
        norm_row_store(v, P.in[I_NMIX], md + 1024, md, H + (size_t)t * 1024, lane);
    }
}

#ifndef EXP_P3
#define EXP_P3 0
#endif
struct TileGeo { int tok0, b, pos0, slen, isctx; };
__device__ __forceinline__ TileGeo tile_geo(int tt) {
    TileGeo g; g.tok0 = tt * 64;
    if (g.tok0 < TL) { g.isctx = 0; g.b = g.tok0 >> 12; g.pos0 = g.tok0 & 4095; g.slen = 4096; }
    else { g.isctx = 1; const int r = g.tok0 - TL; g.b = r >> 8; g.pos0 = r & 255; g.slen = 256; }
    return g;
}
__device__ __forceinline__ void unpack4(u32x2 u, float (&o)[4]) { o[0] = bflo(u[0]); o[1] = bfhi(u[0]); o[2] = bflo(u[1]); o[3] = bfhi(u[1]); }
__device__ __forceinline__ void unpack8(u32x4 u, float (&o)[8]) {
#pragma unroll
    for (int e = 0; e < 4; ++e) { o[2 * e] = bflo(u[e]); o[2 * e + 1] = bfhi(u[e]); } }

__device__ __forceinline__ void p3_prep(CParams& P, unsigned char* smem, int l) {
    const int G = gridDim.x, tid = otid(), bid = obid();
    unsigned char* ws = P.ws;
    const bf16_t* PJ = (const bf16_t*)(ws + WS_PJ);
    if (!(EXP_P3 & 1)) {
        bf16_t* vvL = (bf16_t*)smem;
        const int c4 = tid & 63, tq = tid >> 6;
        const float* cw = P.in[I_HCW] + (size_t)l * 3 * 768; const float* cb = P.in[I_HCB] + (size_t)l * 768;
        float wx[3][4], wv[3][4], bx[4], bv[4];
#pragma unroll
        for (int e = 0; e < 4; ++e) { bx[e] = cb[256 + 4 * c4 + e]; bv[e] = cb[512 + 4 * c4 + e];
#pragma unroll
            for (int k = 0; k < 3; ++k) { wx[k][e] = cw[k * 768 + 256 + 4 * c4 + e]; wv[k][e] = cw[k * 768 + 512 + 4 * c4 + e]; } }
        u32x2 xq[10], vq[10]; bool okq[10];
#define P3A_REQ(ttx) do { const TileGeo g_ = tile_geo(ttx); const int p0_ = g_.pos0 + tq * 8; const bf16_t* rowp_ = PJ + (size_t)(g_.tok0 + tq * 8) * PJW; \
            _Pragma("unroll") for (int j = 0; j < 10; ++j) { const int pp = p0_ + j - 1; okq[j] = (pp >= 0 && pp < g_.slen); const bf16_t* rp = rowp_ + (ptrdiff_t)(okq[j] ? j - 1 : 0) * PJW; \
                xq[j] = *(const u32x2*)(rp + 256 + 4 * c4); vq[j] = *(const u32x2*)(rp + 512 + 4 * c4); } } while (0)
        int tt = bid;
        if (tt < T / 64) P3A_REQ(tt);
#pragma unroll 1
        for (; tt < T / 64; tt += G) {
            const TileGeo g = tile_geo(tt);
            float rx[3][4], rv[3][4], vva[8][4];
#define P3A_ROW(k, j) do { unpack4(xq[j], rx[k]); unpack4(vq[j], rv[k]); _Pragma("unroll") for (int e = 0; e < 4; ++e) { rx[k][e] = okq[j] ? rx[k][e] : 0.f; rv[k][e] = okq[j] ? rv[k][e] : 0.f; } } while (0)
            P3A_ROW(0, 0); P3A_ROW(1, 1);
#pragma unroll
            for (int j = 0; j < 8; ++j) {
                P3A_ROW(2, j + 2);
#pragma unroll
                for (int e = 0; e < 4; ++e) {
                    const float x2 = wx[0][e] * rx[0][e] + wx[1][e] * rx[1][e] + wx[2][e] * rx[2][e] + bx[e];
                    const float vv = wv[0][e] * rv[0][e] + wv[1][e] * rv[1][e] + wv[2][e] * rv[2][e] + bv[e];
                    vva[j][e] = x2 * vv;
                    rx[0][e] = rx[1][e]; rx[1][e] = rx[2][e]; rv[0][e] = rv[1][e]; rv[1][e] = rv[2][e]; }
            }
#undef P3A_ROW
#pragma unroll
            for (int e = 0; e < 4; ++e) { u32x4 o4;
#pragma unroll
                for (int p = 0; p < 4; ++p) o4[p] = cvt_pk_bf16(vva[2 * p][e], vva[2 * p + 1][e]);
                *(u32x4*)(vvL + (4 * c4 + e) * 72 + ((tq + (c4 & 7)) & 7) * 8) = o4; }
            if (tt + G < T / 64) P3A_REQ(tt + G);
            __syncthreads();
            { const int c = tid >> 1, hf = tid & 1;
              bf16_t* d = g.isctx ? (bf16_t*)(ws + WS_VVTC) + ((size_t)g.b * 256 + c) * 256 + g.pos0 + hf * 32
                                  : (bf16_t*)(ws + WS_VVT) + ((size_t)g.b * 256 + c) * 4096 + g.pos0 + hf * 32;
#pragma unroll
              for (int q = 0; q < 4; ++q) *(u32x4*)(d + q * 8) = *(const u32x4*)(vvL + c * 72 + (((hf * 4 + q) + ((c >> 2) & 7)) & 7) * 8); }
            __syncthreads();
        }
#undef P3A_REQ
    }
    if (!(EXP_P3 & 2)) {
        bf16_t* YC = (bf16_t*)(ws + WS_YC);
        const int c8 = tid & 31, ts = tid >> 5;
        const int gi = c8 >> 3, hw = 1 << gi;
        for (int tt = (bid + 85) % G; tt < T / 64; tt += G) {
            const TileGeo g = tile_geo(tt);
            const int rlen = g.isctx ? 256 : 64;
            const int tl0 = ts * 4, rpos0 = (g.pos0 + tl0) % rlen;
            const bf16_t* base = PJ + (size_t)(g.tok0 + tl0 - rpos0) * PJW + 768 + 8 * c8;
            float sm4[4][8], self[4][8];
#pragma unroll
            for (int q = 0; q < 4; ++q)
#pragma unroll
                for (int e = 0; e < 8; ++e) sm4[q][e] = 0.f;
            u32x4 rw[19];
#pragma unroll
            for (int dj = -8; dj < 11; ++dj) { int j = rpos0 + dj; j = j < 0 ? 0 : (j >= rlen ? rlen - 1 : j); rw[dj + 8] = *(const u32x4*)(base + (size_t)j * PJW); }
#pragma unroll
            for (int dj = -8; dj < 11; ++dj) {
                const int j = rpos0 + dj; const bool inrow = (j >= 0 && j < rlen);
                float v[8]; unpack8(rw[dj + 8], v);
#pragma unroll
                for (int q = 0; q < 4; ++q) {
                    const bool inw = inrow && dj >= q - hw && dj < q + hw;
#pragma unroll
                    for (int e = 0; e < 8; ++e) sm4[q][e] += inw ? v[e] : 0.f;
                    if (dj == q) {
#pragma unroll
                        for (int e = 0; e < 8; ++e) self[q][e] = v[e]; } }
            }
#pragma unroll
            for (int q = 0; q < 4; ++q) {
                const int rpos = rpos0 + q; int lo = rpos - hw; lo = lo < 0 ? 0 : lo; int hi = rpos + hw; hi = hi > rlen ? rlen : hi;
                const float inv = 1.f / (float)(hi - lo);
                u32x4 o;
#pragma unroll
                for (int e = 0; e < 4; ++e) o[e] = cvt_pk_bf16(sm4[q][2 * e] * inv - self[q][2 * e], sm4[q][2 * e + 1] * inv - self[q][2 * e + 1]);
                *(u32x4*)(YC + (size_t)(g.tok0 + tl0 + q) * YCW + 768 + 8 * c8) = o;
            }
        }
    }
    if (!(EXP_P3 & 4)) {
        bf16_t* xsL = (bf16_t*)smem;
        bf16_t* XBN = (bf16_t*)(ws + WS_XBN);
        const int c8 = tid & 127, tq = tid >> 7;
        const float* cw = P.in[I_SCW] + (size_t)l * 3 * 1024; const float* cb = P.in[I_SCB] + (size_t)l * 1024;
        float w[3][8], bb[8];
#pragma unroll
        for (int e = 0; e < 8; ++e) { bb[e] = cb[8 * c8 + e];
#pragma unroll
            for (int k = 0; k < 3; ++k) w[k][e] = cw[k * 1024 + 8 * c8 + e]; }
        u32x4 rw[18]; bool okr[18];
#define P3C_REQ(ttx) do { const TileGeo g_ = tile_geo(ttx); const int p0_ = g_.pos0 + tq * 16; const bf16_t* rowp_ = PJ + (size_t)(g_.tok0 + tq * 16) * PJW + 1536 + 8 * c8; \
            _Pragma("unroll") for (int j = 0; j < 18; ++j) { const int pp = p0_ + j - 1; okr[j] = (pp >= 0 && pp < g_.slen); rw[j] = *(const u32x4*)(rowp_ + (ptrdiff_t)(okr[j] ? j - 1 : 0) * PJW); } } while (0)
        int tt = (bid + 170) % G;
        if (tt < T / 64) P3C_REQ(tt);
#pragma unroll 1
        for (; tt < T / 64; tt += G) {
            const TileGeo g = tile_geo(tt);
            float r0[8], r1[8], r2[8]; u32x4 oall[16];
            unpack8(rw[0], r0); unpack8(rw[1], r1);
#pragma unroll
            for (int e = 0; e < 8; ++e) { r0[e] = okr[0] ? r0[e] : 0.f; r1[e] = okr[1] ? r1[e] : 0.f; }
#pragma unroll
            for (int j = 0; j < 16; ++j) {
                unpack8(rw[j + 2], r2);
#pragma unroll
                for (int e = 0; e < 8; ++e) r2[e] = okr[j + 2] ? r2[e] : 0.f;
                float o[8];
#pragma unroll
                for (int e = 0; e < 8; ++e) { o[e] = fsilu(w[0][e] * r0[e] + w[1][e] * r1[e] + w[2][e] * r2[e] + bb[e]); r0[e] = r1[e]; r1[e] = r2[e]; }
                u32x4 ov;
#pragma unroll
                for (int e = 0; e < 4; ++e) ov[e] = cvt_pk_bf16(o[2 * e], o[2 * e + 1]);
                *(u32x4*)(XBN + (size_t)(g.tok0 + tq * 16 + j) * 1024 + 8 * c8) = ov;
                oall[j] = ov;
            }
            if (c8 < 96) {
#pragma unroll
                for (int e = 0; e < 8; ++e) { u32x4 lo4, hi4;
#pragma unroll
                    for (int p = 0; p < 4; ++p) {
                        lo4[p] = __builtin_amdgcn_perm(oall[2 * p + 1][e >> 1], oall[2 * p][e >> 1], (e & 1) ? 0x07060302u : 0x05040100u);
                        hi4[p] = __builtin_amdgcn_perm(oall[2 * p + 9][e >> 1], oall[2 * p + 8][e >> 1], (e & 1) ? 0x07060302u : 0x05040100u); }
                    bf16_t* rowb = xsL + (8 * c8 + e) * 72; const int rot = c8 & 7;
                    *(u32x4*)(rowb + (((tq * 2) + rot) & 7) * 8) = lo4; *(u32x4*)(rowb + (((tq * 2 + 1) + rot) & 7) * 8) = hi4; }
            }
            if (tt + G < T / 64) P3C_REQ(tt + G);
            __syncthreads();
            for (int ch = tid; ch < 768 * 8; ch += NTH) { const int c = ch >> 3, q = ch & 7;
                bf16_t* d = g.isctx ? (bf16_t*)(ws + WS_XSTC) + ((size_t)g.b * 768 + c) * 256 + g.pos0 + q * 8
                                    : (bf16_t*)(ws + WS_XST) + ((size_t)g.b * 768 + c) * 4096 + g.pos0 + q * 8;
                *(u32x4*)d = *(const u32x4*)(xsL + c * 72 + ((q + ((c >> 3) & 7)) & 7) * 8); }
            __syncthreads();
        }
#undef P3C_REQ
        const float* dtr = (const float*)(ws + WS_DTR); float* dt = (float*)(ws + WS_DT);
        for (int e = bid * NTH + tid; e < T * 16; e += G * NTH) dt[e] = fsoftplus(dtr[e] + P.in[I_SDTB][l * 16 + (e & 15)]);
    }
}

#define EPI_ROWS_BEGIN _Pragma("unroll") for (int ai = 0; ai < 2; ++ai) { _Pragma("unroll") for (int m = 0; m < 4; ++m) { const int rl = ai * 128 + wr * 64 + m * 16 + fr;
#define EPI_ROWS_END } }
#ifndef EXP_BR
#define EXP_BR 0
#endif
typedef f32x4 acc_t[2][2][4][2];
__device__ __forceinline__ u32x4 pack8(const f32x4& a, const f32x4& b) { u32x4 o; o[0] = cvt_pk_bf16(a[0], a[1]); o[1] = cvt_pk_bf16(a[2], a[3]); o[2] = cvt_pk_bf16(b[0], b[1]); o[3] = cvt_pk_bf16(b[2], b[3]); return o; }

struct Src1 {
    const char* H; const char* W1T; const char* WFT; int G, c;
    __device__ __forceinline__ bool get(int i, GUnit& u) const {
        const int L = i * G + c; constexpr int NU1 = (T / 256) * (N1 / 256);
        if (L < NU1) { int pm, pn; pg8::remap_tile(L, T / 256, N1 / 256, pm, pn);
            u.a0 = H + (size_t)pm * 256 * 2048; u.a1 = u.a0 + (size_t)128 * 2048; u.b0 = W1T + (size_t)pn * 256 * 2048; u.b1 = u.b0 + (size_t)128 * 2048;
            u.nt = 16; u.pm = pm; u.pn = pn; u.kind = pn < 16 ? 0 : (pn < 26 ? 1 : 2); u.gidx = nullptr; u.e = 0; return true; }
        const int j = L - NU1; if (j >= 2 * (T / 256)) return false;
        const int pm = j & 1, pn = j >> 1;
        u.a0 = WFT + (size_t)pm * 256 * 2048; u.a1 = u.a0 + (size_t)128 * 2048; u.b0 = H + (size_t)pn * 256 * 2048; u.b1 = u.b0 + (size_t)128 * 2048;
        u.nt = 16; u.pm = pm; u.pn = pn; u.kind = 3; u.gidx = nullptr; u.e = 0; return true;
    }
};
struct Epi1 {
    bf16_t* Gt; bf16_t* PJ; float* DTR; bf16_t* VT; bf16_t* VTC;
    __device__ __forceinline__ void operator()(const acc_t& acc, const GUnit& u, int wr, int wc, int fr, int fq) const {
        const int cl = wc * 32 + 8 * fq;
        if (u.kind == 0) {
            EPI_ROWS_BEGIN { bf16_t* rp = Gt + (size_t)(u.pm * 256 + rl) * 4096 + u.pn * 256 + cl;
#pragma unroll
                for (int bj = 0; bj < 2; ++bj) { f32x4 a = acc[ai][bj][m][0], b = acc[ai][bj][m][1];
#pragma unroll
                    for (int e = 0; e < 4; ++e) { a[e] = fsigmoid(a[e]); b[e] = fsigmoid(b[e]); }
                    *(u32x4*)(rp + bj * 128) = pack8(a, b); } } EPI_ROWS_END
        } else if (u.kind == 1) {
            EPI_ROWS_BEGIN { bf16_t* rp = PJ + (size_t)(u.pm * 256 + rl) * PJW + (u.pn - 16) * 256 + cl;
#pragma unroll
                for (int bj = 0; bj < 2; ++bj) *(u32x4*)(rp + bj * 128) = pack8(acc[ai][bj][m][0], acc[ai][bj][m][1]); } EPI_ROWS_END
        } else if (u.kind == 2) {
            if (wc == 0 && fq < 2) {
                EPI_ROWS_BEGIN { float* rp = DTR + (size_t)(u.pm * 256 + rl) * 16 + 8 * fq; *(f32x4*)rp = acc[ai][0][m][0]; *(f32x4*)(rp + 4) = acc[ai][0][m][1]; } EPI_ROWS_END
            }
        } else {
#pragma unroll
            for (int bj = 0; bj < 2; ++bj) {
                const int tok = u.pn * 256 + bj * 128 + cl;
                bf16_t* cb;
                if (tok < TL) { const int b = tok >> 12, p = tok & 4095; cb = VT + ((size_t)b * 256) * 8192 + p; }
                else { const int r = tok - TL, b = r >> 8, q = r & 255; cb = VTC + ((size_t)b * 256) * 8192 + q; }
                const int hoff = tok < TL ? 4096 : 256;
                EPI_ROWS_BEGIN { const int r = u.pm * 256 + rl, g = r >> 7, half = (r >> 6) & 1, cp = r & 63;
                    *(u32x4*)(cb + (size_t)(g * 64 + cp) * 8192 + half * hoff) = pack8(acc[ai][bj][m][0], acc[ai][bj][m][1]); } EPI_ROWS_END
            }
        }
    }
};

struct SrcDft {
    const char* D4C; const char* D4S; const char* D256; const char* VT; const char* VTC; int first, step;
    __device__ __forceinline__ bool get(int i, GUnit& u) const {
        const int L = first + i * step; u.gidx = nullptr; u.e = 0;
        if (L < 0 || L >= 136) return false;
        if (L < 128) { const int sc = L >> 6, r = L & 63, pm = r & 7, pn = r >> 3;
            u.a0 = (sc ? D4S : D4C) + (size_t)pm * 256 * 8192; u.a1 = u.a0 + (size_t)128 * 8192;
            u.b0 = VT + (size_t)pn * 256 * 16384 + (size_t)sc * 8192; u.b1 = u.b0 + (size_t)128 * 16384;
            u.nt = 64; u.pm = pm; u.pn = pn; u.kind = sc; return true; }
        const int pn = L - 128;
        u.a0 = D256; u.a1 = u.a0 + (size_t)128 * 8192; u.b0 = VTC + (size_t)pn * 256 * 16384; u.b1 = u.b0 + (size_t)128 * 16384;
        u.nt = 8; u.pm = 0; u.pn = pn; u.kind = 2; return true;
    }
};
struct EpiDft {
    bf16_t* YC;
    __device__ __forceinline__ void operator()(const acc_t& acc, const GUnit& u, int wr, int wc, int fr, int fq) const {
        const int cl = wc * 32 + 8 * fq;
        if (u.kind == 2) {
            EPI_ROWS_BEGIN { bf16_t* rp = YC + (size_t)(TL + u.pn * 256 + rl) * YCW + cl;
#pragma unroll
                for (int bj = 0; bj < 2; ++bj) { const u32x4 o = pack8(acc[ai][bj][m][0] * 0.5f, acc[ai][bj][m][1] * 0.5f); *(u32x4*)(rp + bj * 128) = o; *(u32x4*)(rp + 256 + bj * 128) = o; } } EPI_ROWS_END
        } else {
            const int coff = u.kind == 1 ? 256 : 0; const float msign = u.kind == 1 ? -1.f : 1.f;
            EPI_ROWS_BEGIN { const int pp = u.pm * 256 + rl;
                bf16_t* rp = YC + (size_t)(u.pn * 4096 + pp) * YCW + coff + cl;
                bf16_t* rm = YC + (size_t)(u.pn * 4096 + ((4096 - pp) & 4095)) * YCW + coff + cl;
#pragma unroll
                for (int bj = 0; bj < 2; ++bj) { *(u32x4*)(rp + bj * 128) = pack8(acc[ai][bj][m][0], acc[ai][bj][m][1]);
                    if (pp != 0) *(u32x4*)(rm + bj * 128) = pack8(acc[ai][bj][m][0] * msign, acc[ai][bj][m][1] * msign); } } EPI_ROWS_END
        }
    }
};
__device__ __forceinline__ void dft_nyquist(const bf16_t* VT, bf16_t* YC, int row0, int nrows) {
    const int tid = otid(), lane = tid & 63, w = tid >> 6;
    for (int vr = row0 + w; vr < row0 + nrows && vr < 2048; vr += NTH / 64) {
        const bf16_t* src = VT + (size_t)vr * 8192;
        float s = 0.f;
#pragma unroll
        for (int q = 0; q < 8; ++q) { float v[8]; unpack8(*(const u32x4*)(src + q * 512 + lane * 8), v);
            s += (v[0] - v[1]) + (v[2] - v[3]) + (v[4] - v[5]) + (v[6] - v[7]); }
        s = wave_sum(s) * (1.f / 64.f);
        if (lane == 0) { const int b = vr >> 8, gc = vr & 255; bf16_t* d = YC + (size_t)(b * 4096 + 2048) * YCW + gc; d[0] = f2bf(s); d[256] = (bf16_t)0; }
    }
}

struct SrcBr {
    const char* YC; const char* WBRT; int G, c, nM;
    __device__ __forceinline__ bool get(int i, GUnit& u) const {
        const int k = i & 3, L = (i >> 2) * G + c; if (L >= nM * 4) return false;
        int pm, pn; pg8::remap_tile(L, nM, 4, pm, pn);
        const int koff = k == 0 ? 0 : (k == 1 ? 512 : (k == 2 ? 768 : 1024));
        u.a0 = YC + ((size_t)pm * 256 * YCW + koff) * 2; u.a1 = u.a0 + (size_t)128 * YCW * 2;
        u.b0 = WBRT + ((size_t)pn * 256 * YCW + koff) * 2; u.b1 = u.b0 + (size_t)128 * YCW * 2;
        u.nt = (k == 0 || k == 3) ? 8 : 4; u.pm = pm; u.pn = pn; u.kind = k; u.gidx = nullptr; u.e = 0; return true;
    }
};
struct EpiBr {
    const bf16_t* Gt; bf16_t* MG; const float* SSQ;
    __device__ __forceinline__ void operator()(const acc_t& acc, const GUnit& u, int wr, int wc, int fr, int fq) const {
        if (EXP_BR >= 2) return;
        const int cl = wc * 32 + 8 * fq, k = u.kind;
        const size_t row0 = (size_t)u.pm * 256 + wr * 64 + fr;
        const int colb = u.pn * 256 + cl;
        float rs[8];
#pragma unroll
        for (int i = 0; i < 8; ++i) rs[i] = 1.f;
        if (k == 3) {
            f32x4 s0[8], s1[8];
#pragma unroll
            for (int i = 0; i < 8; ++i) { const size_t row = row0 + (i >> 2) * 128 + (i & 3) * 16; s0[i] = *(const f32x4*)(SSQ + row * 8); s1[i] = *(const f32x4*)(SSQ + row * 8 + 4); }
#pragma unroll
            for (int i = 0; i < 8; ++i) rs[i] = rsqrtf((s0[i][0] + s0[i][1] + s0[i][2] + s0[i][3] + s1[i][0] + s1[i][1] + s1[i][2] + s1[i][3]) * (1.f / 512.f) + EPSN);
        }
#pragma unroll
        for (int ai = 0; ai < 2; ++ai) {
            u32x4 gv[4][2], mv[4][2];
#pragma unroll
            for (int m = 0; m < 4; ++m)
#pragma unroll
                for (int bj = 0; bj < 2; ++bj) { const size_t row = row0 + ai * 128 + m * 16;
                    gv[m][bj] = EXP_BR >= 1 ? (u32x4){0x3f803f80u, 0x3f803f80u, 0x3f803f80u, 0x3f803f80u} : *(const u32x4*)(Gt + row * 4096 + k * 1024 + colb + bj * 128);
                    mv[m][bj] = (k == 0 || EXP_BR >= 1) ? (u32x4){0u, 0u, 0u, 0u} : *(const u32x4*)(MG + row * 1024 + colb + bj * 128); }
#pragma unroll
            for (int m = 0; m < 4; ++m)
#pragma unroll
                for (int bj = 0; bj < 2; ++bj) { const size_t row = row0 + ai * 128 + m * 16;
                    float gt[8], mg[8]; unpack8(gv[m][bj], gt); unpack8(mv[m][bj], mg);
                    f32x4 a = acc[ai][bj][m][0], b = acc[ai][bj][m][1]; const float r = rs[ai * 4 + m];
#pragma unroll
                    for (int e = 0; e < 4; ++e) { a[e] = mg[e] + gt[e] * a[e] * r; b[e] = mg[4 + e] + gt[4 + e] * b[e] * r; }
                    *(u32x4*)(MG + row * 1024 + colb + bj * 128) = pack8(a, b); }
        }
    }
};

struct SrcOut {
    const char* MG; const char* WOUTT; int G, c, nM;
    __device__ __forceinline__ bool get(int i, GUnit& u) const {
        const int L = i * G + c; if (L >= nM * 4) return false;
        int pm, pn; pg8::remap_tile(L, nM, 4, pm, pn);
        u.a0 = MG + (size_t)pm * 256 * 2048; u.a1 = u.a0 + (size_t)128 * 2048; u.b0 = WOUTT + (size_t)pn * 256 * 2048; u.b1 = u.b0 + (size_t)128 * 2048;
        u.nt = 16; u.pm = pm; u.pn = pn; u.kind = 0; u.gidx = nullptr; u.e = 0; return true;
    }
};
template <bool F32IN> struct EpiOut {
    const void* xlat; const void* xctx; bf16_t* X1; const float* MODL;
    __device__ __forceinline__ void operator()(const acc_t& acc, const GUnit& u, int wr, int wc, int fr, int fq) const {
        const int cl = wc * 32 + 8 * fq;
        const int mj = u.pm < TL / 256 ? (u.pm >> 4) : 8;
        const size_t xoff = u.pm < TL / 256 ? (size_t)u.pm * 256 * 1024 : (size_t)(u.pm - TL / 256) * 256 * 1024;
        const void* xb = u.pm < TL / 256 ? xlat : xctx;
        const float* g1 = MODL + (size_t)mj * 6144 + 2048 + u.pn * 256 + cl;
        f32x4 gv[2][2];
#pragma unroll
        for (int bj = 0; bj < 2; ++bj) { gv[bj][0] = *(const f32x4*)(g1 + bj * 128); gv[bj][1] = *(const f32x4*)(g1 + bj * 128 + 4); }
#pragma unroll
        for (int ai = 0; ai < 2; ++ai) {
            f32x4 xv[4][2][2];
#pragma unroll
            for (int m = 0; m < 4; ++m)
#pragma unroll
                for (int bj = 0; bj < 2; ++bj) { const size_t o = xoff + (size_t)(ai * 128 + wr * 64 + m * 16 + fr) * 1024 + u.pn * 256 + cl + bj * 128;
                    if constexpr (F32IN) { const float* xr = (const float*)xb + o; xv[m][bj][0] = *(const f32x4*)xr; xv[m][bj][1] = *(const f32x4*)(xr + 4); }
                    else { float t[8]; unpack8(*(const u32x4*)((const bf16_t*)xb + o), t); xv[m][bj][0] = (f32x4){t[0], t[1], t[2], t[3]}; xv[m][bj][1] = (f32x4){t[4], t[5], t[6], t[7]}; } }
#pragma unroll
            for (int m = 0; m < 4; ++m)
#pragma unroll
                for (int bj = 0; bj < 2; ++bj) { bf16_t* orow = X1 + ((size_t)u.pm * 256 + ai * 128 + wr * 64 + m * 16 + fr) * 1024 + u.pn * 256 + cl + bj * 128;
                    *(u32x4*)orow = pack8(xv[m][bj][0] + gv[bj][0] * acc[ai][bj][m][0], xv[m][bj][1] + gv[bj][1] * acc[ai][bj][m][1]); }
        }
    }
};

struct SrcUp {
    const char* H2; const char* WUPT; const int* rtok; const int* meta; int G, c;
    __device__ __forceinline__ bool get(int i, GUnit& u) const {
        const int nu = meta[33]; int ru, j;
        if (G == 256) {
            const int x = c & 7, y = c >> 3; ru = i * 32 + (x >> 1) * 8 + (y & 7); j = (x & 1) * 4 + (y >> 3);
            if (i * 32 >= nu) return false;
            if (ru >= nu) { ru = nu - 1; j = -1; }
        } else { const int L = i * G + c; if (L >= nu * 8) return false; ru = L >> 3; j = L & 7; }
        if (j < 0) return false;
        int e = 0;
#pragma unroll
        for (int s = 16; s > 0; s >>= 1) if (meta[e + s] <= ru) e += s;
        u.a0 = H2; u.a1 = H2; u.gidx = rtok + (size_t)ru * 256;
        u.b0 = WUPT + ((size_t)e * 2048 + j * 128) * 2048; u.b1 = u.b0 + (size_t)1024 * 2048;
        u.nt = 16; u.pm = ru; u.pn = j; u.kind = 0; u.e = e; return true;
    }
};
struct EpiUp {
    bf16_t* ACT; const float* BUP;
    __device__ __forceinline__ void operator()(const acc_t& acc, const GUnit& u, int wr, int wc, int fr, int fq) const {
        const int cl = wc * 32 + 8 * fq, col = u.pn * 128 + cl;
        const float* bp = BUP + (size_t)u.e * 2048 + col;
        const f32x4 bg0 = *(const f32x4*)bp, bg1 = *(const f32x4*)(bp + 4), bl0 = *(const f32x4*)(bp + 1024), bl1 = *(const f32x4*)(bp + 1028);
        EPI_ROWS_BEGIN { f32x4 g0 = acc[ai][0][m][0] + bg0, g1 = acc[ai][0][m][1] + bg1, l0 = acc[ai][1][m][0] + bl0, l1 = acc[ai][1][m][1] + bl1;
#pragma unroll
            for (int e = 0; e < 4; ++e) {
                float a = fminf(g0[e], 7.f), b = fminf(fmaxf(l0[e], -7.f), 7.f); g0[e] = a * fsigmoid(1.702f * a) * (b + 1.f);
                a = fminf(g1[e], 7.f); b = fminf(fmaxf(l1[e], -7.f), 7.f); g1[e] = a * fsigmoid(1.702f * a) * (b + 1.f); }
            *(u32x4*)(ACT + ((size_t)u.pm * 256 + rl) * 1024 + col) = pack8(g0, g1); } EPI_ROWS_END
    }
};
struct SrcDn {
    const char* ACT; const char* WDNT; const int* meta; int G, c;
    __device__ __forceinline__ bool get(int i, GUnit& u) const {
        const int nu = meta[33]; int ru, j;
        if (G == 256) {
            const int x = c & 7, y = c >> 3; ru = i * 64 + x * 8 + (y & 7); j = y >> 3;
            if (i * 64 >= nu || ru >= nu) return false;
        } else { const int L = i * G + c; if (L >= nu * 4) return false; ru = L >> 2; j = L & 3; }
        int e = 0;
#pragma unroll
        for (int s = 16; s > 0; s >>= 1) if (meta[e + s] <= ru) e += s;
        u.a0 = ACT + (size_t)ru * 256 * 2048; u.a1 = u.a0 + (size_t)128 * 2048;
        u.b0 = WDNT + ((size_t)e * 1024 + j * 256) * 2048; u.b1 = u.b0 + (size_t)128 * 2048;
        u.nt = 16; u.pm = ru; u.pn = j; u.kind = 0; u.e = e; u.gidx = nullptr; return true;
    }
};
struct EpiDn {
    bf16_t* YP; const float* BDN; const int* rpair; const float* rw;
    __device__ __forceinline__ void operator()(const acc_t& acc, const GUnit& u, int wr, int wc, int fr, int fq) const {
        const int cl = wc * 32 + 8 * fq;
        const float* bp = BDN + (size_t)u.e * 1024 + u.pn * 256 + cl;
        f32x4 bv[2][2];
#pragma unroll
        for (int bj = 0; bj < 2; ++bj) { bv[bj][0] = *(const f32x4*)(bp + bj * 128); bv[bj][1] = *(const f32x4*)(bp + bj * 128 + 4); }
        int pr[8]; float wv[8];
#pragma unroll
        for (int i = 0; i < 8; ++i) { const int prow = u.pm * 256 + (i >> 2) * 128 + wr * 64 + (i & 3) * 16 + fr; pr[i] = rpair[prow]; wv[i] = rw[prow]; }
#pragma unroll
        for (int ai = 0; ai < 2; ++ai)
#pragma unroll
            for (int m = 0; m < 4; ++m) { const int pair = pr[ai * 4 + m];
                if (pair >= 0) { const float w = wv[ai * 4 + m]; bf16_t* op = YP + (size_t)pair * 1024 + u.pn * 256 + cl;
#pragma unroll
                    for (int bj = 0; bj < 2; ++bj) *(u32x4*)(op + bj * 128) = pack8((acc[ai][bj][m][0] + bv[bj][0]) * w, (acc[ai][bj][m][1] + bv[bj][1]) * w); } }
    }
};

constexpr int HY_FC = 0, HY_VI = 65536, HY_VRS = 8512, HY_YRS = 4116;
__device__ __forceinline__ void hyena_conv_channel(CParams& P, unsigned char* smem, LAS unsigned char* lds, int l, int c) {
    const int tid = otid(), lane = tid & 63, wid = __builtin_amdgcn_readfirstlane(tid >> 6);
    unsigned char* ws = P.ws;
    const float* KT = (const float*)(ws + WS_KRAW) + (size_t)l * 2 * 512 * 4096;
    const float* KPART = (const float*)(ws + WS_KPART) + (size_t)l * 2 * 64 * 512;
    {
        __syncthreads();
        float* red = (float*)(smem + 140000);
        if (tid < 64) { float s = KPART[(size_t)tid * 512 + c] + KPART[(size_t)tid * 512 + 256 + c]; s = wave_sum(s); if (tid == 0) red[0] = 1.f / s; }
        const f32x4 f0 = *(const f32x4*)(KT + (size_t)c * 4096 + tid * 8), f1 = *(const f32x4*)(KT + (size_t)c * 4096 + tid * 8 + 4);
        const f32x4 g0 = *(const f32x4*)(KT + (size_t)(256 + c) * 4096 + tid * 8), g1 = *(const f32x4*)(KT + (size_t)(256 + c) * 4096 + tid * 8 + 4);
        {
            if (tid < 4) ((unsigned*)(smem + HY_VI + 8 * HY_VRS))[tid] = 0u;
            const bf16_t* vsrc = (const bf16_t*)(ws + WS_VVT) + (size_t)c * 4096;
#pragma unroll
            for (int q = 0; q < 8; ++q) { const int ch = tid + q * NTH, b = ch >> 9, s = (ch & 511) * 8;
                *(u32x4*)(smem + HY_VI + b * HY_VRS + s * 2 + 16 * (s >> 8)) = *(const u32x4*)(vsrc + (size_t)b * 256 * 4096 + s); }
        }
        __syncthreads();
        const float inv = red[0];
        bf16_t* fc = (bf16_t*)(smem + HY_FC);
        const float fw[8] = {f0[0], f0[1], f0[2], f0[3], f1[0], f1[1], f1[2], f1[3]}, bw[8] = {g0[0], g0[1], g0[2], g0[3], g1[0], g1[1], g1[2], g1[3]};
#pragma unroll
        for (int e = 0; e < 8; ++e) { const int lag = tid * 8 + e; const bf16_t fv = f2bf(fw[e] * inv), bv = f2bf(bw[e] * inv);
#pragma unroll
            for (int q = 0; q < 4; ++q) { fc[q * 8192 + q + 4096 - lag] = fv;
                const int ib = q + 4096 + lag; if (lag >= 1 && ib < 8192) fc[q * 8192 + ib] = bv; } }
        if (tid < 4) { for (int i = 0; i <= tid; ++i) fc[tid * 8192 + i] = (bf16_t)0; }
        __syncthreads();
        {
            const int t0 = wid, q = t0 & 3, a = t0 >> 2, rho = lane & 31, h = lane >> 5, col = lane & 31, b = col >> 2, i = col & 3;
            f32x16 acc[4];
#pragma unroll
            for (int ct = 0; ct < 4; ++ct)
#pragma unroll
                for (int e = 0; e < 16; ++e) acc[ct][e] = 0.f;
            const LAS unsigned char* fq_ = lds + HY_FC + q * 16384;
            const LAS unsigned char* vi = lds + HY_VI + b * HY_VRS;
            const int ebase = 4096 - 8 * (rho - h) - 4 * a;
            const int sb0 = 256 * i + 8 * h;
#define HY_LDA(dl_) __builtin_shufflevector(*(const LAS bf16x4*)(fq_ + 2 * (ebase - (dl_))), *(const LAS bf16x4*)(fq_ + 2 * (ebase - (dl_)) + 8), 0, 1, 2, 3, 4, 5, 6, 7)
#define HY_LDB(dst, dl_, ct) do { const int s_ = 1024 * (ct) + sb0 - (dl_); const bool ok_ = (unsigned)s_ < 4096u; \
                dst = *(const LAS bf16x8*)(ok_ ? vi + s_ * 2 + 16 * (s_ >> 8) : zchunk); } while (0)
#define HY_VALID(dl_, ct) ((dl_) >= 1024 * (ct) - 4080 && (dl_) <= 1024 * (ct) + 768)
#define HY_LOADS(AF, BF, dl_, MASK) do { AF = HY_LDA(dl_); _Pragma("unroll") for (int ct = 0; ct < 4; ++ct) if ((MASK >> ct) & 1) HY_LDB(BF[ct], dl_, ct); } while (0)
#define HY_MMAS(AF, BF, MASK) do { _Pragma("unroll") for (int ct = 0; ct < 4; ++ct) if ((MASK >> ct) & 1) acc[ct] = __builtin_amdgcn_mfma_f32_32x32x16_bf16(AF, BF[ct], acc[ct], 0, 0, 0); } while (0)
#define HY_SEGMENT(LO, HI, MASK) do { HY_LOADS(a0, b0, LO, MASK); HY_LOADS(a1, b1, (LO) + 16, MASK); _Pragma("unroll 1") for (int dl = (LO); dl <= (HI); dl += 64) { \
                HY_LOADS(a2, b2, dl + 32, MASK); HY_LOADS(a3, b3, dl + 48, MASK); HY_MMAS(a0, b0, MASK); HY_MMAS(a1, b1, MASK); \
                if (dl + 64 <= (HI)) { HY_LOADS(a0, b0, dl + 64, MASK); HY_LOADS(a1, b1, dl + 80, MASK); } HY_MMAS(a2, b2, MASK); HY_MMAS(a3, b3, MASK); } } while (0)
            const LAS unsigned char* zchunk = lds + HY_VI + 8 * HY_VRS;
            bf16x8 a0, a1, a2, a3, b0[4], b1[4], b2[4], b3[4];
#pragma unroll
            for (int ct = 0; ct < 4; ++ct) { b0[ct] = (bf16x8){0, 0, 0, 0, 0, 0, 0, 0}; b1[ct] = b0[ct]; b2[ct] = b0[ct]; b3[ct] = b0[ct]; }
            HY_SEGMENT(-4080, -3072, 1); HY_SEGMENT(-3056, -2048, 3); HY_SEGMENT(-2032, -1024, 7); HY_SEGMENT(-1008, 768, 15);
            HY_SEGMENT(784, 1792, 14); HY_SEGMENT(1808, 2816, 12); HY_SEGMENT(2832, 3840, 8);
#undef HY_LOADS
#undef HY_MMAS
#undef HY_SEGMENT
#undef HY_LDA
#undef HY_LDB
#undef HY_VALID
            __syncthreads();
            float* Y = (float*)smem;
#pragma unroll
            for (int ct = 0; ct < 4; ++ct)
#pragma unroll
                for (int r = 0; r < 16; ++r) { const int rr = (r & 3) + 8 * (r >> 2) + 4 * h; const int t = 1024 * ct + 256 * i + t0 + 8 * rr;
                    Y[b * HY_YRS + t + (t >> 8)] = acc[ct][r]; }
        }
        __syncthreads();
        {
            const float* Y = (const float*)smem; bf16_t* dst = (bf16_t*)(ws + WS_CVT) + (size_t)c * 4096; const int tid2 = otid();
#pragma unroll 2
            for (int q = 0; q < 8; ++q) { const int ch = tid2 + q * NTH, b = ch >> 9, t = (ch & 511) * 8; const float* yp = Y + b * HY_YRS + t + (t >> 8);
                u32x4 ov; ov[0] = cvt_pk_bf16(yp[0], yp[1]); ov[1] = cvt_pk_bf16(yp[2], yp[3]); ov[2] = cvt_pk_bf16(yp[4], yp[5]); ov[3] = cvt_pk_bf16(yp[6], yp[7]);
                *(u32x4*)(dst + (size_t)b * 256 * 4096 + t) = ov; }
        }
        __syncthreads();
        {
            float* fl = (float*)smem;
            float* vc = fl + 520;
            const float* KT1 = KT + (size_t)512 * 4096; const float* KP1 = KPART + (size_t)64 * 512;
            if (tid < 64) { float s = tid < 4 ? KP1[(size_t)tid * 512 + c] + KP1[(size_t)tid * 512 + 256 + c] : 0.f; s = wave_sum(s); if (tid == 0) red[0] = 1.f / s; }
            { const int lag = tid - 256; float v; if (lag <= -256) v = 0.f; else if (lag >= 0) v = KT1[(size_t)c * 4096 + lag]; else v = KT1[(size_t)(256 + c) * 4096 - lag]; fl[tid + 3] = v; }
            if (tid < 3) { fl[tid] = 0.f; fl[515 + tid] = 0.f; }
            for (int e = tid; e < 2048; e += NTH) { const int b = e >> 8, s = e & 255; vc[e + 8] = bf2f(((const bf16_t*)(ws + WS_VVTC))[((size_t)b * 256 + c) * 256 + s]); }
            __syncthreads();
            const float inv1 = red[0];
            const int b = tid >> 6, tl = tid & 63; float o[4] = {0.f, 0.f, 0.f, 0.f};
#pragma unroll 4
            for (int s4 = 0; s4 < 64; ++s4) {
                const f32x4 vv = *(const f32x4*)(vc + 8 + b * 256 + 4 * s4);
                const f32x4 t0 = *(const f32x4*)(fl + 4 * (tl - s4) + 256), t1 = *(const f32x4*)(fl + 4 * (tl - s4) + 260);
                const float tp[8] = {t0[0], t0[1], t0[2], t0[3], t1[0], t1[1], t1[2], t1[3]};
#pragma unroll
                for (int j = 0; j < 4; ++j)
#pragma unroll
                    for (int k = 0; k < 4; ++k) o[j] += tp[j - k + 3] * vv[k]; }
            *(f32x4*)((float*)(ws + WS_CVTC) + ((size_t)b * 256 + c) * 256 + 4 * tl) = (f32x4){o[0] * inv1, o[1] * inv1, o[2] * inv1, o[3] * inv1};
        }
    }
    __syncthreads();
}

__device__ __forceinline__ void hyena_finish(CParams& P, unsigned char* smem, int l) {
    const int G = gridDim.x, tid = otid(), bid = obid();
    unsigned char* ws = P.ws;
    const bf16_t* PJ = (const bf16_t*)(ws + WS_PJ); bf16_t* YC = (bf16_t*)(ws + WS_YC);
    float* cvL = (float*)smem;
    const int c4 = tid & 63, tq = tid >> 6;
    const float* cw = P.in[I_HCW] + (size_t)l * 3 * 768; const float* cb = P.in[I_HCB] + (size_t)l * 768;
    float w1[3][4], wx[3][4], wv[3][4], b1[4], bx[4], bv[4], hb[4];
#pragma unroll
    for (int e = 0; e < 4; ++e) { b1[e] = cb[4 * c4 + e]; bx[e] = cb[256 + 4 * c4 + e]; bv[e] = cb[512 + 4 * c4 + e]; hb[e] = P.in[I_HBIAS][l * 256 + 4 * c4 + e];
#pragma unroll
        for (int k = 0; k < 3; ++k) { w1[k][e] = cw[k * 768 + 4 * c4 + e]; wx[k][e] = cw[k * 768 + 256 + 4 * c4 + e]; wv[k][e] = cw[k * 768 + 512 + 4 * c4 + e]; } }
    for (int tt = bid; tt < T / 64; tt += G) {
        const TileGeo g = tile_geo(tt);
        __syncthreads();
        if (g.isctx) { const float* src = (const float*)(ws + WS_CVTC) + (size_t)g.b * 256 * 256 + g.pos0;
#pragma unroll
          for (int q = 0; q < 8; ++q) { const int ch = tid + q * NTH, c = ch >> 4, j = (ch & 15) * 4; const f32x4 v = *(const f32x4*)(src + (size_t)c * 256 + j);
              float* d = cvL + c * 68 + j; d[0] = v[0]; d[1] = v[1]; d[2] = v[2]; d[3] = v[3]; } }
        else { const bf16_t* src = (const bf16_t*)(ws + WS_CVT) + (size_t)g.b * 256 * 4096 + g.pos0;
          u32x4 v[4];
#pragma unroll
          for (int q = 0; q < 4; ++q) { const int ch = tid + q * NTH, c = ch >> 3, j = (ch & 7) * 8; v[q] = *(const u32x4*)(src + (size_t)c * 4096 + j); }
#pragma unroll
          for (int q = 0; q < 4; ++q) { const int ch = tid + q * NTH, c = ch >> 3, j = (ch & 7) * 8; float f[8]; unpack8(v[q], f);
              float* d = cvL + c * 68 + j;
#pragma unroll
              for (int e = 0; e < 8; ++e) d[e] = f[e]; } }
        __syncthreads();
        const int p0 = g.pos0 + tq * 8;
        const bf16_t* rowp = PJ + (size_t)(g.tok0 + tq * 8) * PJW;
        float r1[3][4], rx[3][4], rv[3][4];
#define LD_FROW(k, dp) do { const int pp = p0 + (dp); const bool ok_ = (pp >= 0 && pp < g.slen); const bf16_t* rp = rowp + (ptrdiff_t)(ok_ ? (dp) : 0) * PJW; \
            unpack4(*(const u32x2*)(rp + 4 * c4), r1[k]); unpack4(*(const u32x2*)(rp + 256 + 4 * c4), rx[k]); unpack4(*(const u32x2*)(rp + 512 + 4 * c4), rv[k]); \
            _Pragma("unroll") for (int e = 0; e < 4; ++e) { r1[k][e] = ok_ ? r1[k][e] : 0.f; rx[k][e] = ok_ ? rx[k][e] : 0.f; rv[k][e] = ok_ ? rv[k][e] : 0.f; } } while (0)
        LD_FROW(0, -1); LD_FROW(1, 0);
#pragma unroll
        for (int j = 0; j < 8; ++j) {
            LD_FROW(2, j + 1);
            float o[4];
#pragma unroll
            for (int e = 0; e < 4; ++e) {
                const float x1 = w1[0][e] * r1[0][e] + w1[1][e] * r1[1][e] + w1[2][e] * r1[2][e] + b1[e];
                const float x2 = wx[0][e] * rx[0][e] + wx[1][e] * rx[1][e] + wx[2][e] * rx[2][e] + bx[e];
                const float vv = wv[0][e] * rv[0][e] + wv[1][e] * rv[1][e] + wv[2][e] * rv[2][e] + bv[e];
                const float xv = x2 * vv;
                o[e] = x1 * (cvL[(4 * c4 + e) * 68 + tq * 8 + j] + xv * hb[e]);
                r1[0][e] = r1[1][e]; r1[1][e] = r1[2][e]; rx[0][e] = rx[1][e]; rx[1][e] = rx[2][e]; rv[0][e] = rv[1][e]; rv[1][e] = rv[2][e]; }
            u32x2 ov; ov[0] = cvt_pk_bf16(o[0], o[1]); ov[1] = cvt_pk_bf16(o[2], o[3]);
            *(u32x2*)(YC + (size_t)(g.tok0 + tq * 8 + j) * YCW + 512 + 4 * c4) = ov;
        }
#undef LD_FROW
    }
    __syncthreads();
}

constexpr int SS_LD = 136;
__device__ __forceinline__ int ssd_tokbase(int b, int cc) { return cc < 2 ? TL + b * 256 + cc * 128 : b * 4096 + (cc - 2) * 128; }
__device__ __forceinline__ const bf16_t* ssd_trow(const unsigned char* ws, int b, int cc, int row) {
    return cc < 2 ? (const bf16_t*)(ws + WS_XSTC) + ((size_t)b * 768 + row) * 256 + cc * 128 : (const bf16_t*)(ws + WS_XST) + ((size_t)b * 768 + row) * 4096 + (cc - 2) * 128;
}
__device__ __forceinline__ void ssd_dt_arrays(CParams& P, float* sm, int l, int b, int g, int cc, int un) {
    const int tid = otid(), lane = tid & 63, w = __builtin_amdgcn_readfirstlane(tid >> 6), dir = w >> 2, r = w & 3, c = dir * 8 + g * 4 + r;
    const float* DT = (const float*)(P.ws + WS_DT); const int tb = ssd_tokbase(b, cc);
    const float d0 = DT[(size_t)(tb + 2 * lane) * 16 + c], d1 = DT[(size_t)(tb + 2 * lane + 1) * 16 + c];
    const float a = -expf(P.in[I_SALOG][l * 16 + c]);
    const float v0 = d0 * a, v1 = d1 * a, p = v0 + v1;
    float inc = p;
#pragma unroll
    for (int d = 1; d < 64; d <<= 1) { const float y = __int_as_float(__builtin_amdgcn_ds_bpermute((lane - d) * 4, __float_as_int(inc))); inc += (lane >= d) ? y : 0.f; }
    const float E = inc - p, tot = __int_as_float(__builtin_amdgcn_readlane(__float_as_int(inc), 63));
    const float s0 = dir ? tot - E : E + v0, s1 = dir ? tot - E - v0 : inc;
    const int o = dir * 512 + (2 * lane) * 4 + r;
    sm[o] = d0; sm[o + 4] = d1; sm[1024 + o] = s0; sm[1024 + o + 4] = s1;
    float* ag = (float*)(P.ws + WS_ACSG) + (size_t)un * 1024; ag[o] = s0; ag[o + 4] = s1;
    { const float sref = dir ? s0 : s1;
      const float ref = __int_as_float(__builtin_amdgcn_ds_bpermute((dir ? (lane & ~7) : (lane | 7)) * 4, __float_as_int(sref)));
      f32x2 wl; wl[0] = d0 * __expf(ref - s0); wl[1] = d1 * __expf(ref - s1); *(f32x2*)(sm + 3072 + dir * 512 + r * 128 + 2 * lane) = wl; }
    { f32x2 wv; wv[0] = d0 * __expf(tot - s0); wv[1] = d1 * __expf(tot - s1); *(f32x2*)(sm + 2048 + dir * 512 + r * 128 + 2 * lane) = wv; }
}
#define SS_FRAG(base, row, k0) (*(const LAS bf16x8*)((base) + ((row) * SS_LD + (k0) + 8 * fq) * 2))

__device__ __forceinline__ void ssd_a_unit(CParams& P, unsigned char* smem, LAS unsigned char* lds, int l, int un) {
    const int tid = otid(), lane = tid & 63, w = __builtin_amdgcn_readfirstlane(tid >> 6), fr = lane & 15, fq = lane >> 4;
    unsigned char* ws = P.ws;
    constexpr int R0 = 0, R1 = 34816, R2 = 69632, R3 = 104448, RS = 121856;
    float* sm = (float*)(smem + RS); float* dtf = sm; float* dtb = sm + 512; float* acf = sm + 1024; float* acb = sm + 1536;
    const bf16_t* XBN = (const bf16_t*)(ws + WS_XBN);
    const int b = un / (2 * NCH), g = (un / NCH) & 1, cc = un % NCH, tb = ssd_tokbase(b, cc);
    __syncthreads();
    u32x4 cv[4], bv[4], tv[4], xv[2];
#pragma unroll
    for (int q = 0; q < 4; ++q) { const int ch = tid + q * NTH, row = ch >> 4, k8 = (ch & 15) * 8;
        cv[q] = *(const u32x4*)(XBN + (size_t)(tb + row) * 1024 + 768 + g * 128 + k8); bv[q] = *(const u32x4*)(XBN + (size_t)(tb + row) * 1024 + 512 + g * 128 + k8);
        tv[q] = *(const u32x4*)(ssd_trow(ws, b, cc, 512 + g * 128 + row) + k8); }
#pragma unroll
    for (int q = 0; q < 2; ++q) { const int ch = tid + q * NTH, row = ch >> 4, k8 = (ch & 15) * 8; xv[q] = *(const u32x4*)(ssd_trow(ws, b, cc, g * 256 + row) + k8); }
    ssd_dt_arrays(P, sm, l, b, g, cc, un);
#pragma unroll
    for (int q = 0; q < 4; ++q) { const int ch = tid + q * NTH, row = ch >> 4, k8 = (ch & 15) * 8;
        *(u32x4*)(smem + R0 + (row * SS_LD + k8) * 2) = cv[q]; *(u32x4*)(smem + R1 + (row * SS_LD + k8) * 2) = bv[q]; *(u32x4*)(smem + R2 + (row * SS_LD + k8) * 2) = tv[q]; }
    __syncthreads();
    f32x4 S[8];
#pragma unroll
    for (int nt = 0; nt < 8; ++nt) S[nt] = (f32x4){0.f, 0.f, 0.f, 0.f};
#pragma unroll
    for (int k0 = 0; k0 < 128; k0 += 32) { const bf16x8 af = SS_FRAG(lds + R0, 16 * w + fr, k0);
#pragma unroll
        for (int nt = 0; nt < 8; ++nt) S[nt] = __builtin_amdgcn_mfma_f32_16x16x32_bf16(SS_FRAG(lds + R1, 16 * nt + fr, k0), af, S[nt], 0, 0, 0); }
#pragma unroll 1
    for (int r = 0; r < 4; ++r) {
        __syncthreads();
#pragma unroll
        for (int q = 0; q < 2; ++q) { const int ch = tid + q * NTH, row = ch >> 4, k8 = (ch & 15) * 8; *(u32x4*)(smem + R3 + (row * SS_LD + k8) * 2) = xv[q]; }
        if (r < 3) {
#pragma unroll
            for (int q = 0; q < 2; ++q) { const int ch = tid + q * NTH, row = ch >> 4, k8 = (ch & 15) * 8; xv[q] = *(const u32x4*)(ssd_trow(ws, b, cc, g * 256 + (r + 1) * 64 + row) + k8); } }
        { const int i = 16 * w + fr; const float afi = acf[i * 4 + r], abi = acb[i * 4 + r], dfi = dtf[i * 4 + r];
#pragma unroll
          for (int nt = 0; nt < 8; ++nt) { float o[4];
              if (nt == w) {
#pragma unroll
                  for (int e = 0; e < 4; ++e) { const int j = 16 * nt + 4 * fq + e;
                      const bool fw = j < i; const float* ap = fw ? acf : acb; const float* dp = fw ? dtf : dtb;
                      float wgt = __expf((fw ? afi : abi) - ap[j * 4 + r]) * dp[j * 4 + r];
                      wgt += (j == i) ? dfi : 0.f;
                      o[e] = S[nt][e] * wgt; }
              } else {
                  const bool fw = nt < w;
                  const float E = __expf(fw ? afi - acf[(16 * nt + 15) * 4 + r] : abi - acb[(16 * nt) * 4 + r]);
                  const f32x4 wv = *(const f32x4*)(sm + 3072 + (fw ? 0 : 512) + r * 128 + 16 * nt + 4 * fq);
#pragma unroll
                  for (int e = 0; e < 4; ++e) o[e] = S[nt][e] * (E * wv[e]);
              }
              u32x2 ov; ov[0] = cvt_pk_bf16(o[0], o[1]); ov[1] = cvt_pk_bf16(o[2], o[3]);
              *(u32x2*)(smem + R0 + (i * SS_LD + 16 * nt + 4 * fq) * 2) = ov; } }
        __syncthreads();
        { const int p = tid >> 3, j0 = (tid & 7) * 16; const float* wf = sm + 2048 + r * 128 + j0; const float* wb = wf + 512;
#pragma unroll
          for (int h2 = 0; h2 < 2; ++h2) { float v[8]; unpack8(*(const u32x4*)(smem + R3 + (p * SS_LD + j0 + 8 * h2) * 2), v); u32x4 of, ob; float vf[8], vb[8];
              const f32x4 f0 = *(const f32x4*)(wf + 8 * h2), f1 = *(const f32x4*)(wf + 8 * h2 + 4), b0 = *(const f32x4*)(wb + 8 * h2), b1 = *(const f32x4*)(wb + 8 * h2 + 4);
#pragma unroll
              for (int e = 0; e < 4; ++e) { vf[e] = v[e] * f0[e]; vf[e + 4] = v[e + 4] * f1[e]; vb[e] = v[e] * b0[e]; vb[e + 4] = v[e + 4] * b1[e]; }
#pragma unroll
              for (int e = 0; e < 4; ++e) { of[e] = cvt_pk_bf16(vf[2 * e], vf[2 * e + 1]); ob[e] = cvt_pk_bf16(vb[2 * e], vb[2 * e + 1]); }
              *(u32x4*)(smem + R1 + (p * SS_LD + j0 + 8 * h2) * 2) = of; *(u32x4*)(smem + R1 + 17408 + (p * SS_LD + j0 + 8 * h2) * 2) = ob; } }
        { f32x4 yd[4];
#pragma unroll
          for (int nt = 0; nt < 4; ++nt) yd[nt] = (f32x4){0.f, 0.f, 0.f, 0.f};
#pragma unroll
          for (int k0 = 0; k0 < 128; k0 += 32) { const bf16x8 af = SS_FRAG(lds + R0, 16 * w + fr, k0);
#pragma unroll
              for (int nt = 0; nt < 4; ++nt) yd[nt] = __builtin_amdgcn_mfma_f32_16x16x32_bf16(SS_FRAG(lds + R3, 16 * nt + fr, k0), af, yd[nt], 0, 0, 0); }
          bf16_t* yp = (bf16_t*)(ws + WS_YD) + (size_t)(tb + 16 * w + fr) * 512 + g * 256 + r * 64 + 4 * fq;
#pragma unroll
          for (int nt = 0; nt < 4; ++nt) { u32x2 ov; ov[0] = cvt_pk_bf16(yd[nt][0], yd[nt][1]); ov[1] = cvt_pk_bf16(yd[nt][2], yd[nt][3]); *(u32x2*)(yp + 16 * nt) = ov; } }
        __syncthreads();
#pragma unroll
        for (int dir = 0; dir < 2; ++dir) {
            const int pt = w & 3, nt0 = (w >> 2) * 4;
            f32x4 st[4];
#pragma unroll
            for (int q = 0; q < 4; ++q) st[q] = (f32x4){0.f, 0.f, 0.f, 0.f};
#pragma unroll
            for (int k0 = 0; k0 < 128; k0 += 32) { const bf16x8 af = SS_FRAG(lds + R1 + dir * 17408, 16 * pt + fr, k0);
#pragma unroll
                for (int q = 0; q < 4; ++q) st[q] = __builtin_amdgcn_mfma_f32_16x16x32_bf16(SS_FRAG(lds + R2, 16 * (nt0 + q) + fr, k0), af, st[q], 0, 0, 0); }
            bf16_t* sp = (bf16_t*)(ws + WS_ST) + ((((size_t)(b * 2 + g) * 4 + r) * 2 + dir) * NCH + cc) * 8192 + (16 * pt + fr) * 128 + 4 * fq;
#pragma unroll
            for (int q = 0; q < 4; ++q) { u32x2 ov; ov[0] = cvt_pk_bf16(st[q][0], st[q][1]); ov[1] = cvt_pk_bf16(st[q][2], st[q][3]); *(u32x2*)(sp + 16 * (nt0 + q)) = ov; }
        }
    }
    if (tid < 8) { const int dir = tid >> 2, r = tid & 3; ((float*)(ws + WS_ACT))[(((size_t)(b * 2 + g) * 4 + r) * 2 + dir) * NCH + cc] = dir ? acb[r] : acf[127 * 4 + r]; }
    __syncthreads();
}

__device__ __forceinline__ void ssd_phase_b(CParams& P) {
    unsigned char* ws = P.ws;
    const bf16_t* ST = (const bf16_t*)(ws + WS_ST); const float* ACTS = (const float*)(ws + WS_ACT); bf16_t* HENT = (bf16_t*)(ws + WS_HENT);
    for (int it = obid() * NTH + otid(); it < NB * 2 * 4 * 2 * 2048; it += gridDim.x * NTH) {
        const int hd = it >> 11, e4 = (it & 2047) * 4, dir = hd & 1;
        f32x4 h = (f32x4){0.f, 0.f, 0.f, 0.f};
#pragma unroll
        for (int hf = 0; hf < 2; ++hf) {
            u32x2 sv[17]; float dv[17];
#pragma unroll
            for (int s = 0; s < 17; ++s) { const int st = hf * 17 + s; const int cc = dir == 0 ? st : (st < 2 ? 1 - st : NCH + 1 - st);
                sv[s] = *(const u32x2*)(ST + ((size_t)hd * NCH + cc) * 8192 + e4); dv[s] = ACTS[(size_t)hd * NCH + cc]; }
#pragma unroll
            for (int s = 0; s < 17; ++s) { const int st = hf * 17 + s; const int cc = dir == 0 ? st : (st < 2 ? 1 - st : NCH + 1 - st);
                u32x2 ov; ov[0] = cvt_pk_bf16(h[0], h[1]); ov[1] = cvt_pk_bf16(h[2], h[3]); *(u32x2*)(HENT + ((size_t)hd * NCH + cc) * 8192 + e4) = ov;
                h = h * __expf(dv[s]) + (f32x4){bflo(sv[s][0]), bfhi(sv[s][0]), bflo(sv[s][1]), bfhi(sv[s][1])}; }
        }
    }
}

__device__ __forceinline__ void ssd_phase_c(CParams& P, unsigned char* smem, LAS unsigned char* lds, int l) {
    const int G = gridDim.x, tid = otid(), bid = obid(), lane = tid & 63, w = __builtin_amdgcn_readfirstlane(tid >> 6), fr = lane & 15, fq = lane >> 4;
    unsigned char* ws = P.ws;
    constexpr int R0 = 0, R1 = 34816, R2 = 52224, RS = 69632;
    float* sm = (float*)(smem + RS); float* acf = sm + 1024; float* acb = sm + 1536;
    const bf16_t* XBN = (const bf16_t*)(ws + WS_XBN); const bf16_t* PJ = (const bf16_t*)(ws + WS_PJ); const bf16_t* HENT = (const bf16_t*)(ws + WS_HENT);
    bf16_t* YC = (bf16_t*)(ws + WS_YC); const bf16_t* YD = (const bf16_t*)(ws + WS_YD); float* SSQ = (float*)(ws + WS_SSQ); const float* DT = (const float*)(ws + WS_DT);
    constexpr int NIT = NB * 2 * NCH * 4;
    const int it0 = (int)((unsigned)(bid * NIT) / (unsigned)G), it1 = (int)((unsigned)((bid + 1) * NIT) / (unsigned)G);
    const int i = 16 * w + fr;
    u32x4 hv[4], cvn[4]; u32x2 ydn[4], xrn[4], zrn[4]; float acn[2];
#define SC_REQ(itx, newunit) do { const int un_ = (itx) >> 2, r_ = (itx) & 3, b_ = un_ / (2 * NCH), g_ = (un_ / NCH) & 1, cc_ = un_ % NCH, tb_ = ssd_tokbase(b_, cc_); \
        const size_t tok_ = (size_t)tb_ + i; const int hc_ = g_ * 256 + r_ * 64 + 4 * fq; \
        _Pragma("unroll") for (int q = 0; q < 4; ++q) { const int ch = tid + q * NTH, dir = ch >> 10, hrow = (ch >> 4) & 63, k8 = (ch & 15) * 8; \
            hv[q] = *(const u32x4*)(HENT + ((((size_t)(b_ * 2 + g_) * 4 + r_) * 2 + dir) * NCH + cc_) * 8192 + hrow * 128 + k8); } \
        _Pragma("unroll") for (int nt = 0; nt < 4; ++nt) { ydn[nt] = *(const u32x2*)(YD + tok_ * 512 + hc_ + 16 * nt); xrn[nt] = *(const u32x2*)(XBN + tok_ * 1024 + hc_ + 16 * nt); zrn[nt] = *(const u32x2*)(PJ + tok_ * PJW + 1024 + hc_ + 16 * nt); } \
        if (newunit) { \
            _Pragma("unroll") for (int q = 0; q < 4; ++q) { const int ch = tid + q * NTH, row = ch >> 4, k8 = (ch & 15) * 8; cvn[q] = *(const u32x4*)(XBN + (size_t)(tb_ + row) * 1024 + 768 + g_ * 128 + k8); } \
            _Pragma("unroll") for (int q = 0; q < 2; ++q) acn[q] = ((const float*)(ws + WS_ACSG))[(size_t)un_ * 1024 + tid + q * NTH]; } \
        } while (0)
    if (it0 < it1) SC_REQ(it0, true);
    int cur_un = -1;
#pragma unroll 1
    for (int it = it0; it < it1; ++it) {
        const int un = it >> 2, r = it & 3, b = un / (2 * NCH), g = (un / NCH) & 1, cc = un % NCH, tb = ssd_tokbase(b, cc);
        const size_t tok = (size_t)tb + i; const int hc = g * 256 + r * 64 + 4 * fq;
        __syncthreads();
        if (un != cur_un) {
            cur_un = un;
#pragma unroll
            for (int q = 0; q < 2; ++q) sm[1024 + tid + q * NTH] = acn[q];
#pragma unroll
            for (int q = 0; q < 4; ++q) { const int ch = tid + q * NTH, row = ch >> 4, k8 = (ch & 15) * 8; *(u32x4*)(smem + R0 + (row * SS_LD + k8) * 2) = cvn[q]; }
        }
#pragma unroll
        for (int q = 0; q < 4; ++q) { const int ch = tid + q * NTH, dir = ch >> 10, hrow = (ch >> 4) & 63, k8 = (ch & 15) * 8; *(u32x4*)(smem + (dir ? R2 : R1) + (hrow * SS_LD + k8) * 2) = hv[q]; }
        u32x2 ydv[4], xr[4], zr[4];
#pragma unroll
        for (int nt = 0; nt < 4; ++nt) { ydv[nt] = ydn[nt]; xr[nt] = xrn[nt]; zr[nt] = zrn[nt]; }
        if (it + 1 < it1) { const bool nu_ = ((it + 1) >> 2) != un; SC_REQ(it + 1, nu_); }
        __syncthreads();
        f32x4 yf[4], yb[4];
#pragma unroll
        for (int nt = 0; nt < 4; ++nt) { yf[nt] = (f32x4){0.f, 0.f, 0.f, 0.f}; yb[nt] = (f32x4){0.f, 0.f, 0.f, 0.f}; }
#pragma unroll
        for (int k0 = 0; k0 < 128; k0 += 32) { const bf16x8 af = SS_FRAG(lds + R0, 16 * w + fr, k0);
#pragma unroll
            for (int nt = 0; nt < 4; ++nt) { yf[nt] = __builtin_amdgcn_mfma_f32_16x16x32_bf16(SS_FRAG(lds + R1, 16 * nt + fr, k0), af, yf[nt], 0, 0, 0);
                                             yb[nt] = __builtin_amdgcn_mfma_f32_16x16x32_bf16(SS_FRAG(lds + R2, 16 * nt + fr, k0), af, yb[nt], 0, 0, 0); } }
        const float ef = __expf(acf[i * 4 + r]), eb = __expf(acb[i * 4 + r]), dsk = P.in[I_SD][l * 8 + g * 4 + r];
        float ssq = 0.f;
#pragma unroll
        for (int nt = 0; nt < 4; ++nt) {
            float xv[4], zv[4], yv[4]; unpack4(xr[nt], xv); unpack4(zr[nt], zv); unpack4(ydv[nt], yv);
            float o[4];
#pragma unroll
            for (int e = 0; e < 4; ++e) { o[e] = (yv[e] + ef * yf[nt][e] + eb * yb[nt][e] + xv[e] * dsk) * fsilu(zv[e]); ssq += o[e] * o[e]; }
            u32x2 ov; ov[0] = cvt_pk_bf16(o[0], o[1]); ov[1] = cvt_pk_bf16(o[2], o[3]);
            *(u32x2*)(YC + tok * YCW + 1024 + hc + 16 * nt) = ov; }
        ssq += swz_xor<16>(ssq); ssq = xor32_sum(ssq);
        if (fq == 0) SSQ[tok * 8 + g * 4 + r] = ssq;
    }
#undef SC_REQ
    __syncthreads();
}

__device__ __forceinline__ void p7a_route(CParams& P, unsigned char* smem, LAS unsigned char* lds, int l, const int TT) {
    const int G = gridDim.x, tid = otid(), bid = obid(), lane = tid & 63, w = __builtin_amdgcn_readfirstlane(tid >> 6), fr = lane & 15, fq = lane >> 4;
    unsigned char* ws = P.ws;
    constexpr int HLD = 1032, OFF_HI = 0, OFF_LO = 16 * HLD * 2, OFF_PART = 2 * 16 * HLD * 2, OFF_LG = OFF_PART + 8 * 16 * 32 * 4, OFF_HIST = OFF_LG + 16 * 32 * 4;
    float* part = (float*)(smem + OFF_PART); float* lg = (float*)(smem + OFF_LG); int* hist = (int*)(smem + OFF_HIST);
    const bf16_t* X1 = (const bf16_t*)(ws + WS_X1); bf16_t* H2 = (bf16_t*)(ws + WS_H2);
    const float* MODL = (const float*)(ws + WS_MOD) + (size_t)l * 9 * 6144;
    const float* nf = P.in[I_NFFN] + (size_t)l * 1024;
    bf16x8 wh[2][4], wl[2][4];
    { const bf16_t* wr = (const bf16_t*)(ws + WS_WRT) + (size_t)l * 2 * 32 * 1024;
#pragma unroll
      for (int nt = 0; nt < 2; ++nt)
#pragma unroll
          for (int ks = 0; ks < 4; ++ks) { const size_t o = (size_t)(16 * nt + fr) * 1024 + 128 * w + 32 * ks + 8 * fq;
              wh[nt][ks] = *(const bf16x8*)(wr + o); wl[nt][ks] = *(const bf16x8*)(wr + 32 * 1024 + o); } }
    if (tid < 32) hist[tid] = 0;
    f32x4 gn[4];
#pragma unroll
    for (int q = 0; q < 4; ++q) gn[q] = *(const f32x4*)(nf + q * 256 + lane * 4);
    const int nit = (TT / 16 + G - 1) / G;
    f32x4 v[2][4];
    { const int t0 = bid * 16;
#pragma unroll
      for (int j = 0; j < 2; ++j)
#pragma unroll
          for (int q = 0; q < 4; ++q) { float t_[4] = {0.f, 0.f, 0.f, 0.f}; if (t0 < TT) unpack4(*(const u32x2*)(X1 + (size_t)(t0 + 2 * w + j) * 1024 + q * 256 + lane * 4), t_); v[j][q] = (f32x4){t_[0], t_[1], t_[2], t_[3]}; } }
    for (int it = 0; it < nit; ++it) {
        const int t0 = (it * G + bid) * 16;
        __syncthreads();
        if (t0 < TT) {
            f32x4 av[4], bv[4];
            { const float* md = MODL + (size_t)tok_modj(t0) * 6144;
#pragma unroll
              for (int q = 0; q < 4; ++q) { av[q] = *(const f32x4*)(md + 4096 + q * 256 + lane * 4); bv[q] = *(const f32x4*)(md + 3072 + q * 256 + lane * 4); } }
#pragma unroll
            for (int j = 0; j < 2; ++j) {
                const int t = t0 + 2 * w + j;
                float ss = 0.f;
#pragma unroll
                for (int q = 0; q < 4; ++q) ss += v[j][q][0] * v[j][q][0] + v[j][q][1] * v[j][q][1] + v[j][q][2] * v[j][q][2] + v[j][q][3] * v[j][q][3];
                ss = wave_sum(ss); const float rs = rsqrtf(ss * (1.f / 1024.f) + EPSN);
#pragma unroll
                for (int q = 0; q < 4; ++q) { const int c = q * 256 + lane * 4;
                    const f32x4 g = gn[q], a = av[q], b = bv[q];
                    float o[4], lo[4];
#pragma unroll
                    for (int e = 0; e < 4; ++e) o[e] = v[j][q][e] * rs * g[e] * (1.f + a[e]) + b[e];
                    u32x2 ov; ov[0] = cvt_pk_bf16(o[0], o[1]); ov[1] = cvt_pk_bf16(o[2], o[3]);
                    *(u32x2*)(H2 + (size_t)t * 1024 + c) = ov;
                    lo[0] = o[0] - bflo(ov[0]); lo[1] = o[1] - bfhi(ov[0]); lo[2] = o[2] - bflo(ov[1]); lo[3] = o[3] - bfhi(ov[1]);
                    u32x2 lv; lv[0] = cvt_pk_bf16(lo[0], lo[1]); lv[1] = cvt_pk_bf16(lo[2], lo[3]);
                    *(u32x2*)(smem + OFF_HI + ((2 * w + j) * HLD + c) * 2) = ov; *(u32x2*)(smem + OFF_LO + ((2 * w + j) * HLD + c) * 2) = lv; }
            }
        }
        { const int tn = ((it + 1) * G + bid) * 16;
          if (it + 1 < nit && tn < TT) {
#pragma unroll
              for (int j = 0; j < 2; ++j)
#pragma unroll
                  for (int q = 0; q < 4; ++q) { float t_[4]; unpack4(*(const u32x2*)(X1 + (size_t)(tn + 2 * w + j) * 1024 + q * 256 + lane * 4), t_); v[j][q] = (f32x4){t_[0], t_[1], t_[2], t_[3]}; } } }
        __syncthreads();
        if (t0 < TT) {
            f32x4 acc[2] = {(f32x4){0.f, 0.f, 0.f, 0.f}, (f32x4){0.f, 0.f, 0.f, 0.f}};
#pragma unroll
            for (int ks = 0; ks < 4; ++ks) {
                const bf16x8 ah = *(const LAS bf16x8*)(lds + OFF_HI + (fr * HLD + 128 * w + 32 * ks + 8 * fq) * 2), al = *(const LAS bf16x8*)(lds + OFF_LO + (fr * HLD + 128 * w + 32 * ks + 8 * fq) * 2);
#pragma unroll
                for (int nt = 0; nt < 2; ++nt) { acc[nt] = __builtin_amdgcn_mfma_f32_16x16x32_bf16(wh[nt][ks], ah, acc[nt], 0, 0, 0);
                    acc[nt] = __builtin_amdgcn_mfma_f32_16x16x32_bf16(wl[nt][ks], ah, acc[nt], 0, 0, 0); acc[nt] = __builtin_amdgcn_mfma_f32_16x16x32_bf16(wh[nt][ks], al, acc[nt], 0, 0, 0); } }
#pragma unroll
            for (int nt = 0; nt < 2; ++nt) *(f32x4*)(part + (w * 16 + fr) * 32 + 16 * nt + 4 * fq) = acc[nt];
        }
        __syncthreads();
        if (t0 < TT) {
            const int tk = tid >> 5, e = tid & 31; float x = P.in[I_RB][l * 32 + e];
#pragma unroll
            for (int q = 0; q < 8; ++q) x += part[(q * 16 + tk) * 32 + e];
            float vv[4]; int ix[4];
#pragma unroll
            for (int k = 0; k < 4; ++k) {
                float m = x; m = fmaxf(m, swz_xor<1>(m)); m = fmaxf(m, swz_xor<2>(m)); m = fmaxf(m, swz_xor<4>(m)); m = fmaxf(m, swz_xor<8>(m)); m = fmaxf(m, swz_xor<16>(m));
                const unsigned long long bm = __ballot(x == m); const unsigned hm = (unsigned)(bm >> (lane & 32));
                const int bi = __builtin_ctz(hm);
                vv[k] = m; ix[k] = bi; if (e == bi) x = -3.0e38f; }
            if (e == 0) {
                const int t = t0 + tk; float ex[4], sum = 0.f;
#pragma unroll
                for (int k = 0; k < 4; ++k) { ex[k] = expf(vv[k] - vv[0]); sum += ex[k]; }
                const float inv = 1.f / sum;
#pragma unroll
                for (int k = 0; k < 4; ++k) { ((int*)(ws + WS_TKE))[(size_t)t * 4 + k] = ix[k]; ((float*)(ws + WS_TKW))[(size_t)t * 4 + k] = ex[k] * inv; atomicAdd(&hist[ix[k]], 1); }
            }
        }
    }
    __syncthreads();
    if (tid < 32) ((int*)(ws + WS_BCNT))[bid * 32 + tid] = hist[tid];
}
__device__ __forceinline__ void p7b_scatter(CParams& P, unsigned char* smem, const int TT) {
    const int G = gridDim.x, tid = otid(), bid = obid();
    unsigned char* ws = P.ws;
    int* cur = (int*)smem; int* tot = cur + 32; int* rst = tot + 32; int* ust = rst + 32;
    const int* BC = (const int*)(ws + WS_BCNT);
    __syncthreads();
    int* ptot = ust + 40; int* pbef = ptot + 512;
    { const int e = tid & 31, pr = tid >> 5; int before = 0, total = 0;
      for (int b = pr; b < G; b += 16) { const int c = BC[b * 32 + e]; total += c; before += (b < bid) ? c : 0; }
      ptot[pr * 32 + e] = total; pbef[pr * 32 + e] = before; }
    __syncthreads();
    if (tid < 32) { int before = 0, total = 0;
#pragma unroll
        for (int pr = 0; pr < 16; ++pr) { total += ptot[pr * 32 + tid]; before += pbef[pr * 32 + tid]; }
        tot[tid] = total; cur[tid] = before; }
    __syncthreads();
    if (tid == 0) { int u = 0; for (int e = 0; e < 32; ++e) { ust[e] = u; rst[e] = u * 256; u += (tot[e] + 255) >> 8; } ust[32] = u; }
    __syncthreads();
    if (tid < 32) cur[tid] += rst[tid];
    if (bid == 0 && tid < 33) ((int*)(ws + WS_META))[tid] = ust[tid];
    if (bid == 0 && tid == 33) ((int*)(ws + WS_META))[33] = ust[32];
    __syncthreads();
    int* RTOK = (int*)(ws + WS_RTOK); int* RPAIR = (int*)(ws + WS_RPAIR); float* RW = (float*)(ws + WS_RW);
    const int nit = (TT / 16 + G - 1) / G;
    for (int pi = tid; pi < nit * 64; pi += NTH) {
        const int it = pi >> 6, wq = (pi >> 2) & 15, k = pi & 3, t = (it * G + bid) * 16 + wq;
        if (t < TT) { const int e = ((const int*)(ws + WS_TKE))[(size_t)t * 4 + k]; const int pos = atomicAdd(&cur[e], 1);
            RTOK[pos] = t; RPAIR[pos] = t * 4 + k; RW[pos] = ((const float*)(ws + WS_TKW))[(size_t)t * 4 + k]; }
    }
    for (int e = bid; e < 32; e += G) { const int lo = rst[e] + tot[e], hi = rst[e] + (((tot[e] + 255) >> 8) << 8);
        for (int r = lo + tid; r < hi; r += NTH) { RTOK[r] = 0; RPAIR[r] = -1; RW[r] = 0.f; } }
    __syncthreads();
}

__device__ __forceinline__ void p10_combine(CParams& P, int l) {
    const int tid_ = otid(), lane = tid_ & 63, gw = (obid() * NTH + tid_) >> 6, nw = gridDim.x * (NTH / 64);
    unsigned char* ws = P.ws;
    const bf16_t* X1 = (const bf16_t*)(ws + WS_X1); const bf16_t* YP = (const bf16_t*)(ws + WS_YP);
    const float* MODL = (const float*)(ws + WS_MOD) + (size_t)l * 9 * 6144;
    const int TT = (l == NL - 1) ? TL : T;
    const int per = (TT + nw - 1) / nw, tb = gw * per, te = (tb + per < TT) ? tb + per : TT;
    if (tb >= te) return;
    f32x4 gain[4], g2v[4], scv[4], shv[4]; int curj = -1;
    u32x2 xn[4], yn[4][4];
#define P10_REQ(tx) do { _Pragma("unroll") for (int q = 0; q < 4; ++q) { const int c = q * 256 + lane * 4; xn[q] = *(const u32x2*)(X1 + (size_t)(tx) * 1024 + c); \
        _Pragma("unroll") for (int k = 0; k < 4; ++k) yn[q][k] = *(const u32x2*)(YP + ((size_t)(tx) * 4 + k) * 1024 + c); } } while (0)
    P10_REQ(tb);
#pragma unroll
    for (int q = 0; q < 4; ++q) gain[q] = (l < NL - 1) ? *(const f32x4*)(P.in[I_NMIX] + (size_t)(l + 1) * 1024 + q * 256 + lane * 4) : *(const f32x4*)(P.in[I_NFIN] + q * 256 + lane * 4);
#pragma unroll 1
    for (int t = tb; t < te; ++t) {
        const int mj = tok_modj(t);
        if (mj != curj) { curj = mj; const float* md = MODL + (size_t)mj * 6144; const float* mdn = md + (size_t)9 * 6144;
#pragma unroll
            for (int q = 0; q < 4; ++q) { const int c = q * 256 + lane * 4; g2v[q] = *(const f32x4*)(md + 5120 + c);
                if (l < NL - 1) { scv[q] = *(const f32x4*)(mdn + 1024 + c); shv[q] = *(const f32x4*)(mdn + c); } } }
        f32x4 v[4];
#pragma unroll
        for (int q = 0; q < 4; ++q) { f32x4 s = (f32x4){0.f, 0.f, 0.f, 0.f};
#pragma unroll
            for (int k = 0; k < 4; ++k) { float y[4]; unpack4(yn[q][k], y); s[0] += y[0]; s[1] += y[1]; s[2] += y[2]; s[3] += y[3]; }
            float x1_[4]; unpack4(xn[q], x1_);
            v[q] = (f32x4){x1_[0], x1_[1], x1_[2], x1_[3]} + g2v[q] * s; }
        if (t + 1 < te) P10_REQ(t + 1);
        float ss = 0.f;
#pragma unroll
        for (int q = 0; q < 4; ++q) ss += v[q][0] * v[q][0] + v[q][1] * v[q][1] + v[q][2] * v[q][2] + v[q][3] * v[q][3];
        ss = wave_sum(ss); const float rs = rsqrtf(ss * (1.f / 1024.f) + EPSN);
        if (l < NL - 1) {
#pragma unroll
            for (int q = 0; q < 4; ++q) { const int c = q * 256 + lane * 4;
                u32x2 o_; o_[0] = cvt_pk_bf16(v[q][0], v[q][1]); o_[1] = cvt_pk_bf16(v[q][2], v[q][3]); *(u32x2*)((bf16_t*)(ws + WS_XC) + (size_t)t * 1024 + c) = o_;
                u32x2 h_; h_[0] = cvt_pk_bf16(v[q][0] * rs * gain[q][0] * (1.f + scv[q][0]) + shv[q][0], v[q][1] * rs * gain[q][1] * (1.f + scv[q][1]) + shv[q][1]);
                h_[1] = cvt_pk_bf16(v[q][2] * rs * gain[q][2] * (1.f + scv[q][2]) + shv[q][2], v[q][3] * rs * gain[q][3] * (1.f + scv[q][3]) + shv[q][3]);
                *(u32x2*)((bf16_t*)(ws + WS_H) + (size_t)t * 1024 + c) = h_; }
        } else {
#pragma unroll
            for (int q = 0; q < 4; ++q) { const int c = q * 256 + lane * 4; *(f32x4*)(P.out + (size_t)t * 1024 + c) = v[q] * rs * gain[q]; }
        }
    }
#undef P10_REQ
}

#ifndef PROBE_ID
#define PROBE_ID 0
#endif
template <class Tsrc> __device__ __forceinline__ void probe_dump(const Tsrc* src, size_t n, float* out) {
    const size_t nout = (size_t)TL * 1024; const size_t gth = (size_t)blockIdx.x * NTH + threadIdx.x, nth = (size_t)gridDim.x * NTH;
    for (size_t i = gth; i < nout; i += nth) { float v;
        if constexpr (sizeof(Tsrc) == 2) v = bf2f(((const bf16_t*)src)[i % n]); else v = (float)src[i % n];
        out[i] = v; }
}
#define PROBE_AT(id, type, off, n) do { if (PROBE_ID == (id) && l == 0) { GRID_BAR(); probe_dump((const type*)(WSP + (off)), (size_t)(n), kparams()->out); return; } } while (0)

template <class Tsrc> __device__ __forceinline__ void probe_max(const Tsrc* src, size_t lo, size_t hi, float* out, unsigned* word) {
    const size_t nout = (size_t)TL * 1024; const size_t gth = (size_t)blockIdx.x * NTH + threadIdx.x, nth = (size_t)gridDim.x * NTH;
    float m = 0.f;
    for (size_t i = lo + gth; i < hi; i += nth) { float v; if constexpr (sizeof(Tsrc) == 2) v = bf2f(((const bf16_t*)src)[i]); else v = (float)src[i]; m = fmaxf(m, fabsf(v)); }
    atomicMax(word, __float_as_uint(m));
    for (size_t i = gth; i < nout; i += nth) out[i] = 0.f;
}
#define PROBE_MAX(id, type, off, lo, hi) do { if (PROBE_ID == (id) && l == 0) { GRID_BAR(); unsigned* w_ = (unsigned*)(WSP + WS_CTL) + 3600; probe_max((const type*)(WSP + (off)), (size_t)(lo), (size_t)(hi), kparams()->out, w_); \
    GRID_BAR(); if (blockIdx.x == 0 && threadIdx.x == 0) kparams()->out[0] = __uint_as_float(__hip_atomic_load(w_, __ATOMIC_RELAXED, __HIP_MEMORY_SCOPE_AGENT)); return; } } while (0)

template <class Tsrc> __device__ __forceinline__ void probe_cnt(const Tsrc* src, size_t lo, size_t hi, float thr, float* out, unsigned* word) {
    const size_t nout = (size_t)TL * 1024; const size_t gth = (size_t)blockIdx.x * NTH + threadIdx.x, nth = (size_t)gridDim.x * NTH;
    unsigned m = 0;
    for (size_t i = lo + gth; i < hi; i += nth) { float v; if constexpr (sizeof(Tsrc) == 2) v = bf2f(((const bf16_t*)src)[i]); else v = (float)src[i]; m += (fabsf(v) > thr || v != v) ? 1u : 0u; }
    atomicAdd(word, m);
    for (size_t i = gth; i < nout; i += nth) out[i] = 0.f;
}
#define PROBE_CNT(id, type, off, lo, hi, thr) do { if (PROBE_ID == (id) && l == 0) { GRID_BAR(); unsigned* w_ = (unsigned*)(WSP + WS_CTL) + 3600; probe_cnt((const type*)(WSP + (off)), (size_t)(lo), (size_t)(hi), thr, kparams()->out, w_); \
    GRID_BAR(); if (blockIdx.x == 0 && threadIdx.x == 0) kparams()->out[0] = 100.f + (float)__hip_atomic_load(w_, __ATOMIC_RELAXED, __HIP_MEMORY_SCOPE_AGENT); return; } } while (0)

__device__ __forceinline__ void probe_cnt2(const bf16_t* src, int r0, int r1, int c0, int c1, int ld, float thr, float* out, unsigned* word) {
    const size_t nout = (size_t)TL * 1024; const size_t gth = (size_t)blockIdx.x * NTH + threadIdx.x, nth = (size_t)gridDim.x * NTH;
    unsigned m = 0; const size_t w = (size_t)(c1 - c0), n = (size_t)(r1 - r0) * w;
    for (size_t i = gth; i < n; i += nth) { const size_t r = r0 + i / w, c = c0 + i % w; const float v = bf2f(src[r * ld + c]); m += (fabsf(v) > thr || v != v) ? 1u : 0u; }
    atomicAdd(word, m);
    for (size_t i = gth; i < nout; i += nth) out[i] = 0.f;
}
#define PROBE_CNT2(id, off, r0, r1, c0, c1, ld, thr) do { if (PROBE_ID == (id) && l == 0) { GRID_BAR(); unsigned* w_ = (unsigned*)(WSP + WS_CTL) + 3600; probe_cnt2((const bf16_t*)(WSP + (off)), r0, r1, c0, c1, ld, thr, kparams()->out, w_); \
    GRID_BAR(); if (blockIdx.x == 0 && threadIdx.x == 0) kparams()->out[0] = 100.f + (float)__hip_atomic_load(w_, __ATOMIC_RELAXED, __HIP_MEMORY_SCOPE_AGENT); return; } } while (0)

#ifndef PROBE_TI
#define PROBE_TI -1
#endif
#ifndef PROBE_TJ
#define PROBE_TJ 0
#endif
__device__ __forceinline__ void tstamp(unsigned char* wsp, int slot) {
    if (PROBE_TI >= 0 && blockIdx.x == 0 && threadIdx.x == 0) {
        unsigned long long* tw = (unsigned long long*)(wsp + WS_CTL + 14400);
        const unsigned long long now = wall_clock64(); const unsigned long long prev = tw[0];
        if (slot >= 0) tw[1 + slot] += now - prev;
        tw[0] = now;
    }
}
__device__ __forceinline__ void tdump(unsigned char* wsp, float* out) {
    if (PROBE_TI >= 0 && blockIdx.x == 0 && threadIdx.x == 0) {
        const unsigned long long* tw = (const unsigned long long*)(wsp + WS_CTL + 14400);
        out[0] = 10.f * log2f((float)tw[1 + (PROBE_TI >= 0 ? PROBE_TI : 0)] * 0.01f + 1.f) - 25.f;
    }
}
constexpr int MOE_TILES_P5 = 3712;
#ifndef EXP_P4
#define EXP_P4 0
#endif
#ifndef DUP_MASK
#define DUP_MASK 0
#endif
#define smem fresh_smem()
#define lds fresh_lds()
#define bid obid()
#define LL l
#define P (*kparams())
#define WSP (kparams()->ws)
#define TS(slot) tstamp(WSP, slot)
#define GRID_BAR() do { XcdBarrier b_; b_.bar = (unsigned*)(kparams()->ws + WS_CTL); b_.x = xb_xcc_id(); b_.st = (volatile LAS unsigned*)(lds + LDS_XB); xcd_barrier(b_); } while (0)
template <int l> __device__ __forceinline__ void run_layer() {
    const int G = gridDim.x;
    constexpr int TT = (l == NL - 1) ? TL : T;
        for (int rep_ = 0; rep_ < ((DUP_MASK & 2) ? 2 : 1); ++rep_) {
        { Src1 S{(const char*)(WSP + WS_H), (const char*)(WSP + WS_W1T) + (size_t)LL * N1 * 2048, (const char*)(WSP + WS_WFT) + (size_t)LL * 512 * 2048, G, bid};
          Epi1 E{(bf16_t*)(WSP + WS_G), (bf16_t*)(WSP + WS_PJ), (float*)(WSP + WS_DTR), (bf16_t*)(WSP + WS_VT), (bf16_t*)(WSP + WS_VTC)};
          pg8::gemm_phase<false>(lds, S, E, 1024, 1024); }
        PROBE_AT(1, bf16_t, WS_PJ, (size_t)T * PJW);
        PROBE_AT(2, bf16_t, WS_G, (size_t)T * 4096);
        PROBE_MAX(20, bf16_t, WS_G, 0, (size_t)T * 4096);
        PROBE_MAX(21, bf16_t, WS_PJ, 0, (size_t)T * PJW);
        PROBE_CNT(23, bf16_t, WS_G, 0, (size_t)T * 4096, 1.001f);
        PROBE_CNT2(24, WS_G, 0, T, 0, 2048, 4096, 1.001f);
        PROBE_CNT2(25, WS_G, 0, T, 3840, 4096, 4096, 1.001f);
        PROBE_CNT2(26, WS_G, 0, 256, 0, 4096, 4096, 1.001f);
        PROBE_MAX(22, bf16_t, WS_H, 0, (size_t)T * 1024);
        GRID_BAR();
        }
        TS(2);
        for (int rep_ = 0; rep_ < ((DUP_MASK & (32 | 64)) ? 2 : 1); ++rep_) {
        p3_prep(P, smem, LL);
        GRID_BAR();
        }
        TS(3);
        for (int rep_ = 0; rep_ < ((DUP_MASK & 4) ? 2 : 1); ++rep_) {
        { dft_nyquist((const bf16_t*)(WSP + WS_VT), (bf16_t*)(WSP + WS_YC), bid * 8, 8);
          if (G < 256) for (int r0_ = G * 8; r0_ < 2048; r0_ += 8) dft_nyquist((const bf16_t*)(WSP + WS_VT), (bf16_t*)(WSP + WS_YC), r0_, 8);
          unsigned* wq_ = (unsigned*)(WSP + WS_CTL) + 3800 + l;
#pragma unroll 1
          for (;;) {
              __syncthreads();
              if (threadIdx.x == 0) *(volatile LAS int*)(lds + LDS_XB + 32) = (int)__hip_atomic_fetch_add(wq_, 1u, __ATOMIC_RELAXED, __HIP_MEMORY_SCOPE_AGENT);
              __syncthreads();
              const int idx_ = __builtin_amdgcn_readfirstlane(*(volatile LAS int*)(lds + LDS_XB + 32));
              if (idx_ >= 136 + 256 + NB * 2 * NCH) break;
              if (idx_ < 136) { if (EXP_P4 & 1) continue;
                  SrcDft S{(const char*)(WSP + WS_D4C), (const char*)(WSP + WS_D4S), (const char*)(WSP + WS_D256), (const char*)(WSP + WS_VT), (const char*)(WSP + WS_VTC), idx_, 1000};
                  EpiDft E{(bf16_t*)(WSP + WS_YC)};
                  pg8::gemm_phase<false>(lds, S, E, 4096, 8192); }
              else if (idx_ < 136 + 256) { if (!(EXP_P4 & 2)) hyena_conv_channel(P, smem, lds, LL, idx_ - 136); }
              else { if (!(EXP_P4 & 4)) ssd_a_unit(P, smem, lds, LL, idx_ - 136 - 256); }
          }
          TS(16); }
        GRID_BAR();
        }
        TS(4);
        for (int rep_ = 0; rep_ < ((DUP_MASK & (32 | 128)) ? 2 : 1); ++rep_) {
#pragma unroll 1
        for (int s_ = 0; s_ < 2; ++s_) { if (((s_ ^ bid) & 1) == 0) hyena_finish(P, smem, LL); else ssd_phase_b(P); }
        GRID_BAR();
        }
        TS(5);
        for (int rep_ = 0; rep_ < ((DUP_MASK & (32 | 256)) ? 2 : 1); ++rep_) {
        ssd_phase_c(P, smem, lds, LL);
        PROBE_AT(3, bf16_t, WS_YC, (size_t)T * YCW);
        GRID_BAR();
        }
        TS(6);
        for (int rep_ = 0; rep_ < ((DUP_MASK & 16) ? 2 : 1); ++rep_) {
        { SrcBr S{(const char*)(WSP + WS_YC), (const char*)(WSP + WS_WBRT) + (size_t)LL * 1024 * YCW * 2, G, bid, TT / 256};
          EpiBr E{(const bf16_t*)(WSP + WS_G), (bf16_t*)(WSP + WS_MG), (const float*)(WSP + WS_SSQ)};
          pg8::gemm_phase<false>(lds, S, E, YCW, YCW); }
        {
            constexpr int NSU = (TT / 256) * 4; const int rem = NSU % G, b_ = bid;
            const int nearly = rem == 0 ? G : G - rem, part = rem == 0 ? b_ : b_ - rem;
            if (part >= 0) p0_transposes(P, smem, l * TILES_PER_LAYER + TILES_DENSE + MOE_TILES_P0, l * TILES_PER_LAYER + TILES_DENSE + MOE_TILES_P0 + MOE_TILES_P5, part, nearly); }
        GRID_BAR();
        }
        TS(7);
        for (int rep_ = 0; rep_ < ((DUP_MASK & 32768) ? 2 : 1); ++rep_) {
        PROBE_AT(6, bf16_t, WS_MG, (size_t)T * 1024);
        PROBE_AT(7, float, WS_SSQ, (size_t)T * 8);
        { SrcOut S{(const char*)(WSP + WS_MG), (const char*)(WSP + WS_WOUTT) + (size_t)LL * 1024 * 2048, G, bid, TT / 256};
          if constexpr (l == 0) { EpiOut<true> E{P.in[I_X], P.in[I_CTX], (bf16_t*)(WSP + WS_X1), (const float*)(WSP + WS_MOD) + (size_t)LL * 9 * 6144}; pg8::gemm_phase<false>(lds, S, E, 1024, 1024); }
          else { EpiOut<false> E{(const bf16_t*)(WSP + WS_XC), (const bf16_t*)(WSP + WS_XC) + (size_t)TL * 1024, (bf16_t*)(WSP + WS_X1), (const float*)(WSP + WS_MOD) + (size_t)LL * 9 * 6144}; pg8::gemm_phase<false>(lds, S, E, 1024, 1024); } }
        {
            constexpr int NSU = (TT / 256) * 4; const int rem = NSU % G, b_ = bid;
            const int nearly = rem == 0 ? G : G - rem, part = rem == 0 ? b_ : b_ - rem;
            if (part >= 0) p0_transposes(P, smem, l * TILES_PER_LAYER + TILES_DENSE + MOE_TILES_P0 + MOE_TILES_P5, (l + 1) * TILES_PER_LAYER, part, nearly); }
        GRID_BAR();
        }
        TS(8);
        for (int rep_ = 0; rep_ < ((DUP_MASK & (32 | 512)) ? 2 : 1); ++rep_) {
        PROBE_AT(4, bf16_t, WS_X1, (size_t)T * 1024);
        p7a_route(P, smem, lds, LL, TT);
        GRID_BAR();
        }
        TS(9);
        for (int rep_ = 0; rep_ < ((DUP_MASK & (32 | 1024)) ? 2 : 1); ++rep_) {
        p7b_scatter(P, smem, TT);
        GRID_BAR();
        if (DUP_MASK & 65536) { GRID_BAR(); GRID_BAR(); GRID_BAR(); GRID_BAR(); GRID_BAR(); GRID_BAR(); GRID_BAR(); GRID_BAR(); }
        }
        TS(10);
        for (int rep_ = 0; rep_ < ((DUP_MASK & 8) ? 2 : 1); ++rep_) {
        { SrcUp S{(const char*)(WSP + WS_H2), (const char*)(WSP + WS_WUPT) + (size_t)LL * 32 * 2048 * 2048, (const int*)(WSP + WS_RTOK), (const int*)(WSP + WS_META), G, bid};
          EpiUp E{(bf16_t*)(WSP + WS_ACTB), P.in[I_BUP] + (size_t)LL * 32 * 2048};
          pg8::gemm_phase<true>(lds, S, E, 1024, 1024); }
        GRID_BAR();
        }
        TS(11);
        for (int rep_ = 0; rep_ < ((DUP_MASK & 8) ? 2 : 1); ++rep_) {
        { SrcDn S{(const char*)(WSP + WS_ACTB), (const char*)(WSP + WS_WDNT) + (size_t)LL * 32 * 1024 * 2048, (const int*)(WSP + WS_META), G, bid};
          EpiDn E{(bf16_t*)(WSP + WS_YP), P.in[I_BDN] + (size_t)LL * 32 * 1024, (const int*)(WSP + WS_RPAIR), (const float*)(WSP + WS_RW)};
          pg8::gemm_phase<false>(lds, S, E, 1024, 1024); }
        GRID_BAR();
        }
        TS(12);
        for (int rep_ = 0; rep_ < ((DUP_MASK & (32 | 2048)) ? 2 : 1); ++rep_) {
        PROBE_AT(5, bf16_t, WS_YP, (size_t)T * 4 * 1024);
        p10_combine(P, LL);
        GRID_BAR();
        }
        TS(13);
}
__global__ void __launch_bounds__(NTH, 2) fwd_kernel(Params Pk) {
    const int tid = threadIdx.x, G = gridDim.x;
    if (tid < 4) ((volatile LAS unsigned*)(lds + LDS_XB))[tid] = 0u;
    __syncthreads();
    (void)xcd_barrier_post((unsigned*)(Pk.ws + WS_CTL), (volatile LAS unsigned*)(lds + LDS_XB));

    TS(-1);
    for (int rep_ = 0; rep_ < ((DUP_MASK & 1) ? 2 : 1); ++rep_) {
    p0_prep(P, smem);
    GRID_BAR();
    }
    TS(0);
    p1_norm0(P);
    GRID_BAR();
    TS(1);
    run_layer<0>(); run_layer<1>(); run_layer<2>(); run_layer<3>();
    if (PROBE_TI >= 0) { GRID_BAR(); tdump(WSP, kparams()->out); }
}
#undef bid
#undef LL
#undef smem
#undef lds
#undef GRID_BAR
#undef P
#undef WSP
#undef TS

extern "C" void kernel_launch(void* const* d_in, const int* in_sizes, int n_in, void* d_out, int out_size, void* d_ws, size_t ws_size, hipStream_t stream) {
    static int grid = 0;
    if (grid == 0) {
        if (n_in != 35 || ws_size < WS_END) { fprintf(stderr, "kernel_launch: need 35 inputs and %zu bytes of workspace (got %d, %zu)\n", (size_t)WS_END, n_in, ws_size); grid = -1; return; }
        int dev = 0, cus = 0, per_cu = 0;
        if (hipGetDevice(&dev) != hipSuccess || hipDeviceGetAttribute(&cus, hipDeviceAttributeMultiprocessorCount, dev) != hipSuccess) { grid = -1; return; }
        if (hipFuncSetAttribute((const void*)fwd_kernel, hipFuncAttributeMaxDynamicSharedMemorySize, LDS_BYTES) != hipSuccess) { fprintf(stderr, "kernel_launch: hipFuncSetAttribute failed\n"); grid = -1; return; }
        if (hipOccupancyMaxActiveBlocksPerMultiprocessor(&per_cu, (const void*)fwd_kernel, NTH, LDS_BYTES) != hipSuccess || per_cu < 1) { fprintf(stderr, "kernel_launch: occupancy query says %d\n", per_cu); }
        (void)hipGetLastError();
        grid = cus;
    }
    if (grid < 0) return;
    (void)in_sizes; (void)out_size;
    hipMemsetAsync((char*)d_ws + WS_CTL, 0, 16384, stream);
    Params p{};
    for (int i = 0; i < 35; ++i) p.in[i] = (const float*)d_in[i];
    p.out = (float*)d_out; p.ws = (unsigned char*)d_ws;
    hipLaunchKernelGGL(fwd_kernel, dim3(grid), dim3(NTH), LDS_BYTES, stream, p);
}
```

```cpp
#include <hip/hip_runtime.h>
#include <cstdio>
#include <cstdint>
#define LAS __attribute__((address_space(3)))
typedef unsigned short bf16_t;
typedef short bf16x8 __attribute__((ext_vector_type(8)));
typedef short bf16x4 __attribute__((ext_vector_type(4)));
typedef float f32x4 __attribute__((ext_vector_type(4)));
typedef float f32x2 __attribute__((ext_vector_type(2)));
typedef float f32x16 __attribute__((ext_vector_type(16)));
typedef unsigned u32x4 __attribute__((ext_vector_type(4)));
typedef unsigned u32x2 __attribute__((ext_vector_type(2)));

constexpr int DM = 1024, NB = 8, SEQ = 4096, CTXL = 256, NL = 4;
constexpr int TL = NB * SEQ, TC = NB * CTXL, T = TL + TC;
constexpr int NTH = 512;
constexpr int INW = 2832;
constexpr int N1 = 6912;
constexpr int PJW = 2560;
constexpr int YCW = 1536;
constexpr int NEXP = 32, EFF = 1024;
constexpr int NCH = 34;
constexpr int MAXU = 576;
constexpr int RMAX = MAXU * 256;
constexpr float EPSN = 1e-6f;

constexpr size_t alup(size_t x) { return (x + 255) & ~size_t(255); }
constexpr size_t WS_CTL   = 0;
constexpr size_t WS_W1T   = 16384;
constexpr size_t WS_WFT   = WS_W1T   + alup((size_t)NL * N1 * 1024 * 2);
constexpr size_t WS_WBRT  = WS_WFT   + alup((size_t)NL * 512 * 1024 * 2);
constexpr size_t WS_WOUTT = WS_WBRT  + alup((size_t)NL * 1024 * YCW * 2);
constexpr size_t WS_WUPT  = WS_WOUTT + alup((size_t)NL * 1024 * 1024 * 2);
constexpr size_t WS_WDNT  = WS_WUPT  + alup((size_t)NL * 32 * 2048 * 1024 * 2);
constexpr size_t WS_D4C   = WS_WDNT  + alup((size_t)NL * 32 * 1024 * 1024 * 2);
constexpr size_t WS_D4S   = WS_D4C   + alup((size_t)4096 * 4096 * 2);
constexpr size_t WS_D256  = WS_D4S   + alup((size_t)4096 * 4096 * 2);
constexpr size_t WS_KRAW  = WS_D256  + alup((size_t)256 * 4096 * 2);
constexpr size_t WS_KPART = WS_KRAW  + alup((size_t)NL * 2 * 4096 * 512 * 4);
constexpr size_t WS_MOD   = WS_KPART + alup((size_t)NL * 2 * 64 * 512 * 4);
constexpr size_t WS_H     = WS_MOD   + alup((size_t)NL * 9 * 6144 * 4);
constexpr size_t WS_G     = WS_H     + alup((size_t)T * 1024 * 2);
constexpr size_t WS_PJ    = WS_G     + alup((size_t)T * 4096 * 2);
constexpr size_t WS_DTR   = WS_PJ    + alup((size_t)T * PJW * 2);
constexpr size_t WS_DT    = WS_DTR   + alup((size_t)T * 16 * 4);
constexpr size_t WS_VT    = WS_DT    + alup((size_t)T * 16 * 4);
constexpr size_t WS_VTC   = WS_VT    + alup((size_t)2048 * 8192 * 2);
constexpr size_t WS_YC    = WS_VTC   + alup((size_t)2048 * 8192 * 2);
constexpr size_t WS_XBN   = WS_YC    + alup((size_t)T * YCW * 2);
constexpr size_t WS_XST   = WS_XBN   + alup((size_t)T * 1024 * 2);
constexpr size_t WS_XSTC  = WS_XST   + alup((size_t)8 * 768 * 4096 * 2);
constexpr size_t WS_VVT   = WS_XSTC  + alup((size_t)8 * 768 * 256 * 2);
constexpr size_t WS_VVTC  = WS_VVT   + alup((size_t)8 * 256 * 4096 * 2);
constexpr size_t WS_CVT   = WS_VVTC  + alup((size_t)8 * 256 * 256 * 2);
constexpr size_t WS_CVTC  = WS_CVT   + alup((size_t)8 * 256 * 4096 * 4);
constexpr size_t WS_ST    = WS_CVTC  + alup((size_t)8 * 256 * 256 * 4);
constexpr size_t WS_HENT  = WS_ST    + alup((size_t)8 * 2 * 4 * 2 * NCH * 8192 * 4);
constexpr size_t WS_ACT   = WS_HENT  + alup((size_t)8 * 2 * 4 * 2 * NCH * 8192 * 2);
constexpr size_t WS_YD    = WS_ACT   + alup((size_t)8 * 2 * 4 * 2 * NCH * 4);
constexpr size_t WS_SSQ   = WS_YD    + alup((size_t)T * 512 * 4);
constexpr size_t WS_MG    = WS_SSQ   + alup((size_t)T * 8 * 4);
constexpr size_t WS_X1    = WS_MG    + alup((size_t)T * 1024 * 2);
constexpr size_t WS_XC    = WS_X1    + alup((size_t)T * 1024 * 4);
constexpr size_t WS_H2    = WS_XC    + alup((size_t)T * 1024 * 4);
constexpr size_t WS_TKE   = WS_H2    + alup((size_t)T * 1024 * 2);
constexpr size_t WS_TKW   = WS_TKE   + alup((size_t)T * 4 * 4);
constexpr size_t WS_BCNT  = WS_TKW   + alup((size_t)T * 4 * 4);
constexpr size_t WS_RTOK  = WS_BCNT  + alup((size_t)1024 * 32 * 4);
constexpr size_t WS_RPAIR = WS_RTOK  + alup((size_t)RMAX * 4);
constexpr size_t WS_RW    = WS_RPAIR + alup((size_t)RMAX * 4);
constexpr size_t WS_META  = WS_RW    + alup((size_t)RMAX * 4);
constexpr size_t WS_ACTB  = WS_META  + alup(256);
constexpr size_t WS_YP    = WS_ACTB  + alup((size_t)RMAX * 1024 * 2);
constexpr size_t WS_WRT   = WS_YP    + alup((size_t)T * 4 * 1024 * 2);
constexpr size_t WS_ACSG  = WS_WRT   + alup((size_t)NL * 2 * 32 * 1024 * 2);
constexpr size_t WS_END   = WS_ACSG  + alup((size_t)NB * 2 * NCH * 1024 * 4);

constexpr int LDS_BYTES = 155648;
constexpr int LDS_XB = LDS_BYTES - 64;

__device__ __forceinline__ unsigned cvt_pk_bf16(float lo, float hi) { typedef __bf16 bf2_t __attribute__((ext_vector_type(2))); const bf2_t v = {(__bf16)lo, (__bf16)hi}; return __builtin_bit_cast(unsigned, v); }
__device__ __forceinline__ bf16_t f2bf(float f) { return (bf16_t)(cvt_pk_bf16(f, 0.f) & 0xffffu); }
__device__ __forceinline__ float bf2f(bf16_t b) { return __uint_as_float(((unsigned)b) << 16); }
__device__ __forceinline__ float bflo(unsigned u) { return __uint_as_float(u << 16); }
__device__ __forceinline__ float bfhi(unsigned u) { return __uint_as_float(u & 0xffff0000u); }
template <int X> __device__ __forceinline__ float swz_xor(float v) { return __int_as_float(__builtin_amdgcn_ds_swizzle(__float_as_int(v), (X << 10) | 0x1f)); }
__device__ __forceinline__ float xor32_sum(float v) {
    typedef unsigned u2 __attribute__((ext_vector_type(2)));
    const u2 r = __builtin_amdgcn_permlane32_swap(__float_as_uint(v), __float_as_uint(v), false, false);
    return __uint_as_float(r[0]) + __uint_as_float(r[1]);
}
__device__ __forceinline__ float wave_sum(float v) {
    v += swz_xor<1>(v); v += swz_xor<2>(v); v += swz_xor<4>(v); v += swz_xor<8>(v); v += swz_xor<16>(v);
    return xor32_sum(v);
}
extern __shared__ __attribute__((aligned(16))) unsigned char dyn_smem[];
__device__ __forceinline__ LAS unsigned char* fresh_lds() { unsigned o = 0; asm volatile("" : "+s"(o)); return (LAS unsigned char*)dyn_smem + o; }
__device__ __forceinline__ unsigned char* fresh_smem() { return (unsigned char*)fresh_lds(); }
__device__ __forceinline__ int otid() { int t = threadIdx.x; asm volatile("" : "+v"(t)); return t; }
__device__ __forceinline__ int obid() { int t = blockIdx.x; asm volatile("" : "+s"(t)); return t; }
__device__ __forceinline__ int ouni(int t) { asm volatile("" : "+s"(t)); return t; }
__device__ __forceinline__ float fsigmoid(float x) { return __builtin_amdgcn_rcpf(1.f + __expf(-x)); }
__device__ __forceinline__ float fsilu(float x) { return x * fsigmoid(x); }
__device__ __forceinline__ float fsoftplus(float x) { return x > 20.f ? x : log1pf(expf(x)); }

#define XB_TMO      128
#define XB_XCNT(j)  (256  + 64 * (j))
#define XB_XSUB(j)  (1280 + 64 * (j))
#define XB_XGEN(j)  (2304 + 64 * (j))
#define XB_TOP      3328
#define XB_TOPGEN   3392
#define XCD_BAR_WORDS 3456
#define XB_SPIN_CAP (1u << 22)
__device__ __forceinline__ unsigned xb_ld(unsigned* p)              { return __hip_atomic_load(p, __ATOMIC_RELAXED, __HIP_MEMORY_SCOPE_AGENT); }
__device__ __forceinline__ unsigned xb_add(unsigned* p, unsigned v) { return __hip_atomic_fetch_add(p, v, __ATOMIC_RELAXED, __HIP_MEMORY_SCOPE_AGENT); }
__device__ __forceinline__ unsigned xb_xcc_id() { return (unsigned)__builtin_amdgcn_s_getreg((3 << 11) | 20) & 0xFu; }
#define XB_SPIN(cond, bar) do { unsigned _sp = 0; while (cond) { __builtin_amdgcn_s_sleep(1); \
    if ((++_sp & 255u) == 0u) { if (xb_ld(&(bar)[XB_TMO])) break; if (_sp > XB_SPIN_CAP) { atomicAdd(&(bar)[XB_TMO], 1u); break; } } } } while (0)
struct XcdBarrier { unsigned* bar; unsigned x; volatile LAS unsigned* st; };
__device__ __forceinline__ XcdBarrier xcd_barrier_post(unsigned* bar, volatile LAS unsigned* st) {
    XcdBarrier b; b.bar = bar; b.x = xb_xcc_id(); b.st = st;
    if (threadIdx.x == 0) (void)xb_add(&bar[XB_XCNT(b.x)], 1u);
    return b;
}
__device__ __forceinline__ void xcd_barrier_complete(unsigned* bar, unsigned x, unsigned& nloc, unsigned& nx) {
    const unsigned G = gridDim.x * gridDim.y * gridDim.z;
    unsigned sum, cnt, mine, sp = 0u;
    for (;;) {
        sum = 0u; cnt = 0u; mine = 0u;
#pragma unroll
        for (unsigned j = 0; j < 16; ++j) { const unsigned c = xb_ld(&bar[XB_XCNT(j)]); sum += c; cnt += (c > 0u) ? 1u : 0u; mine = (j == x) ? c : mine; }
        if (sum == G) break;
        __builtin_amdgcn_s_sleep(1);
        if ((++sp & 255u) == 0u) { if (xb_ld(&bar[XB_TMO])) break; if (sp > XB_SPIN_CAP) { atomicAdd(&bar[XB_TMO], 1u); break; } }
    }
    nloc = mine > 0u ? mine : 1u; nx = cnt > 0u ? cnt : 1u;
}
__device__ __forceinline__ void xcd_barrier(const XcdBarrier& b) {
    asm volatile("s_waitcnt vmcnt(0)" ::: "memory");
    __syncthreads();
    if (threadIdx.x == 0) {
        unsigned* bar = b.bar;
        __builtin_amdgcn_s_waitcnt(0);
        unsigned nloc = b.st[0], nx = b.st[1];
        if (nloc == 0u) { xcd_barrier_complete(bar, b.x, nloc, nx); b.st[0] = nloc; b.st[1] = nx; }
        const unsigned old = xb_add(&bar[XB_XSUB(b.x)], 1u);
        const unsigned gen = old / nloc;
        if (old + 1u == (gen + 1u) * nloc) {
            __builtin_amdgcn_fence(__ATOMIC_RELEASE, "agent");
            asm volatile("s_waitcnt vmcnt(0)" ::: "memory");
            const unsigned og = xb_add(&bar[XB_TOP], 1u);
            const unsigned tg = og / nx;
            if (og + 1u == (tg + 1u) * nx) xb_add(&bar[XB_TOPGEN], 1u);
            else XB_SPIN(xb_ld(&bar[XB_TOPGEN]) == tg, bar);
            __builtin_amdgcn_fence(__ATOMIC_ACQUIRE, "agent");
            xb_add(&bar[XB_XGEN(b.x)], 1u);
            asm volatile("s_waitcnt vmcnt(0)" ::: "memory");
        } else {
            XB_SPIN(xb_ld(&bar[XB_XGEN(b.x)]) == gen, bar);
            __builtin_amdgcn_fence(__ATOMIC_ACQUIRE, "agent");
            asm volatile("s_waitcnt vmcnt(0)" ::: "memory");
        }
    }
    __syncthreads();
}

namespace pg8 {
constexpr int BM = 256, BK = 64, HALF = 128, HTB = HALF * BK * 2, STAGE_BYTES = 8 * HTB, NXCD = 8, WGM = 8;
__host__ __device__ __forceinline__ int lds_byte(int r, int c) { const int st = (r >> 4) * 2 + (c >> 5), rr = r & 15, cc = c & 31, ob = rr * 64 + cc * 2; return st * 1024 + (ob ^ (((ob >> 9) & 1) << 5)); }
__host__ __device__ __forceinline__ void stage_rc(int b, int& R, int& C) { const int st = b / 1024, sb = b % 1024, swz = sb ^ (((sb >> 9) & 1) << 5); R = (st >> 1) * 16 + swz / 64; C = (st & 1) * 32 + (swz % 64) / 2; }
__host__ __device__ __forceinline__ int perm32(int rho) { const int n = rho >> 4, i = rho & 15; return 8 * (i >> 2) + 4 * n + (i & 3); }

__device__ __forceinline__ void remap_tile(int L, int nM, int nN, int& pm, int& pn) {
    const int nwg = nM * nN; int wgid = L;
    { const int q = nwg / NXCD, r = nwg % NXCD, xcd = wgid % NXCD, off = wgid / NXCD; wgid = (xcd < r ? xcd * (q + 1) : r * (q + 1) + (xcd - r) * q) + off; }
    const int nig = WGM * nN, gid = wgid / nig, fm = gid * WGM, gsz = (nM - fm) < WGM ? (nM - fm) : WGM;
    pm = fm + ((wgid % nig) % gsz); pn = (wgid % nig) / gsz;
}

struct GUnit { const char* a0; const char* a1; const char* b0; const char* b1; const int* gidx; int nt, pm, pn, kind, e; };

template <bool GATHER, class Src, class Epi>
__device__ __forceinline__ void gemm_phase(LAS unsigned char* lds, const Src& S, const Epi& E, const int lda, const int ldb) {
    const int tid = otid(), wid = __builtin_amdgcn_readfirstlane(tid >> 6), lane = tid & 63, wr = wid >> 2, wc = wid & 3, fr = lane & 15, fq = lane >> 4;
    unsigned voffA[2], voffB[2];
#pragma unroll
    for (int i = 0; i < 2; ++i) { int R, C; stage_rc(tid * 16 + i * 8192, R, C); const int Rb = (R & ~31) + perm32(R & 31);
        voffA[i] = (unsigned)(R * lda + C) * 2u; voffB[i] = (unsigned)(Rb * ldb + C) * 2u; }
    const size_t kstep = (size_t)(BK * 2);
    const unsigned ldsw = (unsigned)wid * 1024u;
    const int aoff = lds_byte(wr * 64 + fr, fq * 8), boff = lds_byte(wc * 32 + fr, fq * 8);
#define PG8_SA(b, h) (((b) * 2 + (h)) * HTB)
#define PG8_SB(b, h) ((4 + (b) * 2 + (h)) * HTB)
#define PG8_STAGE(bufoff, gbase, voff) do { _Pragma("unroll") for (int _i = 0; _i < 2; ++_i) \
        __builtin_amdgcn_global_load_lds((const unsigned*)((const char*)(gbase) + (voff)[_i]), (LAS unsigned*)(lds + (bufoff) + ldsw + _i * 8192), 16, 0, 0); } while (0)
#define PG8_LDA(dst, b, h) do { _Pragma("unroll") for (int m = 0; m < 4; ++m) _Pragma("unroll") for (int k = 0; k < 2; ++k) dst[m][k] = *(const LAS bf16x8*)(lds + PG8_SA(b, h) + aoff + m * 2048 + k * 1024); } while (0)
#define PG8_LDB(dst, b, h) do { _Pragma("unroll") for (int n = 0; n < 2; ++n) _Pragma("unroll") for (int k = 0; k < 2; ++k) dst[n][k] = *(const LAS bf16x8*)(lds + PG8_SB(b, h) + boff + n * 2048 + k * 1024); } while (0)
#define PG8_MMA(ai, bj, At, Bt) do { __builtin_amdgcn_s_setprio(1); _Pragma("unroll") for (int m = 0; m < 4; ++m) _Pragma("unroll") for (int n = 0; n < 2; ++n) _Pragma("unroll") for (int k = 0; k < 2; ++k) \
        acc[ai][bj][m][n] = __builtin_amdgcn_mfma_f32_16x16x32_bf16(Bt[n][k], At[m][k], acc[ai][bj][m][n], 0, 0, 0); __builtin_amdgcn_s_setprio(0); } while (0)
#define PG8_WAIT_V(n) asm volatile("s_waitcnt vmcnt(" #n ")" ::: "memory")
#define PG8_WAIT_L(n) asm volatile("s_waitcnt lgkmcnt(" #n ")" ::: "memory")
#define PG8_BAR __builtin_amdgcn_s_barrier()
#define PG8_SCHED __builtin_amdgcn_sched_barrier(0)
#define PG8_LOADV(u, v) do { int _tt = tid; asm volatile("" : "+v"(_tt)); _Pragma("unroll") for (int _i = 0; _i < 2; ++_i) { int _R, _C; stage_rc(_tt * 16 + _i * 8192, _R, _C); \
        _Pragma("unroll") for (int _h = 0; _h < 2; ++_h) { if constexpr (GATHER) v[_h][_i] = (unsigned)((u).gidx[_h * 128 + _R] * lda + _C) * 2u; else v[_h][_i] = voffA[_i]; } } } while (0)
    GUnit cur, nxt; int ui = 0;
    if (!S.get(0, cur)) return;
    f32x4 acc[2][2][4][2];
#pragma unroll
    for (int a = 0; a < 2; ++a)
#pragma unroll
        for (int b = 0; b < 2; ++b)
#pragma unroll
            for (int m = 0; m < 4; ++m)
#pragma unroll
                for (int n = 0; n < 2; ++n) acc[a][b][m][n] = (f32x4){0.f, 0.f, 0.f, 0.f};
    bf16x8 At[4][2], B0[2][2], B1[2][2];
    unsigned va[2][2];
    PG8_LOADV(cur, va);
    const char* cA0 = cur.a0; const char* cA1 = cur.a1; const char* cB0 = cur.b0; const char* cB1 = cur.b1;
    PG8_STAGE(PG8_SB(0, 0), cB0, voffB); PG8_STAGE(PG8_SA(0, 0), cA0, va[0]); PG8_STAGE(PG8_SB(0, 1), cB1, voffB); PG8_STAGE(PG8_SA(0, 1), cA1, va[1]);
    if (wr == 1) PG8_BAR;
    PG8_WAIT_V(4); PG8_BAR;
    PG8_STAGE(PG8_SB(1, 0), cB0 + kstep, voffB); PG8_STAGE(PG8_SA(1, 0), cA0 + kstep, va[0]); PG8_STAGE(PG8_SB(1, 1), cB1 + kstep, voffB);
    PG8_WAIT_V(6); PG8_BAR;
    for (;;) {
        const bool has_next = S.get(ui + 1, nxt);
        const char* nA0 = has_next ? nxt.a0 : cA0; const char* nA1 = has_next ? nxt.a1 : cA1;
        const char* nB0 = has_next ? nxt.b0 : cB0; const char* nB1 = has_next ? nxt.b1 : cB1;
        const int nt = cur.nt;
        for (int t = 0; t < nt; t += 2) {
            const bool last = (t == nt - 2);
            const char* a1h1 = cA1 + (size_t)(t + 1) * kstep;
            const char* a2h0 = last ? nA0 : cA0 + (size_t)(t + 2) * kstep; const char* a2h1 = last ? nA1 : cA1 + (size_t)(t + 2) * kstep;
            const char* b2h0 = last ? nB0 : cB0 + (size_t)(t + 2) * kstep; const char* b2h1 = last ? nB1 : cB1 + (size_t)(t + 2) * kstep;
            const char* a3h0 = a2h0 + kstep; const char* b3h0 = b2h0 + kstep; const char* b3h1 = b2h1 + kstep;
            PG8_LDB(B0, 0, 0); PG8_SCHED; PG8_LDA(At, 0, 0); PG8_STAGE(PG8_SA(1, 1), a1h1, va[1]);
            if constexpr (GATHER) { if (last && has_next) { PG8_LOADV(nxt, va); } }
            PG8_WAIT_L(8); PG8_BAR; PG8_WAIT_L(0); PG8_MMA(0, 0, At, B0); PG8_BAR; PG8_SCHED;
            PG8_LDB(B1, 0, 1); PG8_STAGE(PG8_SB(0, 0), b2h0, voffB);
            PG8_BAR; PG8_WAIT_L(0); PG8_MMA(0, 1, At, B1); PG8_BAR;
            PG8_LDA(At, 0, 1); PG8_STAGE(PG8_SA(0, 0), a2h0, va[0]);
            PG8_BAR; PG8_WAIT_L(0); PG8_MMA(1, 0, At, B0); PG8_BAR; PG8_SCHED;
            PG8_STAGE(PG8_SB(0, 1), b2h1, voffB);
            PG8_WAIT_V(6); PG8_BAR; PG8_MMA(1, 1, At, B1); PG8_BAR;
            PG8_LDB(B0, 1, 0); PG8_SCHED; PG8_LDA(At, 1, 0); PG8_STAGE(PG8_SA(0, 1), a2h1, va[1]);
            PG8_WAIT_L(8); PG8_BAR; PG8_WAIT_L(0); PG8_MMA(0, 0, At, B0); PG8_BAR; PG8_SCHED;
            PG8_LDB(B1, 1, 1); PG8_STAGE(PG8_SB(1, 0), b3h0, voffB);
            PG8_BAR; PG8_WAIT_L(0); PG8_MMA(0, 1, At, B1); PG8_BAR;
            PG8_LDA(At, 1, 1); PG8_STAGE(PG8_SA(1, 0), a3h0, va[0]);
            PG8_BAR; PG8_WAIT_L(0); PG8_MMA(1, 0, At, B0); PG8_BAR; PG8_SCHED;
            PG8_STAGE(PG8_SB(1, 1), b3h1, voffB);
            PG8_WAIT_V(6); PG8_BAR; PG8_MMA(1, 1, At, B1); PG8_BAR;
        }
        E(acc, cur, wr, wc, fr, fq);
        if (!has_next) break;
#pragma unroll
        for (int a = 0; a < 2; ++a)
#pragma unroll
            for (int b = 0; b < 2; ++b)
#pragma unroll
                for (int m = 0; m < 4; ++m)
#pragma unroll
                    for (int n = 0; n < 2; ++n) acc[a][b][m][n] = (f32x4){0.f, 0.f, 0.f, 0.f};
        cur = nxt; cA0 = nA0; cA1 = nA1; cB0 = nB0; cB1 = nB1; ++ui;
    }
    PG8_WAIT_V(0);
    if (wr == 0) PG8_BAR;
    PG8_BAR;
#undef PG8_SA
#undef PG8_SB
#undef PG8_STAGE
#undef PG8_LDA
#undef PG8_LDB
#undef PG8_MMA
#undef PG8_WAIT_V
#undef PG8_WAIT_L
#undef PG8_BAR
#undef PG8_SCHED
#undef PG8_LOADV
}
}
using pg8::GUnit;

struct Params { const float* in[35]; float* out; unsigned char* ws; };
typedef const Params __attribute__((address_space(4))) CParams;
__device__ __forceinline__ CParams* kparams() { CParams* p = (CParams*)__builtin_amdgcn_kernarg_segment_ptr(); asm volatile("" : "+s"(p)); return p; }
enum { I_X = 0, I_C, I_CTX, I_CCTX, I_WMOD, I_BMOD, I_NMIX, I_NFFN, I_WIN, I_HCW, I_HCB, I_HW1, I_HB1, I_HW2, I_HB2, I_HW3, I_HBIAS, I_PW, I_PS,
       I_SCW, I_SCB, I_SDTB, I_SALOG, I_SD, I_SNORM, I_WBR, I_WGATE, I_WOUT, I_RW, I_RB, I_WUP, I_BUP, I_WDN, I_BDN, I_NFIN };

__device__ __forceinline__ int tok_modj(int t) { return t < TL ? (t >> 12) : 8; }

struct TJob { const float* src; size_t ld_src; int K, N; bf16_t* dst; size_t ld_dst; int nmat; size_t src_ms, dst_ms; const float* kscale; };
__device__ __forceinline__ TJob make_tjob(CParams& P, int l, int j) {
    unsigned char* ws = P.ws; TJob J;
    bf16_t* W1T = (bf16_t*)(ws + WS_W1T) + (size_t)l * N1 * 1024;
    bf16_t* WBRT = (bf16_t*)(ws + WS_WBRT) + (size_t)l * 1024 * YCW;
    const float* wbr = P.in[I_WBR] + (size_t)l * 1280 * 1024;
    J.kscale = nullptr; J.nmat = 1; J.src_ms = 0; J.dst_ms = 0; J.ld_src = 1024; J.K = 1024; J.N = 1024; J.ld_dst = 1024;
    if (j == 0) { J.src = P.in[I_WGATE] + (size_t)l * 4 * 1024 * 1024; J.dst = W1T; J.nmat = 4; J.src_ms = (size_t)1024 * 1024; J.dst_ms = (size_t)1024 * 1024; }
    else if (j == 1) { J.src = P.in[I_WIN] + (size_t)l * 1024 * INW + 256; J.ld_src = INW; J.N = 2576; J.dst = W1T + (size_t)4096 * 1024; }
    else if (j == 2) { J.src = wbr; J.K = 256; J.dst = WBRT; J.ld_dst = YCW; }
    else if (j == 3) { J.src = wbr; J.K = 256; J.dst = WBRT + 256; J.ld_dst = YCW; }
    else if (j == 4) { J.src = wbr + (size_t)256 * 1024; J.K = 256; J.dst = WBRT + 512; J.ld_dst = YCW; }
    else if (j == 5) { J.src = wbr + (size_t)768 * 1024; J.K = 512; J.dst = WBRT + 1024; J.ld_dst = YCW; J.kscale = P.in[I_SNORM] + l * 512; }
    else if (j == 6) { J.src = P.in[I_WOUT] + (size_t)l * 1024 * 1024; J.dst = (bf16_t*)(ws + WS_WOUTT) + (size_t)l * 1024 * 1024; }
    else if (j == 7) { J.src = P.in[I_WUP] + (size_t)l * 32 * 1024 * 2048; J.ld_src = 2048; J.N = 2048; J.dst = (bf16_t*)(ws + WS_WUPT) + (size_t)l * 32 * 2048 * 1024; J.nmat = 32; J.src_ms = (size_t)1024 * 2048; J.dst_ms = (size_t)2048 * 1024; }
    else { J.src = P.in[I_WDN] + (size_t)l * 32 * 1024 * 1024; J.dst = (bf16_t*)(ws + WS_WDNT) + (size_t)l * 32 * 1024 * 1024; J.nmat = 32; J.src_ms = (size_t)1024 * 1024; J.dst_ms = (size_t)1024 * 1024; }
    return J;
}
constexpr int MOE_TILES_P0 = 640;
constexpr int TILES_DENSE = 256 + 176 + 16 + 16 + 16 + 32 + 64, TILES_PER_LAYER = TILES_DENSE + 4096 + 2048;
struct TRef { const float* sr; bf16_t* d; size_t ld_dst; int nval; float sc; };
__device__ __forceinline__ TRef tile_locate(CParams& P, int g, int tid) {
    constexpr int PER_L = 256 + 176 + 16 + 16 + 16 + 32 + 64 + 4096 + 2048;
    const int l = g / PER_L; int r = g % PER_L, j = 0;
    const int cnt[9] = {256, 176, 16, 16, 16, 32, 64, 4096, 2048};
#pragma unroll
    for (int q = 0; q < 8; ++q) { if (j == q && r >= cnt[q]) { r -= cnt[q]; j = q + 1; } }
    const TJob J = make_tjob(P, l, j);
    const int ktiles = J.K / 64, ntiles = (J.N + 255) / 256, per = ktiles * ntiles;
    const int mat = r / per, rr = r % per, nt = rr / ktiles, kt = rr % ktiles;
    TRef T; const int row = tid >> 3;
    T.sr = J.src + (size_t)mat * J.src_ms + (size_t)(kt * 64 + row) * J.ld_src + nt * 256;
    T.d = J.dst + (size_t)mat * J.dst_ms + (size_t)(nt * 256) * J.ld_dst + kt * 64; T.ld_dst = J.ld_dst;
    T.nval = (J.N - nt * 256) < 256 ? (J.N - nt * 256) : 256;
    T.sc = J.kscale ? J.kscale[kt * 64 + row] : 1.f;
    return T;
}
__device__ __forceinline__ void p0_transposes(CParams& P, unsigned char* smem, int lo, int hi, int part, int nparts) {
    float* tile = (float*)smem;
    const int tid = otid(); const int G = nparts, TOTAL = hi;
    const int row = tid >> 3, c0 = (tid & 7) * 4;
    int g = lo + part; bool have = g < TOTAL;
    TRef T = tile_locate(P, have ? g : lo, tid);
    f32x4 v[8];
#pragma unroll
    for (int j = 0; j < 8; ++j) { const int c = c0 + 32 * j; v[j] = (have && c < T.nval) ? *(const f32x4*)(T.sr + c) : (f32x4){0.f, 0.f, 0.f, 0.f}; }
#pragma unroll 1
    while (have) {
        const int gn = g + G; const bool hasn = gn < TOTAL;
        __syncthreads();
#pragma unroll
        for (int j = 0; j < 8; ++j) { float* tp = tile + row * 257 + c0 + 32 * j; tp[0] = v[j][0] * T.sc; tp[1] = v[j][1] * T.sc; tp[2] = v[j][2] * T.sc; tp[3] = v[j][3] * T.sc; }
        bf16_t* d = T.d; const size_t ldd = T.ld_dst; const int nval = T.nval;
        if (hasn) { T = tile_locate(P, gn, tid);
#pragma unroll
            for (int j = 0; j < 8; ++j) { const int c = c0 + 32 * j; v[j] = (c < T.nval) ? *(const f32x4*)(T.sr + c) : (f32x4){0.f, 0.f, 0.f, 0.f}; } }
        __syncthreads();
        { const int n = tid >> 1, kh = (tid & 1) * 32;
          if (n < nval) {
#pragma unroll
              for (int q = 0; q < 4; ++q) { u32x4 o;
#pragma unroll
                  for (int e = 0; e < 4; ++e) o[e] = cvt_pk_bf16(tile[(kh + q * 8 + 2 * e) * 257 + n], tile[(kh + q * 8 + 2 * e + 1) * 257 + n]);
                  *(u32x4*)(d + (size_t)n * ldd + kh + q * 8) = o; } } }
        g = gn; have = hasn;
    }
    __syncthreads();
}

__device__ __forceinline__ void p0_prep(CParams& P, unsigned char* smem) {
    const int G = gridDim.x, tid = otid(), bid = obid();
    unsigned char* ws = P.ws;
    for (int l = 0; l < NL; ++l) p0_transposes(P, smem, l * TILES_PER_LAYER, l * TILES_PER_LAYER + TILES_DENSE + MOE_TILES_P0, bid, G);
    {
        float* wt = (float*)smem;
        float* ctab = wt + 64 * 65; float* stab = ctab + 64;
        if (tid < 64) { float s, c; sincospif((float)tid / 32.f, &s, &c); ctab[tid] = c * 0.125f; stab[tid] = s * 0.125f; }
        for (int it = bid; it < NL * 4 * 16; it += G) {
            const int l = it / 64, g = (it / 16) & 3, kb = it & 15;
            __syncthreads();
            { const int row = tid >> 3, c0 = (tid & 7) * 8; const float* sr = P.in[I_WIN] + ((size_t)l * 1024 + kb * 64 + row) * INW + g * 64 + c0;
#pragma unroll
              for (int j = 0; j < 8; ++j) wt[row * 65 + c0 + j] = sr[j]; }
            __syncthreads();
            const int rp = tid >> 2, kq = tid & 3, half = rp >> 6, cp = rp & 63;
            const float* tab = half ? stab : ctab;
            float o[16];
#pragma unroll
            for (int kk = 0; kk < 16; ++kk) o[kk] = 0.f;
            for (int c = 0; c < 64; ++c) { const float tv = tab[(c * cp) & 63];
#pragma unroll
                for (int kk = 0; kk < 16; ++kk) o[kk] += wt[(kq * 16 + kk) * 65 + c] * tv; }
            bf16_t* d = (bf16_t*)(ws + WS_WFT) + ((size_t)l * 512 + (g * 2 + half) * 64 + cp) * 1024 + kb * 64 + kq * 16;
            u32x4 o0, o1;
#pragma unroll
            for (int e = 0; e < 4; ++e) { o0[e] = cvt_pk_bf16(o[2 * e], o[2 * e + 1]); o1[e] = cvt_pk_bf16(o[8 + 2 * e], o[8 + 2 * e + 1]); }
            *(u32x4*)d = o0; *(u32x4*)(d + 8) = o1;
        }
        __syncthreads();
    }
    {
        float* pw = (float*)smem;
        float* wb = pw + 64 * 65;
        for (int it = bid; it < NL * 4 * 4; it += G) {
            const int l = it / 16, g = (it / 4) & 3, nb = it & 3;
            __syncthreads();
            for (int e = tid; e < 4096; e += NTH) { const int c = e >> 6, d = e & 63;
                pw[c * 65 + d] = P.in[I_PW][(((size_t)l * 4 + g) * 64 + c) * 64 + d] * P.in[I_PS][l * 256 + g * 64 + d]; }
            for (int e = tid; e < 64 * 256; e += NTH) { const int d = e >> 8, n = e & 255;
                wb[d * 257 + n] = P.in[I_WBR][((size_t)l * 1280 + 512 + g * 64 + d) * 1024 + nb * 256 + n]; }
            __syncthreads();
            const int n = tid & 255, ch = tid >> 8;
            bf16_t* d0 = (bf16_t*)(ws + WS_WBRT) + ((size_t)l * 1024 + nb * 256 + n) * YCW + 768 + g * 64 + ch * 32;
            float o[32];
#pragma unroll
            for (int e = 0; e < 32; ++e) o[e] = 0.f;
#pragma unroll 1
            for (int d = 0; d < 64; ++d) { const float wv = wb[d * 257 + n];
#pragma unroll
                for (int e = 0; e < 32; ++e) o[e] += pw[(ch * 32 + e) * 65 + d] * wv; }
#pragma unroll
            for (int q = 0; q < 4; ++q) { u32x4 ov;
#pragma unroll
                for (int e = 0; e < 4; ++e) ov[e] = cvt_pk_bf16(o[q * 8 + 2 * e], o[q * 8 + 2 * e + 1]);
                *(u32x4*)(d0 + q * 8) = ov; }
        }
        __syncthreads();
    }
    {
        bf16_t* D4C = (bf16_t*)(ws + WS_D4C); bf16_t* D4S = (bf16_t*)(ws + WS_D4S); bf16_t* D256 = (bf16_t*)(ws + WS_D256);
        const int gth = bid * NTH + tid, nth = G * NTH;
        for (int ch = gth; ch < 2048 * 512; ch += nth) {
            const int pp = ch >> 9, p0 = (ch & 511) * 8;
            u32x4 oc, os; float cv[8], sv[8];
#pragma unroll
            for (int e = 0; e < 8; ++e) { const int j = (pp * (p0 + e)) & 4095; float s, c; sincospif((float)j / 2048.f, &s, &c); cv[e] = c * (1.f / 64.f); sv[e] = -s * (1.f / 64.f); }
#pragma unroll
            for (int e = 0; e < 4; ++e) { oc[e] = cvt_pk_bf16(cv[2 * e], cv[2 * e + 1]); os[e] = cvt_pk_bf16(sv[2 * e], sv[2 * e + 1]); }
            *(u32x4*)(D4C + (size_t)pp * 4096 + p0) = oc; *(u32x4*)(D4S + (size_t)pp * 4096 + p0) = os;
        }
        for (int ch = gth; ch < 256 * 64; ch += nth) {
            const int pp = ch >> 6, k0 = (ch & 63) * 8; u32x4 o; float v[8];
#pragma unroll
            for (int e = 0; e < 8; ++e) { const int k = k0 + e; const int j = (pp * (k & 255)) & 255; float s, c; sincospif((float)j / 128.f, &s, &c); v[e] = (k < 256 ? c : -s) * (1.f / 16.f); }
#pragma unroll
            for (int e = 0; e < 4; ++e) o[e] = cvt_pk_bf16(v[2 * e], v[2 * e + 1]);
            *(u32x4*)(D256 + (size_t)pp * 4096 + k0) = o;
        }
    }
    {
        float* feats = (float*)smem;
        float* h1 = feats + 64 * 33;
        float* h2 = h1 + 64 * 65;
        const float dmin = 4.605170185988091f / 1.5f, dmax = 4.605170185988091f / 0.3f;
        for (int it = bid; it < NL * 68; it += G) {
            const int l = it / 68, r = it % 68, cfg = r < 64 ? 0 : 1, tile = cfg ? r - 64 : r, n = cfg ? 256 : 4096;
            __syncthreads();
            for (int e = tid; e < 64 * 33; e += NTH) { const int i = e / 33, f = e % 33; const int pos = tile * 64 + i;
                float v;
                if (f == 0) v = (float)pos / (float)(n - 1);
                else { const int j = (f - 1) & 15; const float fr = 1e-4f + (float)j * ((15.f - 1e-4f) / 15.f);
                       const float ang = 6.283185307179586f * (float)pos / (float)n * fr; v = (f <= 16) ? cosf(ang) : -sinf(ang); }
                feats[e] = v; }
            __syncthreads();
            { const int j = tid & 63, pg = tid >> 6; const float* w1 = P.in[I_HW1] + (size_t)l * 33 * 64; const float b = P.in[I_HB1][l * 64 + j];
              for (int q = 0; q < 8; ++q) { const int i = pg * 8 + q; float s = b; for (int f = 0; f < 33; ++f) s += feats[i * 33 + f] * w1[f * 64 + j]; h1[i * 65 + j] = sinf(s); } }
            __syncthreads();
            { const int j = tid & 63, pg = tid >> 6; const float* w2 = P.in[I_HW2] + (size_t)l * 64 * 64; const float b = P.in[I_HB2][l * 64 + j];
              for (int q = 0; q < 8; ++q) { const int i = pg * 8 + q; float s = b; for (int f = 0; f < 64; ++f) s += h1[i * 65 + f] * w2[f * 64 + j]; h2[i * 65 + j] = sinf(s); } }
            __syncthreads();
            { const int o = tid, c = o & 255, dir = o >> 8; const float* w3 = P.in[I_HW3] + (size_t)l * 64 * 512;
              float w[64];
#pragma unroll
              for (int f = 0; f < 64; ++f) w[f] = w3[f * 512 + o];
              const float delta = dmin + (float)c * ((dmax - dmin) / 255.f);
              float* kst = h2 + 64 * 65;
              float* kt = (float*)(ws + WS_KRAW) + ((size_t)l * 2 + cfg) * 512 * 4096 + tile * 64;
              float asum = 0.f;
#pragma unroll 1
              for (int i0 = 0; i0 < 64; i0 += 16) {
#pragma unroll 1
                  for (int ii = 0; ii < 16; ++ii) { const int i = i0 + ii; float s = 0.f;
#pragma unroll
                      for (int f = 0; f < 64; ++f) s += h2[i * 65 + f] * w[f];
                      const int pos = tile * 64 + i; const float tt = (float)pos / (float)(n - 1);
                      s *= expf(-tt * delta);
                      kst[o * 17 + ii] = s;
                      if (!(dir == 1 && pos == 0)) asum += fabsf(s); }
                  __syncthreads();
#pragma unroll
                  for (int q = 0; q < 4; ++q) { const int ch = tid + q * NTH, oo = ch >> 2, j = (ch & 3) * 4; const float* sp = kst + oo * 17 + j;
                      *(f32x4*)(kt + (size_t)oo * 4096 + i0 + j) = (f32x4){sp[0], sp[1], sp[2], sp[3]}; }
                  __syncthreads();
              }
              ((float*)(ws + WS_KPART))[(((size_t)l * 2 + cfg) * 64 + tile) * 512 + o] = asum; }
        }
        __syncthreads();
    }
    for (int e = bid * NTH + tid; e < NL * 32 * 1024; e += G * NTH) { const int l = e >> 15, ex = (e >> 10) & 31, k = e & 1023;
        const float wv = P.in[I_RW][((size_t)l * 1024 + k) * 32 + ex]; const bf16_t hi = f2bf(wv); const bf16_t lo = f2bf(wv - bf2f(hi));
        bf16_t* d = (bf16_t*)(ws + WS_WRT) + (size_t)l * 2 * 32 * 1024 + (size_t)ex * 1024 + k; d[0] = hi; d[32 * 1024] = lo; }
    {
        float* sc = (float*)smem;
        float* red = sc + 9 * 1024;
        for (int it = bid; it < NL * 24; it += G) {
            const int l = it / 24, nb = it % 24;
            __syncthreads();
            for (int e = tid; e < 9 * 1024; e += NTH) { const int j = e >> 10, k = e & 1023; const float v = j < 8 ? P.in[I_C][j * 1024 + k] : P.in[I_CCTX][k]; sc[e] = fsilu(v); }
            __syncthreads();
            const int n = nb * 256 + (tid & 255), kh = tid >> 8;
            const float* w = P.in[I_WMOD] + (size_t)l * 1024 * 6144 + n;
            float a[9];
#pragma unroll
            for (int j = 0; j < 9; ++j) a[j] = 0.f;
#pragma unroll 8
            for (int k = kh * 512; k < kh * 512 + 512; ++k) { const float wv = w[(size_t)k * 6144];
#pragma unroll
                for (int j = 0; j < 9; ++j) a[j] += sc[j * 1024 + k] * wv; }
            if (kh == 1) {
#pragma unroll
                for (int j = 0; j < 9; ++j) red[(tid & 255) * 9 + j] = a[j]; }
            __syncthreads();
            if (kh == 0) { const float b = P.in[I_BMOD][l * 6144 + n];
#pragma unroll
                for (int j = 0; j < 9; ++j) ((float*)(ws + WS_MOD))[((size_t)l * 9 + j) * 6144 + n] = a[j] + red[(tid & 255) * 9 + j] + b; }
        }
        __syncthreads();
    }
}

__device__ __forceinline__ void norm_row_store(const f32x4 (&v)[4], const float* gain, const float* sc, const float* sh, bf16_t* dst, int lane) {
    float ss = 0.f;
#pragma unroll
    for (int q = 0; q < 4; ++q) ss += v[q][0] * v[q][0] + v[q][1] * v[q][1] + v[q][2] * v[q][2] + v[q][3] * v[q][3];
    ss = wave_sum(ss);
    const float rs = rsqrtf(ss * (1.f / 1024.f) + EPSN);
#pragma unroll
    for (int q = 0; q < 4; ++q) { const int c = q * 256 + lane * 4;
        const f32x4 g = *(const f32x4*)(gain + c), a = *(const f32x4*)(sc + c), b = *(const f32x4*)(sh + c);
        u32x2 o; o[0] = cvt_pk_bf16(v[q][0] * rs * g[0] * (1.f + a[0]) + b[0], v[q][1] * rs * g[1] * (1.f + a[1]) + b[1]);
        o[1] = cvt_pk_bf16(v[q][2] * rs * g[2] * (1.f + a[2]) + b[2], v[q][3] * rs * g[3] * (1.f + a[3]) + b[3]);
        *(u32x2*)(dst + c) = o; }
}
__device__ __forceinline__ void p1_norm0(CParams& P) {
    const int tid_ = otid(), lane = tid_ & 63, w = (obid() * NTH + tid_) >> 6, nw = gridDim.x * (NTH / 64);
    bf16_t* H = (bf16_t*)(P.ws + WS_H); const float* MOD = (const float*)(P.ws + WS_MOD);
    for (int t = w; t < T; t += nw) {
        const float* src = t < TL ? P.in[I_X] + (size_t)t * 1024 : P.in[I_CTX] + (size_t)(t - TL) * 1024;
        f32x4 v[4];
#pragma unroll
        for (int q = 0; q < 4; ++q) v[q] = *(const f32x4*)(src + q * 256 + lane * 4);
        const float* md = MOD + (size_t)tok_modj(t) * 6144;
        norm_row_store(v, P.in[I_NMIX], md + 1024, md, H + (size_t)t * 1024, lane);
    }
}

#ifndef EXP_P3
#define EXP_P3 0
#endif
struct TileGeo { int tok0, b, pos0, slen, isctx; };
__device__ __forceinline__ TileGeo tile_geo(int tt) {
    TileGeo g; g.tok0 = tt * 64;
    if (g.tok0 < TL) { g.isctx = 0; g.b = g.tok0 >> 12; g.pos0 = g.tok0 & 4095; g.slen = 4096; }
    else { g.isctx = 1; const int r = g.tok0 - TL; g.b = r >> 8; g.pos0 = r & 255; g.slen = 256; }
    return g;
}
__device__ __forceinline__ void unpack4(u32x2 u, float (&o)[4]) { o[0] = bflo(u[0]); o[1] = bfhi(u[0]); o[2] = bflo(u[1]); o[3] = bfhi(u[1]); }
__device__ __forceinline__ void unpack8(u32x4 u, float (&o)[8]) {
#pragma unroll
    for (int e = 0; e < 4; ++e) { o[2 * e] = bflo(u[e]); o[2 * e + 1] = bfhi(u[e]); } }

__device__ __forceinline__ void p3_prep(CParams& P, unsigned char* smem, int l) {
    const int G = gridDim.x, tid = otid(), bid = obid();
    unsigned char* ws = P.ws;
    const bf16_t* PJ = (const bf16_t*)(ws + WS_PJ);
    if (!(EXP_P3 & 1)) {
        bf16_t* vvL = (bf16_t*)smem;
        const int c4 = tid & 63, tq = tid >> 6;
        const float* cw = P.in[I_HCW] + (size_t)l * 3 * 768; const float* cb = P.in[I_HCB] + (size_t)l * 768;
        float wx[3][4], wv[3][4], bx[4], bv[4];
#pragma unroll
        for (int e = 0; e < 4; ++e) { bx[e] = cb[256 + 4 * c4 + e]; bv[e] = cb[512 + 4 * c4 + e];
#pragma unroll
            for (int k = 0; k < 3; ++k) { wx[k][e] = cw[k * 768 + 256 + 4 * c4 + e]; wv[k][e] = cw[k * 768 + 512 + 4 * c4 + e]; } }
        u32x2 xq[10], vq[10]; bool okq[10];
#define P3A_REQ(ttx) do { const TileGeo g_ = tile_geo(ttx); const int p0_ = g_.pos0 + tq * 8; const bf16_t* rowp_ = PJ + (size_t)(g_.tok0 + tq * 8) * PJW; \
            _Pragma("unroll") for (int j = 0; j < 10; ++j) { const int pp = p0_ + j - 1; okq[j] = (pp >= 0 && pp < g_.slen); const bf16_t* rp = rowp_ + (ptrdiff_t)(okq[j] ? j - 1 : 0) * PJW; \
                xq[j] = *(const u32x2*)(rp + 256 + 4 * c4); vq[j] = *(const u32x2*)(rp + 512 + 4 * c4); } } while (0)
        int tt = bid;
        if (tt < T / 64) P3A_REQ(tt);
#pragma unroll 1
        for (; tt < T / 64; tt += G) {
            const TileGeo g = tile_geo(tt);
            float rx[3][4], rv[3][4], vva[8][4];
#define P3A_ROW(k, j) do { unpack4(xq[j], rx[k]); unpack4(vq[j], rv[k]); _Pragma("unroll") for (int e = 0; e < 4; ++e) { rx[k][e] = okq[j] ? rx[k][e] : 0.f; rv[k][e] = okq[j] ? rv[k][e] : 0.f; } } while (0)
            P3A_ROW(0, 0); P3A_ROW(1, 1);
#pragma unroll
            for (int j = 0; j < 8; ++j) {
                P3A_ROW(2, j + 2);
#pragma unroll
                for (int e = 0; e < 4; ++e) {
                    const float x2 = wx[0][e] * rx[0][e] + wx[1][e] * rx[1][e] + wx[2][e] * rx[2][e] + bx[e];
                    const float vv = wv[0][e] * rv[0][e] + wv[1][e] * rv[1][e] + wv[2][e] * rv[2][e] + bv[e];
                    vva[j][e] = x2 * vv;
                    rx[0][e] = rx[1][e]; rx[1][e] = rx[2][e]; rv[0][e] = rv[1][e]; rv[1][e] = rv[2][e]; }
            }
#undef P3A_ROW
#pragma unroll
            for (int e = 0; e < 4; ++e) { u32x4 o4;
#pragma unroll
                for (int p = 0; p < 4; ++p) o4[p] = cvt_pk_bf16(vva[2 * p][e], vva[2 * p + 1][e]);
                *(u32x4*)(vvL + (4 * c4 + e) * 72 + ((tq + (c4 & 7)) & 7) * 8) = o4; }
            if (tt + G < T / 64) P3A_REQ(tt + G);
            __syncthreads();
            { const int c = tid >> 1, hf = tid & 1;
              bf16_t* d = g.isctx ? (bf16_t*)(ws + WS_VVTC) + ((size_t)g.b * 256 + c) * 256 + g.pos0 + hf * 32
                                  : (bf16_t*)(ws + WS_VVT) + ((size_t)g.b * 256 + c) * 4096 + g.pos0 + hf * 32;
#pragma unroll
              for (int q = 0; q < 4; ++q) *(u32x4*)(d + q * 8) = *(const u32x4*)(vvL + c * 72 + (((hf * 4 + q) + ((c >> 2) & 7)) & 7) * 8); }
            __syncthreads();
        }
#undef P3A_REQ
    }
    if (!(EXP_P3 & 2)) {
        bf16_t* YC = (bf16_t*)(ws + WS_YC);
        const int c8 = tid & 31, ts = tid >> 5;
        const int gi = c8 >> 3, hw = 1 << gi;
        for (int tt = (bid + 85) % G; tt < T / 64; tt += G) {
            const TileGeo g = tile_geo(tt);
            const int rlen = g.isctx ? 256 : 64;
            const int tl0 = ts * 4, rpos0 = (g.pos0 + tl0) % rlen;
            const bf16_t* base = PJ + (size_t)(g.tok0 + tl0 - rpos0) * PJW + 768 + 8 * c8;
            float sm4[4][8], self[4][8];
#pragma unroll
            for (int q = 0; q < 4; ++q)
#pragma unroll
                for (int e = 0; e < 8; ++e) sm4[q][e] = 0.f;
            u32x4 rw[19];
#pragma unroll
            for (int dj = -8; dj < 11; ++dj) { int j = rpos0 + dj; j = j < 0 ? 0 : (j >= rlen ? rlen - 1 : j); rw[dj + 8] = *(const u32x4*)(base + (size_t)j * PJW); }
#pragma unroll
            for (int dj = -8; dj < 11; ++dj) {
                const int j = rpos0 + dj; const bool inrow = (j >= 0 && j < rlen);
                float v[8]; unpack8(rw[dj + 8], v);
#pragma unroll
                for (int q = 0; q < 4; ++q) {
                    const bool inw = inrow && dj >= q - hw && dj < q + hw;
#pragma unroll
                    for (int e = 0; e < 8; ++e) sm4[q][e] += inw ? v[e] : 0.f;
                    if (dj == q) {
#pragma unroll
                        for (int e = 0; e < 8; ++e) self[q][e] = v[e]; } }
            }
#pragma unroll
            for (int q = 0; q < 4; ++q) {
                const int rpos = rpos0 + q; int lo = rpos - hw; lo = lo < 0 ? 0 : lo; int hi = rpos + hw; hi = hi > rlen ? rlen : hi;
                const float inv = 1.f / (float)(hi - lo);
                u32x4 o;
#pragma unroll
                for (int e = 0; e < 4; ++e) o[e] = cvt_pk_bf16(sm4[q][2 * e] * inv - self[q][2 * e], sm4[q][2 * e + 1] * inv - self[q][2 * e + 1]);
                *(u32x4*)(YC + (size_t)(g.tok0 + tl0 + q) * YCW + 768 + 8 * c8) = o;
            }
        }
    }
    if (!(EXP_P3 & 4)) {
        bf16_t* xsL = (bf16_t*)smem;
        bf16_t* XBN = (bf16_t*)(ws + WS_XBN);
        const int c8 = tid & 127, tq = tid >> 7;
        const float* cw = P.in[I_SCW] + (size_t)l * 3 * 1024; const float* cb = P.in[I_SCB] + (size_t)l * 1024;
        float w[3][8], bb[8];
#pragma unroll
        for (int e = 0; e < 8; ++e) { bb[e] = cb[8 * c8 + e];
#pragma unroll
            for (int k = 0; k < 3; ++k) w[k][e] = cw[k * 1024 + 8 * c8 + e]; }
        u32x4 rw[18]; bool okr[18];
#define P3C_REQ(ttx) do { const TileGeo g_ = tile_geo(ttx); const int p0_ = g_.pos0 + tq * 16; const bf16_t* rowp_ = PJ + (size_t)(g_.tok0 + tq * 16) * PJW + 1536 + 8 * c8; \
            _Pragma("unroll") for (int j = 0; j < 18; ++j) { const int pp = p0_ + j - 1; okr[j] = (pp >= 0 && pp < g_.slen); rw[j] = *(const u32x4*)(rowp_ + (ptrdiff_t)(okr[j] ? j - 1 : 0) * PJW); } } while (0)
        int tt = (bid + 170) % G;
        if (tt < T / 64) P3C_REQ(tt);
#pragma unroll 1
        for (; tt < T / 64; tt += G) {
            const TileGeo g = tile_geo(tt);
            float r0[8], r1[8], r2[8]; u32x4 oall[16];
            unpack8(rw[0], r0); unpack8(rw[1], r1);
#pragma unroll
            for (int e = 0; e < 8; ++e) { r0[e] = okr[0] ? r0[e] : 0.f; r1[e] = okr[1] ? r1[e] : 0.f; }
#pragma unroll
            for (int j = 0; j < 16; ++j) {
                unpack8(rw[j + 2], r2);
#pragma unroll
                for (int e = 0; e < 8; ++e) r2[e] = okr[j + 2] ? r2[e] : 0.f;
                float o[8];
#pragma unroll
                for (int e = 0; e < 8; ++e) { o[e] = fsilu(w[0][e] * r0[e] + w[1][e] * r1[e] + w[2][e] * r2[e] + bb[e]); r0[e] = r1[e]; r1[e] = r2[e]; }
                u32x4 ov;
#pragma unroll
                for (int e = 0; e < 4; ++e) ov[e] = cvt_pk_bf16(o[2 * e], o[2 * e + 1]);
                *(u32x4*)(XBN + (size_t)(g.tok0 + tq * 16 + j) * 1024 + 8 * c8) = ov;
                oall[j] = ov;
            }
            if (c8 < 96) {
#pragma unroll
                for (int e = 0; e < 8; ++e) { u32x4 lo4, hi4;
#pragma unroll
                    for (int p = 0; p < 4; ++p) {
                        lo4[p] = __builtin_amdgcn_perm(oall[2 * p + 1][e >> 1], oall[2 * p][e >> 1], (e & 1) ? 0x07060302u : 0x05040100u);
                        hi4[p] = __builtin_amdgcn_perm(oall[2 * p + 9][e >> 1], oall[2 * p + 8][e >> 1], (e & 1) ? 0x07060302u : 0x05040100u); }
                    bf16_t* rowb = xsL + (8 * c8 + e) * 72; const int rot = c8 & 7;
                    *(u32x4*)(rowb + (((tq * 2) + rot) & 7) * 8) = lo4; *(u32x4*)(rowb + (((tq * 2 + 1) + rot) & 7) * 8) = hi4; }
            }
            if (tt + G < T / 64) P3C_REQ(tt + G);
            __syncthreads();
            for (int ch = tid; ch < 768 * 8; ch += NTH) { const int c = ch >> 3, q = ch & 7;
                bf16_t* d = g.isctx ? (bf16_t*)(ws + WS_XSTC) + ((size_t)g.b * 768 + c) * 256 + g.pos0 + q * 8
                                    : (bf16_t*)(ws + WS_XST) + ((size_t)g.b * 768 + c) * 4096 + g.pos0 + q * 8;
                *(u32x4*)d = *(const u32x4*)(xsL + c * 72 + ((q + ((c >> 3) & 7)) & 7) * 8); }
            __syncthreads();
        }
#undef P3C_REQ
        const float* dtr = (const float*)(ws + WS_DTR); float* dt = (float*)(ws + WS_DT);
        for (int e = bid * NTH + tid; e < T * 16; e += G * NTH) dt[e] = fsoftplus(dtr[e] + P.in[I_SDTB][l * 16 + (e & 15)]);
    }
}

#define EPI_ROWS_BEGIN _Pragma("unroll") for (int ai = 0; ai < 2; ++ai) { _Pragma("unroll") for (int m = 0; m < 4; ++m) { const int rl = ai * 128 + wr * 64 + m * 16 + fr;
#define EPI_ROWS_END } }
#ifndef EXP_BR
#define EXP_BR 0
#endif
typedef f32x4 acc_t[2][2][4][2];
__device__ __forceinline__ u32x4 pack8(const f32x4& a, const f32x4& b) { u32x4 o; o[0] = cvt_pk_bf16(a[0], a[1]); o[1] = cvt_pk_bf16(a[2], a[3]); o[2] = cvt_pk_bf16(b[0], b[1]); o[3] = cvt_pk_bf16(b[2], b[3]); return o; }

struct Src1 {
    const char* H; const char* W1T; const char* WFT; int G, c;
    __device__ __forceinline__ bool get(int i, GUnit& u) const {
        const int L = i * G + c; constexpr int NU1 = (T / 256) * (N1 / 256);
        if (L < NU1) { int pm, pn; pg8::remap_tile(L, T / 256, N1 / 256, pm, pn);
            u.a0 = H + (size_t)pm * 256 * 2048; u.a1 = u.a0 + (size_t)128 * 2048; u.b0 = W1T + (size_t)pn * 256 * 2048; u.b1 = u.b0 + (size_t)128 * 2048;
            u.nt = 16; u.pm = pm; u.pn = pn; u.kind = pn < 16 ? 0 : (pn < 26 ? 1 : 2); u.gidx = nullptr; u.e = 0; return true; }
        const int j = L - NU1; if (j >= 2 * (T / 256)) return false;
        const int pm = j & 1, pn = j >> 1;
        u.a0 = WFT + (size_t)pm * 256 * 2048; u.a1 = u.a0 + (size_t)128 * 2048; u.b0 = H + (size_t)pn * 256 * 2048; u.b1 = u.b0 + (size_t)128 * 2048;
        u.nt = 16; u.pm = pm; u.pn = pn; u.kind = 3; u.gidx = nullptr; u.e = 0; return true;
    }
};
struct Epi1 {
    bf16_t* Gt; bf16_t* PJ; float* DTR; bf16_t* VT; bf16_t* VTC;
    __device__ __forceinline__ void operator()(const acc_t& acc, const GUnit& u, int wr, int wc, int fr, int fq) const {
        const int cl = wc * 32 + 8 * fq;
        if (u.kind == 0) {
            EPI_ROWS_BEGIN { bf16_t* rp = Gt + (size_t)(u.pm * 256 + rl) * 4096 + u.pn * 256 + cl;
#pragma unroll
                for (int bj = 0; bj < 2; ++bj) { f32x4 a = acc[ai][bj][m][0], b = acc[ai][bj][m][1];
#pragma unroll
                    for (int e = 0; e < 4; ++e) { a[e] = fsigmoid(a[e]); b[e] = fsigmoid(b[e]); }
                    *(u32x4*)(rp + bj * 128) = pack8(a, b); } } EPI_ROWS_END
        } else if (u.kind == 1) {
            EPI_ROWS_BEGIN { bf16_t* rp = PJ + (size_t)(u.pm * 256 + rl) * PJW + (u.pn - 16) * 256 + cl;
#pragma unroll
                for (int bj = 0; bj < 2; ++bj) *(u32x4*)(rp + bj * 128) = pack8(acc[ai][bj][m][0], acc[ai][bj][m][1]); } EPI_ROWS_END
        } else if (u.kind == 2) {
            if (wc == 0 && fq < 2) {
                EPI_ROWS_BEGIN { float* rp = DTR + (size_t)(u.pm * 256 + rl) * 16 + 8 * fq; *(f32x4*)rp = acc[ai][0][m][0]; *(f32x4*)(rp + 4) = acc[ai][0][m][1]; } EPI_ROWS_END
            }
        } else {
#pragma unroll
            for (int bj = 0; bj < 2; ++bj) {
                const int tok = u.pn * 256 + bj * 128 + cl;
                bf16_t* cb;
                if (tok < TL) { const int b = tok >> 12, p = tok & 4095; cb = VT + ((size_t)b * 256) * 8192 + p; }
                else { const int r = tok - TL, b = r >> 8, q = r & 255; cb = VTC + ((size_t)b * 256) * 8192 + q; }
                const int hoff = tok < TL ? 4096 : 256;
                EPI_ROWS_BEGIN { const int r = u.pm * 256 + rl, g = r >> 7, half = (r >> 6) & 1, cp = r & 63;
                    *(u32x4*)(cb + (size_t)(g * 64 + cp) * 8192 + half * hoff) = pack8(acc[ai][bj][m][0], acc[ai][bj][m][1]); } EPI_ROWS_END
            }
        }
    }
};

struct SrcDft {
    const char* D4C; const char* D4S; const char* D256; const char* VT; const char* VTC; int first, step;
    __device__ __forceinline__ bool get(int i, GUnit& u) const {
        const int L = first + i * step; u.gidx = nullptr; u.e = 0;
        if (L < 0 || L >= 136) return false;
        if (L < 128) { const int sc = L >> 6, r = L & 63, pm = r & 7, pn = r >> 3;
            u.a0 = (sc ? D4S : D4C) + (size_t)pm * 256 * 8192; u.a1 = u.a0 + (size_t)128 * 8192;
            u.b0 = VT + (size_t)pn * 256 * 16384 + (size_t)sc * 8192; u.b1 = u.b0 + (size_t)128 * 16384;
            u.nt = 64; u.pm = pm; u.pn = pn; u.kind = sc; return true; }
        const int pn = L - 128;
        u.a0 = D256; u.a1 = u.a0 + (size_t)128 * 8192; u.b0 = VTC + (size_t)pn * 256 * 16384; u.b1 = u.b0 + (size_t)128 * 16384;
        u.nt = 8; u.pm = 0; u.pn = pn; u.kind = 2; return true;
    }
};
struct EpiDft {
    bf16_t* YC;
    __device__ __forceinline__ void operator()(const acc_t& acc, const GUnit& u, int wr, int wc, int fr, int fq) const {
        const int cl = wc * 32 + 8 * fq;
        if (u.kind == 2) {
            EPI_ROWS_BEGIN { bf16_t* rp = YC + (size_t)(TL + u.pn * 256 + rl) * YCW + cl;
#pragma unroll
                for (int bj = 0; bj < 2; ++bj) { const u32x4 o = pack8(acc[ai][bj][m][0] * 0.5f, acc[ai][bj][m][1] * 0.5f); *(u32x4*)(rp + bj * 128) = o; *(u32x4*)(rp + 256 + bj * 128) = o; } } EPI_ROWS_END
        } else {
            const int coff = u.kind == 1 ? 256 : 0; const float msign = u.kind == 1 ? -1.f : 1.f;
            EPI_ROWS_BEGIN { const int pp = u.pm * 256 + rl;
                bf16_t* rp = YC + (size_t)(u.pn * 4096 + pp) * YCW + coff + cl;
                bf16_t* rm = YC + (size_t)(u.pn * 4096 + ((4096 - pp) & 4095)) * YCW + coff + cl;
#pragma unroll
                for (int bj = 0; bj < 2; ++bj) { *(u32x4*)(rp + bj * 128) = pack8(acc[ai][bj][m][0], acc[ai][bj][m][1]);
                    if (pp != 0) *(u32x4*)(rm + bj * 128) = pack8(acc[ai][bj][m][0] * msign, acc[ai][bj][m][1] * msign); } } EPI_ROWS_END
        }
    }
};
__device__ __forceinline__ void dft_nyquist(const bf16_t* VT, bf16_t* YC, int row0, int nrows) {
    const int tid = otid(), lane = tid & 63, w = tid >> 6;
    for (int vr = row0 + w; vr < row0 + nrows && vr < 2048; vr += NTH / 64) {
        const bf16_t* src = VT + (size_t)vr * 8192;
        float s = 0.f;
#pragma unroll
        for (int q = 0; q < 8; ++q) { float v[8]; unpack8(*(const u32x4*)(src + q * 512 + lane * 8), v);
            s += (v[0] - v[1]) + (v[2] - v[3]) + (v[4] - v[5]) + (v[6] - v[7]); }
        s = wave_sum(s) * (1.f / 64.f);
        if (lane == 0) { const int b = vr >> 8, gc = vr & 255; bf16_t* d = YC + (size_t)(b * 4096 + 2048) * YCW + gc; d[0] = f2bf(s); d[256] = (bf16_t)0; }
    }
}

struct SrcBr {
    const char* YC; const char* WBRT; int G, c, nM;
    __device__ __forceinline__ bool get(int i, GUnit& u) const {
        const int k = i & 3, L = (i >> 2) * G + c; if (L >= nM * 4) return false;
        int pm, pn; pg8::remap_tile(L, nM, 4, pm, pn);
        const int koff = k == 0 ? 0 : (k == 1 ? 512 : (k == 2 ? 768 : 1024));
        u.a0 = YC + ((size_t)pm * 256 * YCW + koff) * 2; u.a1 = u.a0 + (size_t)128 * YCW * 2;
        u.b0 = WBRT + ((size_t)pn * 256 * YCW + koff) * 2; u.b1 = u.b0 + (size_t)128 * YCW * 2;
        u.nt = (k == 0 || k == 3) ? 8 : 4; u.pm = pm; u.pn = pn; u.kind = k; u.gidx = nullptr; u.e = 0; return true;
    }
};
struct EpiBr {
    const bf16_t* Gt; bf16_t* MG; const float* SSQ;
    __device__ __forceinline__ void operator()(const acc_t& acc, const GUnit& u, int wr, int wc, int fr, int fq) const {
        if (EXP_BR >= 2) return;
        const int cl = wc * 32 + 8 * fq, k = u.kind;
        const size_t row0 = (size_t)u.pm * 256 + wr * 64 + fr;
        const int colb = u.pn * 256 + cl;
        float rs[8];
#pragma unroll
        for (int i = 0; i < 8; ++i) rs[i] = 1.f;
        if (k == 3) {
            f32x4 s0[8], s1[8];
#pragma unroll
            for (int i = 0; i < 8; ++i) { const size_t row = row0 + (i >> 2) * 128 + (i & 3) * 16; s0[i] = *(const f32x4*)(SSQ + row * 8); s1[i] = *(const f32x4*)(SSQ + row * 8 + 4); }
#pragma unroll
            for (int i = 0; i < 8; ++i) rs[i] = rsqrtf((s0[i][0] + s0[i][1] + s0[i][2] + s0[i][3] + s1[i][0] + s1[i][1] + s1[i][2] + s1[i][3]) * (1.f / 512.f) + EPSN);
        }
#pragma unroll
        for (int ai = 0; ai < 2; ++ai) {
            u32x4 gv[4][2], mv[4][2];
#pragma unroll
            for (int m = 0; m < 4; ++m)
#pragma unroll
                for (int bj = 0; bj < 2; ++bj) { const size_t row = row0 + ai * 128 + m * 16;
                    gv[m][bj] = EXP_BR >= 1 ? (u32x4){0x3f803f80u, 0x3f803f80u, 0x3f803f80u, 0x3f803f80u} : *(const u32x4*)(Gt + row * 4096 + k * 1024 + colb + bj * 128);
                    mv[m][bj] = (k == 0 || EXP_BR >= 1) ? (u32x4){0u, 0u, 0u, 0u} : *(const u32x4*)(MG + row * 1024 + colb + bj * 128); }
#pragma unroll
            for (int m = 0; m < 4; ++m)
#pragma unroll
                for (int bj = 0; bj < 2; ++bj) { const size_t row = row0 + ai * 128 + m * 16;
                    float gt[8], mg[8]; unpack8(gv[m][bj], gt); unpack8(mv[m][bj], mg);
                    f32x4 a = acc[ai][bj][m][0], b = acc[ai][bj][m][1]; const float r = rs[ai * 4 + m];
#pragma unroll
                    for (int e = 0; e < 4; ++e) { a[e] = mg[e] + gt[e] * a[e] * r; b[e] = mg[4 + e] + gt[4 + e] * b[e] * r; }
                    *(u32x4*)(MG + row * 1024 + colb + bj * 128) = pack8(a, b); }
        }
    }
};

struct SrcOut {
    const char* MG; const char* WOUTT; int G, c, nM;
    __device__ __forceinline__ bool get(int i, GUnit& u) const {
        const int L = i * G + c; if (L >= nM * 4) return false;
        int pm, pn; pg8::remap_tile(L, nM, 4, pm, pn);
        u.a0 = MG + (size_t)pm * 256 * 2048; u.a1 = u.a0 + (size_t)128 * 2048; u.b0 = WOUTT + (size_t)pn * 256 * 2048; u.b1 = u.b0 + (size_t)128 * 2048;
        u.nt = 16; u.pm = pm; u.pn = pn; u.kind = 0; u.gidx = nullptr; u.e = 0; return true;
    }
};
template <bool F32IN> struct EpiOut {
    const void* xlat; const void* xctx; bf16_t* X1; const float* MODL;
    __device__ __forceinline__ void operator()(const acc_t& acc, const GUnit& u, int wr, int wc, int fr, int fq) const {
        const int cl = wc * 32 + 8 * fq;
        const int mj = u.pm < TL / 256 ? (u.pm >> 4) : 8;
        const size_t xoff = u.pm < TL / 256 ? (size_t)u.pm * 256 * 1024 : (size_t)(u.pm - TL / 256) * 256 * 1024;
        const void* xb = u.pm < TL / 256 ? xlat : xctx;
        const float* g1 = MODL + (size_t)mj * 6144 + 2048 + u.pn * 256 + cl;
        f32x4 gv[2][2];
#pragma unroll
        for (int bj = 0; bj < 2; ++bj) { gv[bj][0] = *(const f32x4*)(g1 + bj * 128); gv[bj][1] = *(const f32x4*)(g1 + bj * 128 + 4); }
#pragma unroll
        for (int ai = 0; ai < 2; ++ai) {
            f32x4 xv[4][2][2];
#pragma unroll
            for (int m = 0; m < 4; ++m)
#pragma unroll
                for (int bj = 0; bj < 2; ++bj) { const size_t o = xoff + (size_t)(ai * 128 + wr * 64 + m * 16 + fr) * 1024 + u.pn * 256 + cl + bj * 128;
                    if constexpr (F32IN) { const float* xr = (const float*)xb + o; xv[m][bj][0] = *(const f32x4*)xr; xv[m][bj][1] = *(const f32x4*)(xr + 4); }
                    else { float t[8]; unpack8(*(const u32x4*)((const bf16_t*)xb + o), t); xv[m][bj][0] = (f32x4){t[0], t[1], t[2], t[3]}; xv[m][bj][1] = (f32x4){t[4], t[5], t[6], t[7]}; } }
#pragma unroll
            for (int m = 0; m < 4; ++m)
#pragma unroll
                for (int bj = 0; bj < 2; ++bj) { bf16_t* orow = X1 + ((size_t)u.pm * 256 + ai * 128 + wr * 64 + m * 16 + fr) * 1024 + u.pn * 256 + cl + bj * 128;
                    *(u32x4*)orow = pack8(xv[m][bj][0] + gv[bj][0] * acc[ai][bj][m][0], xv[m][bj][1] + gv[bj][1] * acc[ai][bj][m][1]); }
        }
    }
};

struct SrcUp {
    const char* H2; const char* WUPT; const int* rtok; const int* meta; int G, c;
    __device__ __forceinline__ bool get(int i, GUnit& u) const {
        const int nu = meta[33]; int ru, j;
        if (G == 256) {
            const int x = c & 7, y = c >> 3; ru = i * 32 + (x >> 1) * 8 + (y & 7); j = (x & 1) * 4 + (y >> 3);
            if (i * 32 >= nu) return false;
            if (ru >= nu) { ru = nu - 1; j = -1; }
        } else { const int L = i * G + c; if (L >= nu * 8) return false; ru = L >> 3; j = L & 7; }
        if (j < 0) return false;
        int e = 0;
#pragma unroll
        for (int s = 16; s > 0; s >>= 1) if (meta[e + s] <= ru) e += s;
        u.a0 = H2; u.a1 = H2; u.gidx = rtok + (size_t)ru * 256;
        u.b0 = WUPT + ((size_t)e * 2048 + j * 128) * 2048; u.b1 = u.b0 + (size_t)1024 * 2048;
        u.nt = 16; u.pm = ru; u.pn = j; u.kind = 0; u.e = e; return true;
    }
};
struct EpiUp {
    bf16_t* ACT; const float* BUP;
    __device__ __forceinline__ void operator()(const acc_t& acc, const GUnit& u, int wr, int wc, int fr, int fq) const {
        const int cl = wc * 32 + 8 * fq, col = u.pn * 128 + cl;
        const float* bp = BUP + (size_t)u.e * 2048 + col;
        const f32x4 bg0 = *(const f32x4*)bp, bg1 = *(const f32x4*)(bp + 4), bl0 = *(const f32x4*)(bp + 1024), bl1 = *(const f32x4*)(bp + 1028);
        EPI_ROWS_BEGIN { f32x4 g0 = acc[ai][0][m][0] + bg0, g1 = acc[ai][0][m][1] + bg1, l0 = acc[ai][1][m][0] + bl0, l1 = acc[ai][1][m][1] + bl1;
#pragma unroll
            for (int e = 0; e < 4; ++e) {
                float a = fminf(g0[e], 7.f), b = fminf(fmaxf(l0[e], -7.f), 7.f); g0[e] = a * fsigmoid(1.702f * a) * (b + 1.f);
                a = fminf(g1[e], 7.f); b = fminf(fmaxf(l1[e], -7.f), 7.f); g1[e] = a * fsigmoid(1.702f * a) * (b + 1.f); }
            *(u32x4*)(ACT + ((size_t)u.pm * 256 + rl) * 1024 + col) = pack8(g0, g1); } EPI_ROWS_END
    }
};
struct SrcDn {
    const char* ACT; const char* WDNT; const int* meta; int G, c;
    __device__ __forceinline__ bool get(int i, GUnit& u) const {
        const int nu = meta[33]; int ru, j;
        if (G == 256) {
            const int x = c & 7, y = c >> 3; ru = i * 64 + x * 8 + (y & 7); j = y >> 3;
            if (i * 64 >= nu || ru >= nu) return false;
        } else { const int L = i * G + c; if (L >= nu * 4) return false; ru = L >> 2; j = L & 3; }
        int e = 0;
#pragma unroll
        for (int s = 16; s > 0; s >>= 1) if (meta[e + s] <= ru) e += s;
        u.a0 = ACT + (size_t)ru * 256 * 2048; u.a1 = u.a0 + (size_t)128 * 2048;
        u.b0 = WDNT + ((size_t)e * 1024 + j * 256) * 2048; u.b1 = u.b0 + (size_t)128 * 2048;
        u.nt = 16; u.pm = ru; u.pn = j; u.kind = 0; u.e = e; u.gidx = nullptr; return true;
    }
};
struct EpiDn {
    bf16_t* YP; const float* BDN; const int* rpair; const float* rw;
    __device__ __forceinline__ void operator()(const acc_t& acc, const GUnit& u, int wr, int wc, int fr, int fq) const {
        const int cl = wc * 32 + 8 * fq;
        const float* bp = BDN + (size_t)u.e * 1024 + u.pn * 256 + cl;
        f32x4 bv[2][2];
#pragma unroll
        for (int bj = 0; bj < 2; ++bj) { bv[bj][0] = *(const f32x4*)(bp + bj * 128); bv[bj][1] = *(const f32x4*)(bp + bj * 128 + 4); }
        int pr[8]; float wv[8];
#pragma unroll
        for (int i = 0; i < 8; ++i) { const int prow = u.pm * 256 + (i >> 2) * 128 + wr * 64 + (i & 3) * 16 + fr; pr[i] = rpair[prow]; wv[i] = rw[prow]; }
#pragma unroll
        for (int ai = 0; ai < 2; ++ai)
#pragma unroll
            for (int m = 0; m < 4; ++m) { const int pair = pr[ai * 4 + m];
                if (pair >= 0) { const float w = wv[ai * 4 + m]; bf16_t* op = YP + (size_t)pair * 1024 + u.pn * 256 + cl;
#pragma unroll
                    for (int bj = 0; bj < 2; ++bj) *(u32x4*)(op + bj * 128) = pack8((acc[ai][bj][m][0] + bv[bj][0]) * w, (acc[ai][bj][m][1] + bv[bj][1]) * w); } }
    }
};

constexpr int HY_FC = 0, HY_VI = 65536, HY_VRS = 8512, HY_YRS = 4116;
__device__ __forceinline__ void hyena_conv_channel(CParams& P, unsigned char* smem, LAS unsigned char* lds, int l, int c) {
    const int tid = otid(), lane = tid & 63, wid = __builtin_amdgcn_readfirstlane(tid >> 6);
    unsigned char* ws = P.ws;
    const float* KT = (const float*)(ws + WS_KRAW) + (size_t)l * 2 * 512 * 4096;
    const float* KPART = (const float*)(ws + WS_KPART) + (size_t)l * 2 * 64 * 512;
    {
        __syncthreads();
        float* red = (float*)(smem + 140000);
        if (tid < 64) { float s = KPART[(size_t)tid * 512 + c] + KPART[(size_t)tid * 512 + 256 + c]; s = wave_sum(s); if (tid == 0) red[0] = 1.f / s; }
        const f32x4 f0 = *(const f32x4*)(KT + (size_t)c * 4096 + tid * 8), f1 = *(const f32x4*)(KT + (size_t)c * 4096 + tid * 8 + 4);
        const f32x4 g0 = *(const f32x4*)(KT + (size_t)(256 + c) * 4096 + tid * 8), g1 = *(const f32x4*)(KT + (size_t)(256 + c) * 4096 + tid * 8 + 4);
        {
            if (tid < 4) ((unsigned*)(smem + HY_VI + 8 * HY_VRS))[tid] = 0u;
            const bf16_t* vsrc = (const bf16_t*)(ws + WS_VVT) + (size_t)c * 4096;
#pragma unroll
            for (int q = 0; q < 8; ++q) { const int ch = tid + q * NTH, b = ch >> 9, s = (ch & 511) * 8;
                *(u32x4*)(smem + HY_VI + b * HY_VRS + s * 2 + 16 * (s >> 8)) = *(const u32x4*)(vsrc + (size_t)b * 256 * 4096 + s); }
        }
        __syncthreads();
        const float inv = red[0];
        bf16_t* fc = (bf16_t*)(smem + HY_FC);
        const float fw[8] = {f0[0], f0[1], f0[2], f0[3], f1[0], f1[1], f1[2], f1[3]}, bw[8] = {g0[0], g0[1], g0[2], g0[3], g1[0], g1[1], g1[2], g1[3]};
#pragma unroll
        for (int e = 0; e < 8; ++e) { const int lag = tid * 8 + e; const bf16_t fv = f2bf(fw[e] * inv), bv = f2bf(bw[e] * inv);
#pragma unroll
            for (int q = 0; q < 4; ++q) { fc[q * 8192 + q + 4096 - lag] = fv;
                const int ib = q + 4096 + lag; if (lag >= 1 && ib < 8192) fc[q * 8192 + ib] = bv; } }
        if (tid < 4) { for (int i = 0; i <= tid; ++i) fc[tid * 8192 + i] = (bf16_t)0; }
        __syncthreads();
        {
            const int t0 = wid, q = t0 & 3, a = t0 >> 2, rho = lane & 31, h = lane >> 5, col = lane & 31, b = col >> 2, i = col & 3;
            f32x16 acc[4];
#pragma unroll
            for (int ct = 0; ct < 4; ++ct)
#pragma unroll
                for (int e = 0; e < 16; ++e) acc[ct][e] = 0.f;
            const LAS unsigned char* fq_ = lds + HY_FC + q * 16384;
            const LAS unsigned char* vi = lds + HY_VI + b * HY_VRS;
            const int ebase = 4096 - 8 * (rho - h) - 4 * a;
            const int sb0 = 256 * i + 8 * h;
#define HY_LDA(dl_) __builtin_shufflevector(*(const LAS bf16x4*)(fq_ + 2 * (ebase - (dl_))), *(const LAS bf16x4*)(fq_ + 2 * (ebase - (dl_)) + 8), 0, 1, 2, 3, 4, 5, 6, 7)
#define HY_LDB(dst, dl_, ct) do { const int s_ = 1024 * (ct) + sb0 - (dl_); const bool ok_ = (unsigned)s_ < 4096u; \
                dst = *(const LAS bf16x8*)(ok_ ? vi + s_ * 2 + 16 * (s_ >> 8) : zchunk); } while (0)
#define HY_VALID(dl_, ct) ((dl_) >= 1024 * (ct) - 4080 && (dl_) <= 1024 * (ct) + 768)
#define HY_LOADS(AF, BF, dl_, MASK) do { AF = HY_LDA(dl_); _Pragma("unroll") for (int ct = 0; ct < 4; ++ct) if ((MASK >> ct) & 1) HY_LDB(BF[ct], dl_, ct); } while (0)
#define HY_MMAS(AF, BF, MASK) do { _Pragma("unroll") for (int ct = 0; ct < 4; ++ct) if ((MASK >> ct) & 1) acc[ct] = __builtin_amdgcn_mfma_f32_32x32x16_bf16(AF, BF[ct], acc[ct], 0, 0, 0); } while (0)
#define HY_SEGMENT(LO, HI, MASK) do { HY_LOADS(a0, b0, LO, MASK); HY_LOADS(a1, b1, (LO) + 16, MASK); _Pragma("unroll 1") for (int dl = (LO); dl <= (HI); dl += 64) { \
                HY_LOADS(a2, b2, dl + 32, MASK); HY_LOADS(a3, b3, dl + 48, MASK); HY_MMAS(a0, b0, MASK); HY_MMAS(a1, b1, MASK); \
                if (dl + 64 <= (HI)) { HY_LOADS(a0, b0, dl + 64, MASK); HY_LOADS(a1, b1, dl + 80, MASK); } HY_MMAS(a2, b2, MASK); HY_MMAS(a3, b3, MASK); } } while (0)
            const LAS unsigned char* zchunk = lds + HY_VI + 8 * HY_VRS;
            bf16x8 a0, a1, a2, a3, b0[4], b1[4], b2[4], b3[4];
#pragma unroll
            for (int ct = 0; ct < 4; ++ct) { b0[ct] = (bf16x8){0, 0, 0, 0, 0, 0, 0, 0}; b1[ct] = b0[ct]; b2[ct] = b0[ct]; b3[ct] = b0[ct]; }
            HY_SEGMENT(-4080, -3072, 1); HY_SEGMENT(-3056, -2048, 3); HY_SEGMENT(-2032, -1024, 7); HY_SEGMENT(-1008, 768, 15);
            HY_SEGMENT(784, 1792, 14); HY_SEGMENT(1808, 2816, 12); HY_SEGMENT(2832, 3840, 8);
#undef HY_LOADS
#undef HY_MMAS
#undef HY_SEGMENT
#undef HY_LDA
#undef HY_LDB
#undef HY_VALID
            __syncthreads();
            float* Y = (float*)smem;
#pragma unroll
            for (int ct = 0; ct < 4; ++ct)
#pragma unroll
                for (int r = 0; r < 16; ++r) { const int rr = (r & 3) + 8 * (r >> 2) + 4 * h; const int t = 1024 * ct + 256 * i + t0 + 8 * rr;
                    Y[b * HY_YRS + t + (t >> 8)] = acc[ct][r]; }
        }
        __syncthreads();
        {
            const float* Y = (const float*)smem; bf16_t* dst = (bf16_t*)(ws + WS_CVT) + (size_t)c * 4096; const int tid2 = otid();
#pragma unroll 2
            for (int q = 0; q < 8; ++q) { const int ch = tid2 + q * NTH, b = ch >> 9, t = (ch & 511) * 8; const float* yp = Y + b * HY_YRS + t + (t >> 8);
                u32x4 ov; ov[0] = cvt_pk_bf16(yp[0], yp[1]); ov[1] = cvt_pk_bf16(yp[2], yp[3]); ov[2] = cvt_pk_bf16(yp[4], yp[5]); ov[3] = cvt_pk_bf16(yp[6], yp[7]);
                *(u32x4*)(dst + (size_t)b * 256 * 4096 + t) = ov; }
        }
        __syncthreads();
        {
            float* fl = (float*)smem;
            float* vc = fl + 520;
            const float* KT1 = KT + (size_t)512 * 4096; const float* KP1 = KPART + (size_t)64 * 512;
            if (tid < 64) { float s = tid < 4 ? KP1[(size_t)tid * 512 + c] + KP1[(size_t)tid * 512 + 256 + c] : 0.f; s = wave_sum(s); if (tid == 0) red[0] = 1.f / s; }
            { const int lag = tid - 256; float v; if (lag <= -256) v = 0.f; else if (lag >= 0) v = KT1[(size_t)c * 4096 + lag]; else v = KT1[(size_t)(256 + c) * 4096 - lag]; fl[tid + 3] = v; }
            if (tid < 3) { fl[tid] = 0.f; fl[515 + tid] = 0.f; }
            for (int e = tid; e < 2048; e += NTH) { const int b = e >> 8, s = e & 255; vc[e + 8] = bf2f(((const bf16_t*)(ws + WS_VVTC))[((size_t)b * 256 + c) * 256 + s]); }
            __syncthreads();
            const float inv1 = red[0];
            const int b = tid >> 6, tl = tid & 63; float o[4] = {0.f, 0.f, 0.f, 0.f};
#pragma unroll 4
            for (int s4 = 0; s4 < 64; ++s4) {
                const f32x4 vv = *(const f32x4*)(vc + 8 + b * 256 + 4 * s4);
                const f32x4 t0 = *(const f32x4*)(fl + 4 * (tl - s4) + 256), t1 = *(const f32x4*)(fl + 4 * (tl - s4) + 260);
                const float tp[8] = {t0[0], t0[1], t0[2], t0[3], t1[0], t1[1], t1[2], t1[3]};
#pragma unroll
                for (int j = 0; j < 4; ++j)
#pragma unroll
                    for (int k = 0; k < 4; ++k) o[j] += tp[j - k + 3] * vv[k]; }
            *(f32x4*)((float*)(ws + WS_CVTC) + ((size_t)b * 256 + c) * 256 + 4 * tl) = (f32x4){o[0] * inv1, o[1] * inv1, o[2] * inv1, o[3] * inv1};
        }
    }
    __syncthreads();
}

__device__ __forceinline__ void hyena_finish(CParams& P, unsigned char* smem, int l) {
    const int G = gridDim.x, tid = otid(), bid = obid();
    unsigned char* ws = P.ws;
    const bf16_t* PJ = (const bf16_t*)(ws + WS_PJ); bf16_t* YC = (bf16_t*)(ws + WS_YC);
    float* cvL = (float*)smem;
    const int c4 = tid & 63, tq = tid >> 6;
    const float* cw = P.in[I_HCW] + (size_t)l * 3 * 768; const float* cb = P.in[I_HCB] + (size_t)l * 768;
    float w1[3][4], wx[3][4], wv[3][4], b1[4], bx[4], bv[4], hb[4];
#pragma unroll
    for (int e = 0; e < 4; ++e) { b1[e] = cb[4 * c4 + e]; bx[e] = cb[256 + 4 * c4 + e]; bv[e] = cb[512 + 4 * c4 + e]; hb[e] = P.in[I_HBIAS][l * 256 + 4 * c4 + e];
#pragma unroll
        for (int k = 0; k < 3; ++k) { w1[k][e] = cw[k * 768 + 4 * c4 + e]; wx[k][e] = cw[k * 768 + 256 + 4 * c4 + e]; wv[k][e] = cw[k * 768 + 512 + 4 * c4 + e]; } }
    for (int tt = bid; tt < T / 64; tt += G) {
        const TileGeo g = tile_geo(tt);
        __syncthreads();
        if (g.isctx) { const float* src = (const float*)(ws + WS_CVTC) + (size_t)g.b * 256 * 256 + g.pos0;
#pragma unroll
          for (int q = 0; q < 8; ++q) { const int ch = tid + q * NTH, c = ch >> 4, j = (ch & 15) * 4; const f32x4 v = *(const f32x4*)(src + (size_t)c * 256 + j);
              float* d = cvL + c * 68 + j; d[0] = v[0]; d[1] = v[1]; d[2] = v[2]; d[3] = v[3]; } }
        else { const bf16_t* src = (const bf16_t*)(ws + WS_CVT) + (size_t)g.b * 256 * 4096 + g.pos0;
          u32x4 v[4];
#pragma unroll
          for (int q = 0; q < 4; ++q) { const int ch = tid + q * NTH, c = ch >> 3, j = (ch & 7) * 8; v[q] = *(const u32x4*)(src + (size_t)c * 4096 + j); }
#pragma unroll
          for (int q = 0; q < 4; ++q) { const int ch = tid + q * NTH, c = ch >> 3, j = (ch & 7) * 8; float f[8]; unpack8(v[q], f);
              float* d = cvL + c * 68 + j;
#pragma unroll
              for (int e = 0; e < 8; ++e) d[e] = f[e]; } }
        __syncthreads();
        const int p0 = g.pos0 + tq * 8;
        const bf16_t* rowp = PJ + (size_t)(g.tok0 + tq * 8) * PJW;
        float r1[3][4], rx[3][4], rv[3][4];
#define LD_FROW(k, dp) do { const int pp = p0 + (dp); const bool ok_ = (pp >= 0 && pp < g.slen); const bf16_t* rp = rowp + (ptrdiff_t)(ok_ ? (dp) : 0) * PJW; \
            unpack4(*(const u32x2*)(rp + 4 * c4), r1[k]); unpack4(*(const u32x2*)(rp + 256 + 4 * c4), rx[k]); unpack4(*(const u32x2*)(rp + 512 + 4 * c4), rv[k]); \
            _Pragma("unroll") for (int e = 0; e < 4; ++e) { r1[k][e] = ok_ ? r1[k][e] : 0.f; rx[k][e] = ok_ ? rx[k][e] : 0.f; rv[k][e] = ok_ ? rv[k][e] : 0.f; } } while (0)
        LD_FROW(0, -1); LD_FROW(1, 0);
#pragma unroll
        for (int j = 0; j < 8; ++j) {
            LD_FROW(2, j + 1);
            float o[4];
#pragma unroll
            for (int e = 0; e < 4; ++e) {
                const float x1 = w1[0][e] * r1[0][e] + w1[1][e] * r1[1][e] + w1[2][e] * r1[2][e] + b1[e];
                const float x2 = wx[0][e] * rx[0][e] + wx[1][e] * rx[1][e] + wx[2][e] * rx[2][e] + bx[e];
                const float vv = wv[0][e] * rv[0][e] + wv[1][e] * rv[1][e] + wv[2][e] * rv[2][e] + bv[e];
                const float xv = x2 * vv;
                o[e] = x1 * (cvL[(4 * c4 + e) * 68 + tq * 8 + j] + xv * hb[e]);
                r1[0][e] = r1[1][e]; r1[1][e] = r1[2][e]; rx[0][e] = rx[1][e]; rx[1][e] = rx[2][e]; rv[0][e] = rv[1][e]; rv[1][e] = rv[2][e]; }
            u32x2 ov; ov[0] = cvt_pk_bf16(o[0], o[1]); ov[1] = cvt_pk_bf16(o[2], o[3]);
            *(u32x2*)(YC + (size_t)(g.tok0 + tq * 8 + j) * YCW + 512 + 4 * c4) = ov;
        }
#undef LD_FROW
    }
    __syncthreads();
}

constexpr int SS_LD = 136;
__device__ __forceinline__ int ssd_tokbase(int b, int cc) { return cc < 2 ? TL + b * 256 + cc * 128 : b * 4096 + (cc - 2) * 128; }
__device__ __forceinline__ const bf16_t* ssd_trow(const unsigned char* ws, int b, int cc, int row) {
    return cc < 2 ? (const bf16_t*)(ws + WS_XSTC) + ((size_t)b * 768 + row) * 256 + cc * 128 : (const bf16_t*)(ws + WS_XST) + ((size_t)b * 768 + row) * 4096 + (cc - 2) * 128;
}
__device__ __forceinline__ void ssd_dt_arrays(CParams& P, float* sm, int l, int b, int g, int cc, int un) {
    const int tid = otid(), lane = tid & 63, w = __builtin_amdgcn_readfirstlane(tid >> 6), dir = w >> 2, r = w & 3, c = dir * 8 + g * 4 + r;
    const float* DT = (const float*)(P.ws + WS_DT); const int tb = ssd_tokbase(b, cc);
    const float d0 = DT[(size_t)(tb + 2 * lane) * 16 + c], d1 = DT[(size_t)(tb + 2 * lane + 1) * 16 + c];
    const float a = -expf(P.in[I_SALOG][l * 16 + c]);
    const float v0 = d0 * a, v1 = d1 * a, p = v0 + v1;
    float inc = p;
#pragma unroll
    for (int d = 1; d < 64; d <<= 1) { const float y = __int_as_float(__builtin_amdgcn_ds_bpermute((lane - d) * 4, __float_as_int(inc))); inc += (lane >= d) ? y : 0.f; }
    const float E = inc - p, tot = __int_as_float(__builtin_amdgcn_readlane(__float_as_int(inc), 63));
    const float s0 = dir ? tot - E : E + v0, s1 = dir ? tot - E - v0 : inc;
    const int o = dir * 512 + (2 * lane) * 4 + r;
    sm[o] = d0; sm[o + 4] = d1; sm[1024 + o] = s0; sm[1024 + o + 4] = s1;
    float* ag = (float*)(P.ws + WS_ACSG) + (size_t)un * 1024; ag[o] = s0; ag[o + 4] = s1;
    { const float sref = dir ? s0 : s1;
      const float ref = __int_as_float(__builtin_amdgcn_ds_bpermute((dir ? (lane & ~7) : (lane | 7)) * 4, __float_as_int(sref)));
      f32x2 wl; wl[0] = d0 * __expf(ref - s0); wl[1] = d1 * __expf(ref - s1); *(f32x2*)(sm + 3072 + dir * 512 + r * 128 + 2 * lane) = wl; }
    { f32x2 wv; wv[0] = d0 * __expf(tot - s0); wv[1] = d1 * __expf(tot - s1); *(f32x2*)(sm + 2048 + dir * 512 + r * 128 + 2 * lane) = wv; }
}
#define SS_FRAG(base, row, k0) (*(const LAS bf16x8*)((base) + ((row) * SS_LD + (k0) + 8 * fq) * 2))

__device__ __forceinline__ void ssd_a_unit(CParams& P, unsigned char* smem, LAS unsigned char* lds, int l, int un) {
    const int tid = otid(), lane = tid & 63, w = __builtin_amdgcn_readfirstlane(tid >> 6), fr = lane & 15, fq = lane >> 4;
    unsigned char* ws = P.ws;
    constexpr int R0 = 0, R1 = 34816, R2 = 69632, R3 = 104448, RS = 121856;
    float* sm = (float*)(smem + RS); float* dtf = sm; float* dtb = sm + 512; float* acf = sm + 1024; float* acb = sm + 1536;
    const bf16_t* XBN = (const bf16_t*)(ws + WS_XBN);
    const int b = un / (2 * NCH), g = (un / NCH) & 1, cc = un % NCH, tb = ssd_tokbase(b, cc);
    __syncthreads();
    u32x4 cv[4], bv[4], tv[4], xv[2];
#pragma unroll
    for (int q = 0; q < 4; ++q) { const int ch = tid + q * NTH, row = ch >> 4, k8 = (ch & 15) * 8;
        cv[q] = *(const u32x4*)(XBN + (size_t)(tb + row) * 1024 + 768 + g * 128 + k8); bv[q] = *(const u32x4*)(XBN + (size_t)(tb + row) * 1024 + 512 + g * 128 + k8);
        tv[q] = *(const u32x4*)(ssd_trow(ws, b, cc, 512 + g * 128 + row) + k8); }
#pragma unroll
    for (int q = 0; q < 2; ++q) { const int ch = tid + q * NTH, row = ch >> 4, k8 = (ch & 15) * 8; xv[q] = *(const u32x4*)(ssd_trow(ws, b, cc, g * 256 + row) + k8); }
    ssd_dt_arrays(P, sm, l, b, g, cc, un);
#pragma unroll
    for (int q = 0; q < 4; ++q) { const int ch = tid + q * NTH, row = ch >> 4, k8 = (ch & 15) * 8;
        *(u32x4*)(smem + R0 + (row * SS_LD + k8) * 2) = cv[q]; *(u32x4*)(smem + R1 + (row * SS_LD + k8) * 2) = bv[q]; *(u32x4*)(smem + R2 + (row * SS_LD + k8) * 2) = tv[q]; }
    __syncthreads();
    f32x4 S[8];
#pragma unroll
    for (int nt = 0; nt < 8; ++nt) S[nt] = (f32x4){0.f, 0.f, 0.f, 0.f};
#pragma unroll
    for (int k0 = 0; k0 < 128; k0 += 32) { const bf16x8 af = SS_FRAG(lds + R0, 16 * w + fr, k0);
#pragma unroll
        for (int nt = 0; nt < 8; ++nt) S[nt] = __builtin_amdgcn_mfma_f32_16x16x32_bf16(SS_FRAG(lds + R1, 16 * nt + fr, k0), af, S[nt], 0, 0, 0); }
#pragma unroll 1
    for (int r = 0; r < 4; ++r) {
        __syncthreads();
#pragma unroll
        for (int q = 0; q < 2; ++q) { const int ch = tid + q * NTH, row = ch >> 4, k8 = (ch & 15) * 8; *(u32x4*)(smem + R3 + (row * SS_LD + k8) * 2) = xv[q]; }
        if (r < 3) {
#pragma unroll
            for (int q = 0; q < 2; ++q) { const int ch = tid + q * NTH, row = ch >> 4, k8 = (ch & 15) * 8; xv[q] = *(const u32x4*)(ssd_trow(ws, b, cc, g * 256 + (r + 1) * 64 + row) + k8); } }
        { const int i = 16 * w + fr; const float afi = acf[i * 4 + r], abi = acb[i * 4 + r], dfi = dtf[i * 4 + r];
#pragma unroll
          for (int nt = 0; nt < 8; ++nt) { float o[4];
              if (nt == w) {
#pragma unroll
                  for (int e = 0; e < 4; ++e) { const int j = 16 * nt + 4 * fq + e;
                      const bool fw = j < i; const float* ap = fw ? acf : acb; const float* dp = fw ? dtf : dtb;
                      float wgt = __expf((fw ? afi : abi) - ap[j * 4 + r]) * dp[j * 4 + r];
                      wgt += (j == i) ? dfi : 0.f;
                      o[e] = S[nt][e] * wgt; }
              } else {
                  const bool fw = nt < w;
                  const float E = __expf(fw ? afi - acf[(16 * nt + 15) * 4 + r] : abi - acb[(16 * nt) * 4 + r]);
                  const f32x4 wv = *(const f32x4*)(sm + 3072 + (fw ? 0 : 512) + r * 128 + 16 * nt + 4 * fq);
#pragma unroll
                  for (int e = 0; e < 4; ++e) o[e] = S[nt][e] * (E * wv[e]);
              }
              u32x2 ov; ov[0] = cvt_pk_bf16(o[0], o[1]); ov[1] = cvt_pk_bf16(o[2], o[3]);
              *(u32x2*)(smem + R0 + (i * SS_LD + 16 * nt + 4 * fq) * 2) = ov; } }
        __syncthreads();
        { const int p = tid >> 3, j0 = (tid & 7) * 16; const float* wf = sm + 2048 + r * 128 + j0; const float* wb = wf + 512;
#pragma unroll
          for (int h2 = 0; h2 < 2; ++h2) { float v[8]; unpack8(*(const u32x4*)(smem + R3 + (p * SS_LD + j0 + 8 * h2) * 2), v); u32x4 of, ob; float vf[8], vb[8];
              const f32x4 f0 = *(const f32x4*)(wf + 8 * h2), f1 = *(const f32x4*)(wf + 8 * h2 + 4), b0 = *(const f32x4*)(wb + 8 * h2), b1 = *(const f32x4*)(wb + 8 * h2 + 4);
#pragma unroll
              for (int e = 0; e < 4; ++e) { vf[e] = v[e] * f0[e]; vf[e + 4] = v[e + 4] * f1[e]; vb[e] = v[e] * b0[e]; vb[e + 4] = v[e + 4] * b1[e]; }
#pragma unroll
              for (int e = 0; e < 4; ++e) { of[e] = cvt_pk_bf16(vf[2 * e], vf[2 * e + 1]); ob[e] = cvt_pk_bf16(vb[2 * e], vb[2 * e + 1]); }
              *(u32x4*)(smem + R1 + (p * SS_LD + j0 + 8 * h2) * 2) = of; *(u32x4*)(smem + R1 + 17408 + (p * SS_LD + j0 + 8 * h2) * 2) = ob; } }
        { f32x4 yd[4];
#pragma unroll
          for (int nt = 0; nt < 4; ++nt) yd[nt] = (f32x4){0.f, 0.f, 0.f, 0.f};
#pragma unroll
          for (int k0 = 0; k0 < 128; k0 += 32) { const bf16x8 af = SS_FRAG(lds + R0, 16 * w + fr, k0);
#pragma unroll
              for (int nt = 0; nt < 4; ++nt) yd[nt] = __builtin_amdgcn_mfma_f32_16x16x32_bf16(SS_FRAG(lds + R3, 16 * nt + fr, k0), af, yd[nt], 0, 0, 0); }
          bf16_t* yp = (bf16_t*)(ws + WS_YD) + (size_t)(tb + 16 * w + fr) * 512 + g * 256 + r * 64 + 4 * fq;
#pragma unroll
          for (int nt = 0; nt < 4; ++nt) { u32x2 ov; ov[0] = cvt_pk_bf16(yd[nt][0], yd[nt][1]); ov[1] = cvt_pk_bf16(yd[nt][2], yd[nt][3]); *(u32x2*)(yp + 16 * nt) = ov; } }
        __syncthreads();
#pragma unroll
        for (int dir = 0; dir < 2; ++dir) {
            const int pt = w & 3, nt0 = (w >> 2) * 4;
            f32x4 st[4];
#pragma unroll
            for (int q = 0; q < 4; ++q) st[q] = (f32x4){0.f, 0.f, 0.f, 0.f};
#pragma unroll
            for (int k0 = 0; k0 < 128; k0 += 32) { const bf16x8 af = SS_FRAG(lds + R1 + dir * 17408, 16 * pt + fr, k0);
#pragma unroll
                for (int q = 0; q < 4; ++q) st[q] = __builtin_amdgcn_mfma_f32_16x16x32_bf16(SS_FRAG(lds + R2, 16 * (nt0 + q) + fr, k0), af, st[q], 0, 0, 0); }
            bf16_t* sp = (bf16_t*)(ws + WS_ST) + ((((size_t)(b * 2 + g) * 4 + r) * 2 + dir) * NCH + cc) * 8192 + (16 * pt + fr) * 128 + 4 * fq;
#pragma unroll
            for (int q = 0; q < 4; ++q) { u32x2 ov; ov[0] = cvt_pk_bf16(st[q][0], st[q][1]); ov[1] = cvt_pk_bf16(st[q][2], st[q][3]); *(u32x2*)(sp + 16 * (nt0 + q)) = ov; }
        }
    }
    if (tid < 8) { const int dir = tid >> 2, r = tid & 3; ((float*)(ws + WS_ACT))[(((size_t)(b * 2 + g) * 4 + r) * 2 + dir) * NCH + cc] = dir ? acb[r] : acf[127 * 4 + r]; }
    __syncthreads();
}

__device__ __forceinline__ void ssd_phase_b(CParams& P) {
    unsigned char* ws = P.ws;
    const bf16_t* ST = (const bf16_t*)(ws + WS_ST); const float* ACTS = (const float*)(ws + WS_ACT); bf16_t* HENT = (bf16_t*)(ws + WS_HENT);
    for (int it = obid() * NTH + otid(); it < NB * 2 * 4 * 2 * 2048; it += gridDim.x * NTH) {
        const int hd = it >> 11, e4 = (it & 2047) * 4, dir = hd & 1;
        f32x4 h = (f32x4){0.f, 0.f, 0.f, 0.f};
#pragma unroll
        for (int hf = 0; hf < 2; ++hf) {
            u32x2 sv[17]; float dv[17];
#pragma unroll
            for (int s = 0; s < 17; ++s) { const int st = hf * 17 + s; const int cc = dir == 0 ? st : (st < 2 ? 1 - st : NCH + 1 - st);
                sv[s] = *(const u32x2*)(ST + ((size_t)hd * NCH + cc) * 8192 + e4); dv[s] = ACTS[(size_t)hd * NCH + cc]; }
#pragma unroll
            for (int s = 0; s < 17; ++s) { const int st = hf * 17 + s; const int cc = dir == 0 ? st : (st < 2 ? 1 - st : NCH + 1 - st);
                u32x2 ov; ov[0] = cvt_pk_bf16(h[0], h[1]); ov[1] = cvt_pk_bf16(h[2], h[3]); *(u32x2*)(HENT + ((size_t)hd * NCH + cc) * 8192 + e4) = ov;
                h = h * __expf(dv[s]) + (f32x4){bflo(sv[s][0]), bfhi(sv[s][0]), bflo(sv[s][1]), bfhi(sv[s][1])}; }
        }
    }
}

__device__ __forceinline__ void ssd_phase_c(CParams& P, unsigned char* smem, LAS unsigned char* lds, int l) {
    const int G = gridDim.x, tid = otid(), bid = obid(), lane = tid & 63, w = __builtin_amdgcn_readfirstlane(tid >> 6), fr = lane & 15, fq = lane >> 4;
    unsigned char* ws = P.ws;
    constexpr int R0 = 0, R1 = 34816, R2 = 52224, RS = 69632;
    float* sm = (float*)(smem + RS); float* acf = sm + 1024; float* acb = sm + 1536;
    const bf16_t* XBN = (const bf16_t*)(ws + WS_XBN); const bf16_t* PJ = (const bf16_t*)(ws + WS_PJ); const bf16_t* HENT = (const bf16_t*)(ws + WS_HENT);
    bf16_t* YC = (bf16_t*)(ws + WS_YC); const bf16_t* YD = (const bf16_t*)(ws + WS_YD); float* SSQ = (float*)(ws + WS_SSQ); const float* DT = (const float*)(ws + WS_DT);
    constexpr int NIT = NB * 2 * NCH * 4;
    const int it0 = (int)((unsigned)(bid * NIT) / (unsigned)G), it1 = (int)((unsigned)((bid + 1) * NIT) / (unsigned)G);
    const int i = 16 * w + fr;
    u32x4 hv[4], cvn[4]; u32x2 ydn[4], xrn[4], zrn[4]; float acn[2];
#define SC_REQ(itx, newunit) do { const int un_ = (itx) >> 2, r_ = (itx) & 3, b_ = un_ / (2 * NCH), g_ = (un_ / NCH) & 1, cc_ = un_ % NCH, tb_ = ssd_tokbase(b_, cc_); \
        const size_t tok_ = (size_t)tb_ + i; const int hc_ = g_ * 256 + r_ * 64 + 4 * fq; \
        _Pragma("unroll") for (int q = 0; q < 4; ++q) { const int ch = tid + q * NTH, dir = ch >> 10, hrow = (ch >> 4) & 63, k8 = (ch & 15) * 8; \
            hv[q] = *(const u32x4*)(HENT + ((((size_t)(b_ * 2 + g_) * 4 + r_) * 2 + dir) * NCH + cc_) * 8192 + hrow * 128 + k8); } \
        _Pragma("unroll") for (int nt = 0; nt < 4; ++nt) { ydn[nt] = *(const u32x2*)(YD + tok_ * 512 + hc_ + 16 * nt); xrn[nt] = *(const u32x2*)(XBN + tok_ * 1024 + hc_ + 16 * nt); zrn[nt] = *(const u32x2*)(PJ + tok_ * PJW + 1024 + hc_ + 16 * nt); } \
        if (newunit) { \
            _Pragma("unroll") for (int q = 0; q < 4; ++q) { const int ch = tid + q * NTH, row = ch >> 4, k8 = (ch & 15) * 8; cvn[q] = *(const u32x4*)(XBN + (size_t)(tb_ + row) * 1024 + 768 + g_ * 128 + k8); } \
            _Pragma("unroll") for (int q = 0; q < 2; ++q) acn[q] = ((const float*)(ws + WS_ACSG))[(size_t)un_ * 1024 + tid + q * NTH]; } \
        } while (0)
    if (it0 < it1) SC_REQ(it0, true);
    int cur_un = -1;
#pragma unroll 1
    for (int it = it0; it < it1; ++it) {
        const int un = it >> 2, r = it & 3, b = un / (2 * NCH), g = (un / NCH) & 1, cc = un % NCH, tb = ssd_tokbase(b, cc);
        const size_t tok = (size_t)tb + i; const int hc = g * 256 + r * 64 + 4 * fq;
        __syncthreads();
        if (un != cur_un) {
            cur_un = un;
#pragma unroll
            for (int q = 0; q < 2; ++q) sm[1024 + tid + q * NTH] = acn[q];
#pragma unroll
            for (int q = 0; q < 4; ++q) { const int ch = tid + q * NTH, row = ch >> 4, k8 = (ch & 15) * 8; *(u32x4*)(smem + R0 + (row * SS_LD + k8) * 2) = cvn[q]; }
        }
#pragma unroll
        for (int q = 0; q < 4; ++q) { const int ch = tid + q * NTH, dir = ch >> 10, hrow = (ch >> 4) & 63, k8 = (ch & 15) * 8; *(u32x4*)(smem + (dir ? R2 : R1) + (hrow * SS_LD + k8) * 2) = hv[q]; }
        u32x2 ydv[4], xr[4], zr[4];
#pragma unroll
        for (int nt = 0; nt < 4; ++nt) { ydv[nt] = ydn[nt]; xr[nt] = xrn[nt]; zr[nt] = zrn[nt]; }
        if (it + 1 < it1) { const bool nu_ = ((it + 1) >> 2) != un; SC_REQ(it + 1, nu_); }
        __syncthreads();
        f32x4 yf[4], yb[4];
#pragma unroll
        for (int nt = 0; nt < 4; ++nt) { yf[nt] = (f32x4){0.f, 0.f, 0.f, 0.f}; yb[nt] = (f32x4){0.f, 0.f, 0.f, 0.f}; }
#pragma unroll
        for (int k0 = 0; k0 < 128; k0 += 32) { const bf16x8 af = SS_FRAG(lds + R0, 16 * w + fr, k0);
#pragma unroll
            for (int nt = 0; nt < 4; ++nt) { yf[nt] = __builtin_amdgcn_mfma_f32_16x16x32_bf16(SS_FRAG(lds + R1, 16 * nt + fr, k0), af, yf[nt], 0, 0, 0);
                                             yb[nt] = __builtin_amdgcn_mfma_f32_16x16x32_bf16(SS_FRAG(lds + R2, 16 * nt + fr, k0), af, yb[nt], 0, 0, 0); } }
        const float ef = __expf(acf[i * 4 + r]), eb = __expf(acb[i * 4 + r]), dsk = P.in[I_SD][l * 8 + g * 4 + r];
        float ssq = 0.f;
#pragma unroll
        for (int nt = 0; nt < 4; ++nt) {
            float xv[4], zv[4], yv[4]; unpack4(xr[nt], xv); unpack4(zr[nt], zv); unpack4(ydv[nt], yv);
            float o[4];
#pragma unroll
            for (int e = 0; e < 4; ++e) { o[e] = (yv[e] + ef * yf[nt][e] + eb * yb[nt][e] + xv[e] * dsk) * fsilu(zv[e]); ssq += o[e] * o[e]; }
            u32x2 ov; ov[0] = cvt_pk_bf16(o[0], o[1]); ov[1] = cvt_pk_bf16(o[2], o[3]);
            *(u32x2*)(YC + tok * YCW + 1024 + hc + 16 * nt) = ov; }
        ssq += swz_xor<16>(ssq); ssq = xor32_sum(ssq);
        if (fq == 0) SSQ[tok * 8 + g * 4 + r] = ssq;
    }
#undef SC_REQ
    __syncthreads();
}

__device__ __forceinline__ void p7a_route(CParams& P, unsigned char* smem, LAS unsigned char* lds, int l, const int TT) {
    const int G = gridDim.x, tid = otid(), bid = obid(), lane = tid & 63, w = __builtin_amdgcn_readfirstlane(tid >> 6), fr = lane & 15, fq = lane >> 4;
    unsigned char* ws = P.ws;
    constexpr int HLD = 1032, OFF_HI = 0, OFF_LO = 16 * HLD * 2, OFF_PART = 2 * 16 * HLD * 2, OFF_LG = OFF_PART + 8 * 16 * 32 * 4, OFF_HIST = OFF_LG + 16 * 32 * 4;
    float* part = (float*)(smem + OFF_PART); float* lg = (float*)(smem + OFF_LG); int* hist = (int*)(smem + OFF_HIST);
    const bf16_t* X1 = (const bf16_t*)(ws + WS_X1); bf16_t* H2 = (bf16_t*)(ws + WS_H2);
    const float* MODL = (const float*)(ws + WS_MOD) + (size_t)l * 9 * 6144;
    const float* nf = P.in[I_NFFN] + (size_t)l * 1024;
    bf16x8 wh[2][4], wl[2][4];
    { const bf16_t* wr = (const bf16_t*)(ws + WS_WRT) + (size_t)l * 2 * 32 * 1024;
#pragma unroll
      for (int nt = 0; nt < 2; ++nt)
#pragma unroll
          for (int ks = 0; ks < 4; ++ks) { const size_t o = (size_t)(16 * nt + fr) * 1024 + 128 * w + 32 * ks + 8 * fq;
              wh[nt][ks] = *(const bf16x8*)(wr + o); wl[nt][ks] = *(const bf16x8*)(wr + 32 * 1024 + o); } }
    if (tid < 32) hist[tid] = 0;
    f32x4 gn[4];
#pragma unroll
    for (int q = 0; q < 4; ++q) gn[q] = *(const f32x4*)(nf + q * 256 + lane * 4);
    const int nit = (TT / 16 + G - 1) / G;
    f32x4 v[2][4];
    { const int t0 = bid * 16;
#pragma unroll
      for (int j = 0; j < 2; ++j)
#pragma unroll
          for (int q = 0; q < 4; ++q) { float t_[4] = {0.f, 0.f, 0.f, 0.f}; if (t0 < TT) unpack4(*(const u32x2*)(X1 + (size_t)(t0 + 2 * w + j) * 1024 + q * 256 + lane * 4), t_); v[j][q] = (f32x4){t_[0], t_[1], t_[2], t_[3]}; } }
    for (int it = 0; it < nit; ++it) {
        const int t0 = (it * G + bid) * 16;
        __syncthreads();
        if (t0 < TT) {
            f32x4 av[4], bv[4];
            { const float* md = MODL + (size_t)tok_modj(t0) * 6144;
#pragma unroll
              for (int q = 0; q < 4; ++q) { av[q] = *(const f32x4*)(md + 4096 + q * 256 + lane * 4); bv[q] = *(const f32x4*)(md + 3072 + q * 256 + lane * 4); } }
#pragma unroll
            for (int j = 0; j < 2; ++j) {
                const int t = t0 + 2 * w + j;
                float ss = 0.f;
#pragma unroll
                for (int q = 0; q < 4; ++q) ss += v[j][q][0] * v[j][q][0] + v[j][q][1] * v[j][q][1] + v[j][q][2] * v[j][q][2] + v[j][q][3] * v[j][q][3];
                ss = wave_sum(ss); const float rs = rsqrtf(ss * (1.f / 1024.f) + EPSN);
#pragma unroll
                for (int q = 0; q < 4; ++q) { const int c = q * 256 + lane * 4;
                    const f32x4 g = gn[q], a = av[q], b = bv[q];
                    float o[4], lo[4];
#pragma unroll
                    for (int e = 0; e < 4; ++e) o[e] = v[j][q][e] * rs * g[e] * (1.f + a[e]) + b[e];
                    u32x2 ov; ov[0] = cvt_pk_bf16(o[0], o[1]); ov[1] = cvt_pk_bf16(o[2], o[3]);
                    *(u32x2*)(H2 + (size_t)t * 1024 + c) = ov;
                    lo[0] = o[0] - bflo(ov[0]); lo[1] = o[1] - bfhi(ov[0]); lo[2] = o[2] - bflo(ov[1]); lo[3] = o[3] - bfhi(ov[1]);
                    u32x2 lv; lv[0] = cvt_pk_bf16(lo[0], lo[1]); lv[1] = cvt_pk_bf16(lo[2], lo[3]);
                    *(u32x2*)(smem + OFF_HI + ((2 * w + j) * HLD + c) * 2) = ov; *(u32x2*)(smem + OFF_LO + ((2 * w + j) * HLD + c) * 2) = lv; }
            }
        }
        { const int tn = ((it + 1) * G + bid) * 16;
          if (it + 1 < nit && tn < TT) {
#pragma unroll
              for (int j = 0; j < 2; ++j)
#pragma unroll
                  for (int q = 0; q < 4; ++q) { float t_[4]; unpack4(*(const u32x2*)(X1 + (size_t)(tn + 2 * w + j) * 1024 + q * 256 + lane * 4), t_); v[j][q] = (f32x4){t_[0], t_[1], t_[2], t_[3]}; } } }
        __syncthreads();
        if (t0 < TT) {
            f32x4 acc[2] = {(f32x4){0.f, 0.f, 0.f, 0.f}, (f32x4){0.f, 0.f, 0.f, 0.f}};
#pragma unroll
            for (int ks = 0; ks < 4; ++ks) {
                const bf16x8 ah = *(const LAS bf16x8*)(lds + OFF_HI + (fr * HLD + 128 * w + 32 * ks + 8 * fq) * 2), al = *(const LAS bf16x8*)(lds + OFF_LO + (fr * HLD + 128 * w + 32 * ks + 8 * fq) * 2);
#pragma unroll
                for (int nt = 0; nt < 2; ++nt) { acc[nt] = __builtin_amdgcn_mfma_f32_16x16x32_bf16(wh[nt][ks], ah, acc[nt], 0, 0, 0);
                    acc[nt] = __builtin_amdgcn_mfma_f32_16x16x32_bf16(wl[nt][ks], ah, acc[nt], 0, 0, 0); acc[nt] = __builtin_amdgcn_mfma_f32_16x16x32_bf16(wh[nt][ks], al, acc[nt], 0, 0, 0); } }
#pragma unroll
            for (int nt = 0; nt < 2; ++nt) *(f32x4*)(part + (w * 16 + fr) * 32 + 16 * nt + 4 * fq) = acc[nt];
        }
        __syncthreads();
        if (t0 < TT) {
            const int tk = tid >> 5, e = tid & 31; float x = P.in[I_RB][l * 32 + e];
#pragma unroll
            for (int q = 0; q < 8; ++q) x += part[(q * 16 + tk) * 32 + e];
            float vv[4]; int ix[4];
#pragma unroll
            for (int k = 0; k < 4; ++k) {
                float m = x; m = fmaxf(m, swz_xor<1>(m)); m = fmaxf(m, swz_xor<2>(m)); m = fmaxf(m, swz_xor<4>(m)); m = fmaxf(m, swz_xor<8>(m)); m = fmaxf(m, swz_xor<16>(m));
                const unsigned long long bm = __ballot(x == m); const unsigned hm = (unsigned)(bm >> (lane & 32));
                const int bi = __builtin_ctz(hm);
                vv[k] = m; ix[k] = bi; if (e == bi) x = -3.0e38f; }
            if (e == 0) {
                const int t = t0 + tk; float ex[4], sum = 0.f;
#pragma unroll
                for (int k = 0; k < 4; ++k) { ex[k] = expf(vv[k] - vv[0]); sum += ex[k]; }
                const float inv = 1.f / sum;
#pragma unroll
                for (int k = 0; k < 4; ++k) { ((int*)(ws + WS_TKE))[(size_t)t * 4 + k] = ix[k]; ((float*)(ws + WS_TKW))[(size_t)t * 4 + k] = ex[k] * inv; atomicAdd(&hist[ix[k]], 1); }
            }
        }
    }
    __syncthreads();
    if (tid < 32) ((int*)(ws + WS_BCNT))[bid * 32 + tid] = hist[tid];
}
__device__ __forceinline__ void p7b_scatter(CParams& P, unsigned char* smem, const int TT) {
    const int G = gridDim.x, tid = otid(), bid = obid();
    unsigned char* ws = P.ws;
    int* cur = (int*)smem; int* tot = cur + 32; int* rst = tot + 32; int* ust = rst + 32;
    const int* BC = (const int*)(ws + WS_BCNT);
    __syncthreads();
    int* ptot = ust + 40; int* pbef = ptot + 512;
    { const int e = tid & 31, pr = tid >> 5; int before = 0, total = 0;
      for (int b = pr; b < G; b += 16) { const int c = BC[b * 32 + e]; total += c; before += (b < bid) ? c : 0; }
      ptot[pr * 32 + e] = total; pbef[pr * 32 + e] = before; }
    __syncthreads();
    if (tid < 32) { int before = 0, total = 0;
#pragma unroll
        for (int pr = 0; pr < 16; ++pr) { total += ptot[pr * 32 + tid]; before += pbef[pr * 32 + tid]; }
        tot[tid] = total; cur[tid] = before; }
    __syncthreads();
    if (tid == 0) { int u = 0; for (int e = 0; e < 32; ++e) { ust[e] = u; rst[e] = u * 256; u += (tot[e] + 255) >> 8; } ust[32] = u; }
    __syncthreads();
    if (tid < 32) cur[tid] += rst[tid];
    if (bid == 0 && tid < 33) ((int*)(ws + WS_META))[tid] = ust[tid];
    if (bid == 0 && tid == 33) ((int*)(ws + WS_META))[33] = ust[32];
    __syncthreads();
    int* RTOK = (int*)(ws + WS_RTOK); int* RPAIR = (int*)(ws + WS_RPAIR); float* RW = (float*)(ws + WS_RW);
    const int nit = (TT / 16 + G - 1) / G;
    for (int pi = tid; pi < nit * 64; pi += NTH) {
        const int it = pi >> 6, wq = (pi >> 2) & 15, k = pi & 3, t = (it * G + bid) * 16 + wq;
        if (t < TT) { const int e = ((const int*)(ws + WS_TKE))[(size_t)t * 4 + k]; const int pos = atomicAdd(&cur[e], 1);
            RTOK[pos] = t; RPAIR[pos] = t * 4 + k; RW[pos] = ((const float*)(ws + WS_TKW))[(size_t)t * 4 + k]; }
    }
    for (int e = bid; e < 32; e += G) { const int lo = rst[e] + tot[e], hi = rst[e] + (((tot[e] + 255) >> 8) << 8);
        for (int r = lo + tid; r < hi; r += NTH) { RTOK[r] = 0; RPAIR[r] = -1; RW[r] = 0.f; } }
    __syncthreads();
}

__device__ __forceinline__ void p10_combine(CParams& P, int l) {
    const int tid_ = otid(), lane = tid_ & 63, gw = (obid() * NTH + tid_) >> 6, nw = gridDim.x * (NTH / 64);
    unsigned char* ws = P.ws;
    const bf16_t* X1 = (const bf16_t*)(ws + WS_X1); const bf16_t* YP = (const bf16_t*)(ws + WS_YP);
    const float* MODL = (const float*)(ws + WS_MOD) + (size_t)l * 9 * 6144;
    const int TT = (l == NL - 1) ? TL : T;
    const int per = (TT + nw - 1) / nw, tb = gw * per, te = (tb + per < TT) ? tb + per : TT;
    if (tb >= te) return;
    f32x4 gain[4], g2v[4], scv[4], shv[4]; int curj = -1;
    u32x2 xn[4], yn[4][4];
#define P10_REQ(tx) do { _Pragma("unroll") for (int q = 0; q < 4; ++q) { const int c = q * 256 + lane * 4; xn[q] = *(const u32x2*)(X1 + (size_t)(tx) * 1024 + c); \
        _Pragma("unroll") for (int k = 0; k < 4; ++k) yn[q][k] = __builtin_nontemporal_load((const u32x2*)(YP + ((size_t)(tx) * 4 + k) * 1024 + c)); } } while (0)
    P10_REQ(tb);
#pragma unroll
    for (int q = 0; q < 4; ++q) gain[q] = (l < NL - 1) ? *(const f32x4*)(P.in[I_NMIX] + (size_t)(l + 1) * 1024 + q * 256 + lane * 4) : *(const f32x4*)(P.in[I_NFIN] + q * 256 + lane * 4);
#pragma unroll 1
    for (int t = tb; t < te; ++t) {
        const int mj = tok_modj(t);
        if (mj != curj) { curj = mj; const float* md = MODL + (size_t)mj * 6144; const float* mdn = md + (size_t)9 * 6144;
#pragma unroll
            for (int q = 0; q < 4; ++q) { const int c = q * 256 + lane * 4; g2v[q] = *(const f32x4*)(md + 5120 + c);
                if (l < NL - 1) { scv[q] = *(const f32x4*)(mdn + 1024 + c); shv[q] = *(const f32x4*)(mdn + c); } } }
        f32x4 v[4];
#pragma unroll
        for (int q = 0; q < 4; ++q) { f32x4 s = (f32x4){0.f, 0.f, 0.f, 0.f};
#pragma unroll
            for (int k = 0; k < 4; ++k) { float y[4]; unpack4(yn[q][k], y); s[0] += y[0]; s[1] += y[1]; s[2] += y[2]; s[3] += y[3]; }
            float x1_[4]; unpack4(xn[q], x1_);
            v[q] = (f32x4){x1_[0], x1_[1], x1_[2], x1_[3]} + g2v[q] * s; }
        if (t + 1 < te) P10_REQ(t + 1);
        float ss = 0.f;
#pragma unroll
        for (int q = 0; q < 4; ++q) ss += v[q][0] * v[q][0] + v[q][1] * v[q][1] + v[q][2] * v[q][2] + v[q][3] * v[q][3];
        ss = wave_sum(ss); const float rs = rsqrtf(ss * (1.f / 1024.f) + EPSN);
        if (l < NL - 1) {
#pragma unroll
            for (int q = 0; q < 4; ++q) { const int c = q * 256 + lane * 4;
                u32x2 o_; o_[0] = cvt_pk_bf16(v[q][0], v[q][1]); o_[1] = cvt_pk_bf16(v[q][2], v[q][3]); *(u32x2*)((bf16_t*)(ws + WS_XC) + (size_t)t * 1024 + c) = o_;
                u32x2 h_; h_[0] = cvt_pk_bf16(v[q][0] * rs * gain[q][0] * (1.f + scv[q][0]) + shv[q][0], v[q][1] * rs * gain[q][1] * (1.f + scv[q][1]) + shv[q][1]);
                h_[1] = cvt_pk_bf16(v[q][2] * rs * gain[q][2] * (1.f + scv[q][2]) + shv[q][2], v[q][3] * rs * gain[q][3] * (1.f + scv[q][3]) + shv[q][3]);
                *(u32x2*)((bf16_t*)(ws + WS_H) + (size_t)t * 1024 + c) = h_; }
        } else {
#pragma unroll
            for (int q = 0; q < 4; ++q) { const int c = q * 256 + lane * 4; *(f32x4*)(P.out + (size_t)t * 1024 + c) = v[q] * rs * gain[q]; }
        }
    }
#undef P10_REQ
}

#ifndef PROBE_ID
#define PROBE_ID 0
#endif
template <class Tsrc> __device__ __forceinline__ void probe_dump(const Tsrc* src, size_t n, float* out) {
    const size_t nout = (size_t)TL * 1024; const size_t gth = (size_t)blockIdx.x * NTH + threadIdx.x, nth = (size_t)gridDim.x * NTH;
    for (size_t i = gth; i < nout; i += nth) { float v;
        if constexpr (sizeof(Tsrc) == 2) v = bf2f(((const bf16_t*)src)[i % n]); else v = (float)src[i % n];
        out[i] = v; }
}
#define PROBE_AT(id, type, off, n) do { if (PROBE_ID == (id) && l == 0) { GRID_BAR(); probe_dump((const type*)(WSP + (off)), (size_t)(n), kparams()->out); return; } } while (0)

template <class Tsrc> __device__ __forceinline__ void probe_max(const Tsrc* src, size_t lo, size_t hi, float* out, unsigned* word) {
    const size_t nout = (size_t)TL * 1024; const size_t gth = (size_t)blockIdx.x * NTH + threadIdx.x, nth = (size_t)gridDim.x * NTH;
    float m = 0.f;
    for (size_t i = lo + gth; i < hi; i += nth) { float v; if constexpr (sizeof(Tsrc) == 2) v = bf2f(((const bf16_t*)src)[i]); else v = (float)src[i]; m = fmaxf(m, fabsf(v)); }
    atomicMax(word, __float_as_uint(m));
    for (size_t i = gth; i < nout; i += nth) out[i] = 0.f;
}
#define PROBE_MAX(id, type, off, lo, hi) do { if (PROBE_ID == (id) && l == 0) { GRID_BAR(); unsigned* w_ = (unsigned*)(WSP + WS_CTL) + 3600; probe_max((const type*)(WSP + (off)), (size_t)(lo), (size_t)(hi), kparams()->out, w_); \
    GRID_BAR(); if (blockIdx.x == 0 && threadIdx.x == 0) kparams()->out[0] = __uint_as_float(__hip_atomic_load(w_, __ATOMIC_RELAXED, __HIP_MEMORY_SCOPE_AGENT)); return; } } while (0)

template <class Tsrc> __device__ __forceinline__ void probe_cnt(const Tsrc* src, size_t lo, size_t hi, float thr, float* out, unsigned* word) {
    const size_t nout = (size_t)TL * 1024; const size_t gth = (size_t)blockIdx.x * NTH + threadIdx.x, nth = (size_t)gridDim.x * NTH;
    unsigned m = 0;
    for (size_t i = lo + gth; i < hi; i += nth) { float v; if constexpr (sizeof(Tsrc) == 2) v = bf2f(((const bf16_t*)src)[i]); else v = (float)src[i]; m += (fabsf(v) > thr || v != v) ? 1u : 0u; }
    atomicAdd(word, m);
    for (size_t i = gth; i < nout; i += nth) out[i] = 0.f;
}
#define PROBE_CNT(id, type, off, lo, hi, thr) do { if (PROBE_ID == (id) && l == 0) { GRID_BAR(); unsigned* w_ = (unsigned*)(WSP + WS_CTL) + 3600; probe_cnt((const type*)(WSP + (off)), (size_t)(lo), (size_t)(hi), thr, kparams()->out, w_); \
    GRID_BAR(); if (blockIdx.x == 0 && threadIdx.x == 0) kparams()->out[0] = 100.f + (float)__hip_atomic_load(w_, __ATOMIC_RELAXED, __HIP_MEMORY_SCOPE_AGENT); return; } } while (0)

__device__ __forceinline__ void probe_cnt2(const bf16_t* src, int r0, int r1, int c0, int c1, int ld, float thr, float* out, unsigned* word) {
    const size_t nout = (size_t)TL * 1024; const size_t gth = (size_t)blockIdx.x * NTH + threadIdx.x, nth = (size_t)gridDim.x * NTH;
    unsigned m = 0; const size_t w = (size_t)(c1 - c0), n = (size_t)(r1 - r0) * w;
    for (size_t i = gth; i < n; i += nth) { const size_t r = r0 + i / w, c = c0 + i % w; const float v = bf2f(src[r * ld + c]); m += (fabsf(v) > thr || v != v) ? 1u : 0u; }
    atomicAdd(word, m);
    for (size_t i = gth; i < nout; i += nth) out[i] = 0.f;
}
#define PROBE_CNT2(id, off, r0, r1, c0, c1, ld, thr) do { if (PROBE_ID == (id) && l == 0) { GRID_BAR(); unsigned* w_ = (unsigned*)(WSP + WS_CTL) + 3600; probe_cnt2((const bf16_t*)(WSP + (off)), r0, r1, c0, c1, ld, thr, kparams()->out, w_); \
    GRID_BAR(); if (blockIdx.x == 0 && threadIdx.x == 0) kparams()->out[0] = 100.f + (float)__hip_atomic_load(w_, __ATOMIC_RELAXED, __HIP_MEMORY_SCOPE_AGENT); return; } } while (0)

#ifndef PROBE_TI
#define PROBE_TI -1
#endif
#ifndef PROBE_TJ
#define PROBE_TJ 0
#endif
__device__ __forceinline__ void tstamp(unsigned char* wsp, int slot) {
    if (PROBE_TI >= 0 && blockIdx.x == 0 && threadIdx.x == 0) {
        unsigned long long* tw = (unsigned long long*)(wsp + WS_CTL + 14400);
        const unsigned long long now = wall_clock64(); const unsigned long long prev = tw[0];
        if (slot >= 0) tw[1 + slot] += now - prev;
        tw[0] = now;
    }
}
__device__ __forceinline__ void tdump(unsigned char* wsp, float* out) {
    if (PROBE_TI >= 0 && blockIdx.x == 0 && threadIdx.x == 0) {
        const unsigned long long* tw = (const unsigned long long*)(wsp + WS_CTL + 14400);
        out[0] = 10.f * log2f((float)tw[1 + (PROBE_TI >= 0 ? PROBE_TI : 0)] * 0.01f + 1.f) - 25.f;
    }
}
constexpr int MOE_TILES_P5 = 3712;
#ifndef EXP_P4
#define EXP_P4 0
#endif
#ifndef DUP_MASK
#define DUP_MASK 0
#endif
#define smem fresh_smem()
#define lds fresh_lds()
#define bid obid()
#define LL l
#define P (*kparams())
#define WSP (kparams()->ws)
#define TS(slot) tstamp(WSP, slot)
#define GRID_BAR() do { XcdBarrier b_; b_.bar = (unsigned*)(kparams()->ws + WS_CTL); b_.x = xb_xcc_id(); b_.st = (volatile LAS unsigned*)(lds + LDS_XB); xcd_barrier(b_); } while (0)
template <int l> __device__ __forceinline__ void run_layer() {
    const int G = gridDim.x;
    constexpr int TT = (l == NL - 1) ? TL : T;
        for (int rep_ = 0; rep_ < ((DUP_MASK & 2) ? 2 : 1); ++rep_) {
        { Src1 S{(const char*)(WSP + WS_H), (const char*)(WSP + WS_W1T) + (size_t)LL * N1 * 2048, (const char*)(WSP + WS_WFT) + (size_t)LL * 512 * 2048, G, bid};
          Epi1 E{(bf16_t*)(WSP + WS_G), (bf16_t*)(WSP + WS_PJ), (float*)(WSP + WS_DTR), (bf16_t*)(WSP + WS_VT), (bf16_t*)(WSP + WS_VTC)};
          pg8::gemm_phase<false>(lds, S, E, 1024, 1024); }
        PROBE_AT(1, bf16_t, WS_PJ, (size_t)T * PJW);
        PROBE_AT(2, bf16_t, WS_G, (size_t)T * 4096);
        PROBE_MAX(20, bf16_t, WS_G, 0, (size_t)T * 4096);
        PROBE_MAX(21, bf16_t, WS_PJ, 0, (size_t)T * PJW);
        PROBE_CNT(23, bf16_t, WS_G, 0, (size_t)T * 4096, 1.001f);
        PROBE_CNT2(24, WS_G, 0, T, 0, 2048, 4096, 1.001f);
        PROBE_CNT2(25, WS_G, 0, T, 3840, 4096, 4096, 1.001f);
        PROBE_CNT2(26, WS_G, 0, 256, 0, 4096, 4096, 1.001f);
        PROBE_MAX(22, bf16_t, WS_H, 0, (size_t)T * 1024);
        GRID_BAR();
        }
        TS(2);
        for (int rep_ = 0; rep_ < ((DUP_MASK & (32 | 64)) ? 2 : 1); ++rep_) {
        p3_prep(P, smem, LL);
        GRID_BAR();
        }
        TS(3);
        for (int rep_ = 0; rep_ < ((DUP_MASK & 4) ? 2 : 1); ++rep_) {
        { dft_nyquist((const bf16_t*)(WSP + WS_VT), (bf16_t*)(WSP + WS_YC), bid * 8, 8);
          if (G < 256) for (int r0_ = G * 8; r0_ < 2048; r0_ += 8) dft_nyquist((const bf16_t*)(WSP + WS_VT), (bf16_t*)(WSP + WS_YC), r0_, 8);
          unsigned* wq_ = (unsigned*)(WSP + WS_CTL) + 3800 + l;
#pragma unroll 1
          for (;;) {
              __syncthreads();
              if (threadIdx.x == 0) *(volatile LAS int*)(lds + LDS_XB + 32) = (int)__hip_atomic_fetch_add(wq_, 1u, __ATOMIC_RELAXED, __HIP_MEMORY_SCOPE_AGENT);
              __syncthreads();
              const int idx_ = __builtin_amdgcn_readfirstlane(*(volatile LAS int*)(lds + LDS_XB + 32));
              if (idx_ >= 136 + 256 + NB * 2 * NCH) break;
              if (idx_ < 136) { if (EXP_P4 & 1) continue;
                  SrcDft S{(const char*)(WSP + WS_D4C), (const char*)(WSP + WS_D4S), (const char*)(WSP + WS_D256), (const char*)(WSP + WS_VT), (const char*)(WSP + WS_VTC), idx_, 1000};
                  EpiDft E{(bf16_t*)(WSP + WS_YC)};
                  pg8::gemm_phase<false>(lds, S, E, 4096, 8192); }
              else if (idx_ < 136 + 256) { if (!(EXP_P4 & 2)) hyena_conv_channel(P, smem, lds, LL, idx_ - 136); }
              else { if (!(EXP_P4 & 4)) ssd_a_unit(P, smem, lds, LL, idx_ - 136 - 256); }
          }
          TS(16); }
        GRID_BAR();
        }
        TS(4);
        for (int rep_ = 0; rep_ < ((DUP_MASK & (32 | 128)) ? 2 : 1); ++rep_) {
        ssd_phase_b(P);
        hyena_finish(P, smem, LL);
        GRID_BAR();
        }
        TS(5);
        for (int rep_ = 0; rep_ < ((DUP_MASK & (32 | 256)) ? 2 : 1); ++rep_) {
        ssd_phase_c(P, smem, lds, LL);
        PROBE_AT(3, bf16_t, WS_YC, (size_t)T * YCW);
        GRID_BAR();
        }
        TS(6);
        for (int rep_ = 0; rep_ < ((DUP_MASK & 16) ? 2 : 1); ++rep_) {
        { SrcBr S{(const char*)(WSP + WS_YC), (const char*)(WSP + WS_WBRT) + (size_t)LL * 1024 * YCW * 2, G, bid, TT / 256};
          EpiBr E{(const bf16_t*)(WSP + WS_G), (bf16_t*)(WSP + WS_MG), (const float*)(WSP + WS_SSQ)};
          pg8::gemm_phase<false>(lds, S, E, YCW, YCW); }
        {
            constexpr int NSU = (TT / 256) * 4; const int rem = NSU % G, b_ = bid;
            const int nearly = rem == 0 ? G : G - rem, part = rem == 0 ? b_ : b_ - rem;
            if (part >= 0) p0_transposes(P, smem, l * TILES_PER_LAYER + TILES_DENSE + MOE_TILES_P0, l * TILES_PER_LAYER + TILES_DENSE + MOE_TILES_P0 + MOE_TILES_P5, part, nearly); }
        GRID_BAR();
        }
        TS(7);
        for (int rep_ = 0; rep_ < ((DUP_MASK & 32768) ? 2 : 1); ++rep_) {
        PROBE_AT(6, bf16_t, WS_MG, (size_t)T * 1024);
        PROBE_AT(7, float, WS_SSQ, (size_t)T * 8);
        { SrcOut S{(const char*)(WSP + WS_MG), (const char*)(WSP + WS_WOUTT) + (size_t)LL * 1024 * 2048, G, bid, TT / 256};
          if constexpr (l == 0) { EpiOut<true> E{P.in[I_X], P.in[I_CTX], (bf16_t*)(WSP + WS_X1), (const float*)(WSP + WS_MOD) + (size_t)LL * 9 * 6144}; pg8::gemm_phase<false>(lds, S, E, 1024, 1024); }
          else { EpiOut<false> E{(const bf16_t*)(WSP + WS_XC), (const bf16_t*)(WSP + WS_XC) + (size_t)TL * 1024, (bf16_t*)(WSP + WS_X1), (const float*)(WSP + WS_MOD) + (size_t)LL * 9 * 6144}; pg8::gemm_phase<false>(lds, S, E, 1024, 1024); } }
        {
            constexpr int NSU = (TT / 256) * 4; const int rem = NSU % G, b_ = bid;
            const int nearly = rem == 0 ? G : G - rem, part = rem == 0 ? b_ : b_ - rem;
            if (part >= 0) p0_transposes(P, smem, l * TILES_PER_LAYER + TILES_DENSE + MOE_TILES_P0 + MOE_TILES_P5, (l + 1) * TILES_PER_LAYER, part, nearly); }
        GRID_BAR();
        }
        TS(8);
        for (int rep_ = 0; rep_ < ((DUP_MASK & (32 | 512)) ? 2 : 1); ++rep_) {
        PROBE_AT(4, bf16_t, WS_X1, (size_t)T * 1024);
        p7a_route(P, smem, lds, LL, TT);
        GRID_BAR();
        }
        TS(9);
        for (int rep_ = 0; rep_ < ((DUP_MASK & (32 | 1024)) ? 2 : 1); ++rep_) {
        p7b_scatter(P, smem, TT);
        GRID_BAR();
        if (DUP_MASK & 65536) { GRID_BAR(); GRID_BAR(); GRID_BAR(); GRID_BAR(); GRID_BAR(); GRID_BAR(); GRID_BAR(); GRID_BAR(); }
        }
        TS(10);
        for (int rep_ = 0; rep_ < ((DUP_MASK & 8) ? 2 : 1); ++rep_) {
        { SrcUp S{(const char*)(WSP + WS_H2), (const char*)(WSP + WS_WUPT) + (size_t)LL * 32 * 2048 * 2048, (const int*)(WSP + WS_RTOK), (const int*)(WSP + WS_META), G, bid};
          EpiUp E{(bf16_t*)(WSP + WS_ACTB), P.in[I_BUP] + (size_t)LL * 32 * 2048};
          pg8::gemm_phase<true>(lds, S, E, 1024, 1024); }
        GRID_BAR();
        }
        TS(11);
        for (int rep_ = 0; rep_ < ((DUP_MASK & 8) ? 2 : 1); ++rep_) {
        { SrcDn S{(const char*)(WSP + WS_ACTB), (const char*)(WSP + WS_WDNT) + (size_t)LL * 32 * 1024 * 2048, (const int*)(WSP + WS_META), G, bid};
          EpiDn E{(bf16_t*)(WSP + WS_YP), P.in[I_BDN] + (size_t)LL * 32 * 1024, (const int*)(WSP + WS_RPAIR), (const float*)(WSP + WS_RW)};
          pg8::gemm_phase<false>(lds, S, E, 1024, 1024); }
        GRID_BAR();
        }
        TS(12);
        for (int rep_ = 0; rep_ < ((DUP_MASK & (32 | 2048)) ? 2 : 1); ++rep_) {
        PROBE_AT(5, bf16_t, WS_YP, (size_t)T * 4 * 1024);
        p10_combine(P, LL);
        GRID_BAR();
        }
        TS(13);
}
__global__ void __launch_bounds__(NTH, 2) fwd_kernel(Params Pk) {
    const int tid = threadIdx.x, G = gridDim.x;
    if (tid < 4) ((volatile LAS unsigned*)(lds + LDS_XB))[tid] = 0u;
    __syncthreads();
    (void)xcd_barrier_post((unsigned*)(Pk.ws + WS_CTL), (volatile LAS unsigned*)(lds + LDS_XB));

    TS(-1);
    for (int rep_ = 0; rep_ < ((DUP_MASK & 1) ? 2 : 1); ++rep_) {
    p0_prep(P, smem);
    GRID_BAR();
    }
    TS(0);
    p1_norm0(P);
    GRID_BAR();
    TS(1);
    run_layer<0>(); run_layer<1>(); run_layer<2>(); run_layer<3>();
    if (PROBE_TI >= 0) { GRID_BAR(); tdump(WSP, kparams()->out); }
}
#undef bid
#undef LL
#undef smem
#undef lds
#undef GRID_BAR
#undef P
#undef WSP
#undef TS

extern "C" void kernel_launch(void* const* d_in, const int* in_sizes, int n_in, void* d_out, int out_size, void* d_ws, size_t ws_size, hipStream_t stream) {
    static int grid = 0;
    if (grid == 0) {
        if (n_in != 35 || ws_size < WS_END) { fprintf(stderr, "kernel_launch: need 35 inputs and %zu bytes of workspace (got %d, %zu)\n", (size_t)WS_END, n_in, ws_size); grid = -1; return; }
        int dev = 0, cus = 0, per_cu = 0;
        if (hipGetDevice(&dev) != hipSuccess || hipDeviceGetAttribute(&cus, hipDeviceAttributeMultiprocessorCount, dev) != hipSuccess) { grid = -1; return; }
        if (hipFuncSetAttribute((const void*)fwd_kernel, hipFuncAttributeMaxDynamicSharedMemorySize, LDS_BYTES) != hipSuccess) { fprintf(stderr, "kernel_launch: hipFuncSetAttribute failed\n"); grid = -1; return; }
        if (hipOccupancyMaxActiveBlocksPerMultiprocessor(&per_cu, (const void*)fwd_kernel, NTH, LDS_BYTES) != hipSuccess || per_cu < 1) { fprintf(stderr, "kernel_launch: occupancy query says %d\n", per_cu); }
        (void)hipGetLastError();
        grid = cus;
    }
    if (grid < 0) return;
    (void)in_sizes; (void)out_size;
    hipMemsetAsync((char*)d_ws + WS_CTL, 0, 16384, stream);
    Params p{};
    for (int i = 0; i < 35; ++i) p.in[i] = (const float*)d_in[i];
    p.out = (float*)d_out; p.ws = (unsigned char*)d_ws;
    hipLaunchKernelGGL(fwd_kernel, dim3(grid), dim3(NTH), LDS_BYTES, stream, p);
}
```

```cpp
#include <hip/hip_runtime.h>
#include <cstdio>
#include <cstdint>
#define LAS __attribute__((address_space(3)))
typedef unsigned short bf16_t;
typedef short bf16x8 __attribute__((ext_vector_type(8)));
typedef short bf16x4 __attribute__((ext_vector_type(4)));
typedef float f32x4 __attribute__((ext_vector_type(4)));
typedef float f32x2 __attribute__((ext_vector_type(2)));
typedef float f32x16 __attribute__((ext_vector_type(16)));
typedef unsigned u32x4 __attribute__((ext_vector_type(4)));
typedef unsigned u32x2 __attribute__((ext_vector_type(2)));

constexpr int DM = 1024, NB = 8, SEQ = 4096, CTXL = 256, NL = 4;
constexpr int TL = NB * SEQ, TC = NB * CTXL, T = TL + TC;
constexpr int NTH = 512;
constexpr int INW = 2832;
constexpr int N1 = 6912;
constexpr int PJW = 2560;
constexpr int YCW = 1536;
constexpr int NEXP = 32, EFF = 1024;
constexpr int NCH = 34;
constexpr int MAXU = 576;
constexpr int RMAX = MAXU * 256;
constexpr float EPSN = 1e-6f;

constexpr size_t alup(size_t x) { return (x + 255) & ~size_t(255); }
constexpr size_t WS_CTL   = 0;
constexpr size_t WS_W1T   = 16384;
constexpr size_t WS_WFT   = WS_W1T   + alup((size_t)NL * N1 * 1024 * 2);
constexpr size_t WS_WBRT  = WS_WFT   + alup((size_t)NL * 512 * 1024 * 2);
constexpr size_t WS_WOUTT = WS_WBRT  + alup((size_t)NL * 1024 * YCW * 2);
constexpr size_t WS_WUPT  = WS_WOUTT + alup((size_t)NL * 1024 * 1024 * 2);
constexpr size_t WS_WDNT  = WS_WUPT  + alup((size_t)NL * 32 * 2048 * 1024 * 2);
constexpr size_t WS_D4C   = WS_WDNT  + alup((size_t)NL * 32 * 1024 * 1024 * 2);
constexpr size_t WS_D4S   = WS_D4C   + alup((size_t)4096 * 4096 * 2);
constexpr size_t WS_D256  = WS_D4S   + alup((size_t)4096 * 4096 * 2);
constexpr size_t WS_KRAW  = WS_D256  + alup((size_t)256 * 4096 * 2);
constexpr size_t WS_KPART = WS_KRAW  + alup((size_t)NL * 2 * 4096 * 512 * 4);
constexpr size_t WS_MOD   = WS_KPART + alup((size_t)NL * 2 * 64 * 512 * 4);
constexpr size_t WS_H     = WS_MOD   + alup((size_t)NL * 9 * 6144 * 4);
constexpr size_t WS_G     = WS_H     + alup((size_t)T * 1024 * 2);
constexpr size_t WS_PJ    = WS_G     + alup((size_t)T * 4096 * 2);
constexpr size_t WS_DTR   = WS_PJ    + alup((size_t)T * PJW * 2);
constexpr size_t WS_DT    = WS_DTR   + alup((size_t)T * 16 * 4);
constexpr size_t WS_VT    = WS_DT    + alup((size_t)T * 16 * 4);
constexpr size_t WS_VTC   = WS_VT    + alup((size_t)2048 * 8192 * 2);
constexpr size_t WS_YC    = WS_VTC   + alup((size_t)2048 * 8192 * 2);
constexpr size_t WS_XBN   = WS_YC    + alup((size_t)T * YCW * 2);
constexpr size_t WS_XST   = WS_XBN   + alup((size_t)T * 1024 * 2);
constexpr size_t WS_XSTC  = WS_XST   + alup((size_t)8 * 768 * 4096 * 2);
constexpr size_t WS_VVT   = WS_XSTC  + alup((size_t)8 * 768 * 256 * 2);
constexpr size_t WS_VVTC  = WS_VVT   + alup((size_t)8 * 256 * 4096 * 2);
constexpr size_t WS_CVT   = WS_VVTC  + alup((size_t)8 * 256 * 256 * 2);
constexpr size_t WS_CVTC  = WS_CVT   + alup((size_t)8 * 256 * 4096 * 4);
constexpr size_t WS_ST    = WS_CVTC  + alup((size_t)8 * 256 * 256 * 4);
constexpr size_t WS_HENT  = WS_ST    + alup((size_t)8 * 2 * 4 * 2 * NCH * 8192 * 4);
constexpr size_t WS_ACT   = WS_HENT  + alup((size_t)8 * 2 * 4 * 2 * NCH * 8192 * 2);
constexpr size_t WS_YD    = WS_ACT   + alup((size_t)8 * 2 * 4 * 2 * NCH * 4);
constexpr size_t WS_SSQ   = WS_YD    + alup((size_t)T * 512 * 4);
constexpr size_t WS_MG    = WS_SSQ   + alup((size_t)T * 8 * 4);
constexpr size_t WS_X1    = WS_MG    + alup((size_t)T * 1024 * 2);
constexpr size_t WS_XC    = WS_X1    + alup((size_t)T * 1024 * 4);
constexpr size_t WS_H2    = WS_XC    + alup((size_t)T * 1024 * 4);
constexpr size_t WS_TKE   = WS_H2    + alup((size_t)T * 1024 * 2);
constexpr size_t WS_TKW   = WS_TKE   + alup((size_t)T * 4 * 4);
constexpr size_t WS_BCNT  = WS_TKW   + alup((size_t)T * 4 * 4);
constexpr size_t WS_RTOK  = WS_BCNT  + alup((size_t)1024 * 32 * 4);
constexpr size_t WS_RPAIR = WS_RTOK  + alup((size_t)RMAX * 4);
constexpr size_t WS_RW    = WS_RPAIR + alup((size_t)RMAX * 4);
constexpr size_t WS_META  = WS_RW    + alup((size_t)RMAX * 4);
constexpr size_t WS_ACTB  = WS_META  + alup(256);
constexpr size_t WS_YP    = WS_ACTB  + alup((size_t)RMAX * 1024 * 2);
constexpr size_t WS_WRT   = WS_YP    + alup((size_t)T * 4 * 1024 * 2);
constexpr size_t WS_ACSG  = WS_WRT   + alup((size_t)NL * 2 * 32 * 1024 * 2);
constexpr size_t WS_END   = WS_ACSG  + alup((size_t)NB * 2 * NCH * 1024 * 4);

constexpr int LDS_BYTES = 155648;
constexpr int LDS_XB = LDS_BYTES - 64;

__device__ __forceinline__ unsigned cvt_pk_bf16(float lo, float hi) { typedef __bf16 bf2_t __attribute__((ext_vector_type(2))); const bf2_t v = {(__bf16)lo, (__bf16)hi}; return __builtin_bit_cast(unsigned, v); }
__device__ __forceinline__ bf16_t f2bf(float f) { return (bf16_t)(cvt_pk_bf16(f, 0.f) & 0xffffu); }
__device__ __forceinline__ float bf2f(bf16_t b) { return __uint_as_float(((unsigned)b) << 16); }
__device__ __forceinline__ float bflo(unsigned u) { return __uint_as_float(u << 16); }
__device__ __forceinline__ float bfhi(unsigned u) { return __uint_as_float(u & 0xffff0000u); }
template <int X> __device__ __forceinline__ float swz_xor(float v) { return __int_as_float(__builtin_amdgcn_ds_swizzle(__float_as_int(v), (X << 10) | 0x1f)); }
__device__ __forceinline__ float xor32_sum(float v) {
    typedef unsigned u2 __attribute__((ext_vector_type(2)));
    const u2 r = __builtin_amdgcn_permlane32_swap(__float_as_uint(v), __float_as_uint(v), false, false);
    return __uint_as_float(r[0]) + __uint_as_float(r[1]);
}
__device__ __forceinline__ float wave_sum(float v) {
    v += swz_xor<1>(v); v += swz_xor<2>(v); v += swz_xor<4>(v); v += swz_xor<8>(v); v += swz_xor<16>(v);
    return xor32_sum(v);
}
extern __shared__ __attribute__((aligned(16))) unsigned char dyn_smem[];
__device__ __forceinline__ LAS unsigned char* fresh_lds() { unsigned o = 0; asm volatile("" : "+s"(o)); return (LAS unsigned char*)dyn_smem + o; }
__device__ __forceinline__ unsigned char* fresh_smem() { return (unsigned char*)fresh_lds(); }
__device__ __forceinline__ int otid() { int t = threadIdx.x; asm volatile("" : "+v"(t)); return t; }
__device__ __forceinline__ int obid() { int t = blockIdx.x; asm volatile("" : "+s"(t)); return t; }
__device__ __forceinline__ int ouni(int t) { asm volatile("" : "+s"(t)); return t; }
__device__ __forceinline__ float fsigmoid(float x) { return __builtin_amdgcn_rcpf(1.f + __expf(-x)); }
__device__ __forceinline__ float fsilu(float x) { return x * fsigmoid(x); }
__device__ __forceinline__ float fsoftplus(float x) { return x > 20.f ? x : log1pf(expf(x)); }

#define XB_TMO      128
#define XB_XCNT(j)  (256  + 64 * (j))
#define XB_XSUB(j)  (1280 + 64 * (j))
#define XB_XGEN(j)  (2304 + 64 * (j))
#define XB_TOP      3328
#define XB_TOPGEN   3392
#define XCD_BAR_WORDS 3456
#define XB_SPIN_CAP (1u << 22)
__device__ __forceinline__ unsigned xb_ld(unsigned* p)              { return __hip_atomic_load(p, __ATOMIC_RELAXED, __HIP_MEMORY_SCOPE_AGENT); }
__device__ __forceinline__ unsigned xb_add(unsigned* p, unsigned v) { return __hip_atomic_fetch_add(p, v, __ATOMIC_RELAXED, __HIP_MEMORY_SCOPE_AGENT); }
__device__ __forceinline__ unsigned xb_xcc_id() { return (unsigned)__builtin_amdgcn_s_getreg((3 << 11) | 20) & 0xFu; }
#define XB_SPIN(cond, bar) do { unsigned _sp = 0; while (cond) { __builtin_amdgcn_s_sleep(1); \
    if ((++_sp & 255u) == 0u) { if (xb_ld(&(bar)[XB_TMO])) break; if (_sp > XB_SPIN_CAP) { atomicAdd(&(bar)[XB_TMO], 1u); break; } } } } while (0)
struct XcdBarrier { unsigned* bar; unsigned x; volatile LAS unsigned* st; };
__device__ __forceinline__ XcdBarrier xcd_barrier_post(unsigned* bar, volatile LAS unsigned* st) {
    XcdBarrier b; b.bar = bar; b.x = xb_xcc_id(); b.st = st;
    if (threadIdx.x == 0) (void)xb_add(&bar[XB_XCNT(b.x)], 1u);
    return b;
}
__device__ __forceinline__ void xcd_barrier_complete(unsigned* bar, unsigned x, unsigned& nloc, unsigned& nx) {
    const unsigned G = gridDim.x * gridDim.y * gridDim.z;
    unsigned sum, cnt, mine, sp = 0u;
    for (;;) {
        sum = 0u; cnt = 0u; mine = 0u;
#pragma unroll
        for (unsigned j = 0; j < 16; ++j) { const unsigned c = xb_ld(&bar[XB_XCNT(j)]); sum += c; cnt += (c > 0u) ? 1u : 0u; mine = (j == x) ? c : mine; }
        if (sum == G) break;
        __builtin_amdgcn_s_sleep(1);
        if ((++sp & 255u) == 0u) { if (xb_ld(&bar[XB_TMO])) break; if (sp > XB_SPIN_CAP) { atomicAdd(&bar[XB_TMO], 1u); break; } }
    }
    nloc = mine > 0u ? mine : 1u; nx = cnt > 0u ? cnt : 1u;
}
__device__ __forceinline__ void xcd_barrier(const XcdBarrier& b) {
    asm volatile("s_waitcnt vmcnt(0)" ::: "memory");
    __syncthreads();
    if (threadIdx.x == 0) {
        unsigned* bar = b.bar;
        __builtin_amdgcn_s_waitcnt(0);
        unsigned nloc = b.st[0], nx = b.st[1];
        if (nloc == 0u) { xcd_barrier_complete(bar, b.x, nloc, nx); b.st[0] = nloc; b.st[1] = nx; }
        const unsigned old = xb_add(&bar[XB_XSUB(b.x)], 1u);
        const unsigned gen = old / nloc;
        if (old + 1u == (gen + 1u) * nloc) {
            __builtin_amdgcn_fence(__ATOMIC_RELEASE, "agent");
            asm volatile("s_waitcnt vmcnt(0)" ::: "memory");
            const unsigned og = xb_add(&bar[XB_TOP], 1u);
            const unsigned tg = og / nx;
            if (og + 1u == (tg + 1u) * nx) xb_add(&bar[XB_TOPGEN], 1u);
            else XB_SPIN(xb_ld(&bar[XB_TOPGEN]) == tg, bar);
            __builtin_amdgcn_fence(__ATOMIC_ACQUIRE, "agent");
            xb_add(&bar[XB_XGEN(b.x)], 1u);
            asm volatile("s_waitcnt vmcnt(0)" ::: "memory");
        } else {
            XB_SPIN(xb_ld(&bar[XB_XGEN(b.x)]) == gen, bar);
            __builtin_amdgcn_fence(__ATOMIC_ACQUIRE, "agent");
            asm volatile("s_waitcnt vmcnt(0)" ::: "memory");
        }
    }
    __syncthreads();
}

namespace pg8 {
constexpr int BM = 256, BK = 64, HALF = 128, HTB = HALF * BK * 2, STAGE_BYTES = 8 * HTB, NXCD = 8, WGM = 8;
__host__ __device__ __forceinline__ int lds_byte(int r, int c) { const int st = (r >> 4) * 2 + (c >> 5), rr = r & 15, cc = c & 31, ob = rr * 64 + cc * 2; return st * 1024 + (ob ^ (((ob >> 9) & 1) << 5)); }
__host__ __device__ __forceinline__ void stage_rc(int b, int& R, int& C) { const int st = b / 1024, sb = b % 1024, swz = sb ^ (((sb >> 9) & 1) << 5); R = (st >> 1) * 16 + swz / 64; C = (st & 1) * 32 + (swz % 64) / 2; }
__host__ __device__ __forceinline__ int perm32(int rho) { const int n = rho >> 4, i = rho & 15; return 8 * (i >> 2) + 4 * n + (i & 3); }

__device__ __forceinline__ void remap_tile(int L, int nM, int nN, int& pm, int& pn) {
    const int nwg = nM * nN; int wgid = L;
    { const int q = nwg / NXCD, r = nwg % NXCD, xcd = wgid % NXCD, off = wgid / NXCD; wgid = (xcd < r ? xcd * (q + 1) : r * (q + 1) + (xcd - r) * q) + off; }
    const int nig = WGM * nN, gid = wgid / nig, fm = gid * WGM, gsz = (nM - fm) < WGM ? (nM - fm) : WGM;
    pm = fm + ((wgid % nig) % gsz); pn = (wgid % nig) / gsz;
}

struct GUnit { const char* a0; const char* a1; const char* b0; const char* b1; const int* gidx; int nt, pm, pn, kind, e; };

template <bool GATHER, class Src, class Epi>
__device__ __forceinline__ void gemm_phase(LAS unsigned char* lds, const Src& S, const Epi& E, const int lda, const int ldb) {
    const int tid = otid(), wid = __builtin_amdgcn_readfirstlane(tid >> 6), lane = tid & 63, wr = wid >> 2, wc = wid & 3, fr = lane & 15, fq = lane >> 4;
    unsigned voffA[2], voffB[2];
#pragma unroll
    for (int i = 0; i < 2; ++i) { int R, C; stage_rc(tid * 16 + i * 8192, R, C); const int Rb = (R & ~31) + perm32(R & 31);
        voffA[i] = (unsigned)(R * lda + C) * 2u; voffB[i] = (unsigned)(Rb * ldb + C) * 2u; }
    const size_t kstep = (size_t)(BK * 2);
    const unsigned ldsw = (unsigned)wid * 1024u;
    const int aoff = lds_byte(wr * 64 + fr, fq * 8), boff = lds_byte(wc * 32 + fr, fq * 8);
#define PG8_SA(b, h) (((b) * 2 + (h)) * HTB)
#define PG8_SB(b, h) ((4 + (b) * 2 + (h)) * HTB)
#define PG8_STAGE(bufoff, gbase, voff) do { _Pragma("unroll") for (int _i = 0; _i < 2; ++_i) \
        __builtin_amdgcn_global_load_lds((const unsigned*)((const char*)(gbase) + (voff)[_i]), (LAS unsigned*)(lds + (bufoff) + ldsw + _i * 8192), 16, 0, 0); } while (0)
#define PG8_LDA(dst, b, h) do { _Pragma("unroll") for (int m = 0; m < 4; ++m) _Pragma("unroll") for (int k = 0; k < 2; ++k) dst[m][k] = *(const LAS bf16x8*)(lds + PG8_SA(b, h) + aoff + m * 2048 + k * 1024); } while (0)
#define PG8_LDB(dst, b, h) do { _Pragma("unroll") for (int n = 0; n < 2; ++n) _Pragma("unroll") for (int k = 0; k < 2; ++k) dst[n][k] = *(const LAS bf16x8*)(lds + PG8_SB(b, h) + boff + n * 2048 + k * 1024); } while (0)
#define PG8_MMA(ai, bj, At, Bt) do { __builtin_amdgcn_s_setprio(1); _Pragma("unroll") for (int m = 0; m < 4; ++m) _Pragma("unroll") for (int n = 0; n < 2; ++n) _Pragma("unroll") for (int k = 0; k < 2; ++k) \
        acc[ai][bj][m][n] = __builtin_amdgcn_mfma_f32_16x16x32_bf16(Bt[n][k], At[m][k], acc[ai][bj][m][n], 0, 0, 0); __builtin_amdgcn_s_setprio(0); } while (0)
#define PG8_WAIT_V(n) asm volatile("s_waitcnt vmcnt(" #n ")" ::: "memory")
#define PG8_WAIT_L(n) asm volatile("s_waitcnt lgkmcnt(" #n ")" ::: "memory")
#define PG8_BAR __builtin_amdgcn_s_barrier()
#define PG8_SCHED __builtin_amdgcn_sched_barrier(0)
#define PG8_LOADV(u, v) do { int _tt = tid; asm volatile("" : "+v"(_tt)); _Pragma("unroll") for (int _i = 0; _i < 2; ++_i) { int _R, _C; stage_rc(_tt * 16 + _i * 8192, _R, _C); \
        _Pragma("unroll") for (int _h = 0; _h < 2; ++_h) { if constexpr (GATHER) v[_h][_i] = (unsigned)((u).gidx[_h * 128 + _R] * lda + _C) * 2u; else v[_h][_i] = voffA[_i]; } } } while (0)
    GUnit cur, nxt; int ui = 0;
    if (!S.get(0, cur)) return;
    f32x4 acc[2][2][4][2];
#pragma unroll
    for (int a = 0; a < 2; ++a)
#pragma unroll
        for (int b = 0; b < 2; ++b)
#pragma unroll
            for (int m = 0; m < 4; ++m)
#pragma unroll
                for (int n = 0; n < 2; ++n) acc[a][b][m][n] = (f32x4){0.f, 0.f, 0.f, 0.f};
    bf16x8 At[4][2], B0[2][2], B1[2][2];
    unsigned va[2][2];
    PG8_LOADV(cur, va);
    const char* cA0 = cur.a0; const char* cA1 = cur.a1; const char* cB0 = cur.b0; const char* cB1 = cur.b1;
    PG8_STAGE(PG8_SB(0, 0), cB0, voffB); PG8_STAGE(PG8_SA(0, 0), cA0, va[0]); PG8_STAGE(PG8_SB(0, 1), cB1, voffB); PG8_STAGE(PG8_SA(0, 1), cA1, va[1]);
    if (wr == 1) PG8_BAR;
    PG8_WAIT_V(4); PG8_BAR;
    PG8_STAGE(PG8_SB(1, 0), cB0 + kstep, voffB); PG8_STAGE(PG8_SA(1, 0), cA0 + kstep, va[0]); PG8_STAGE(PG8_SB(1, 1), cB1 + kstep, voffB);
    PG8_WAIT_V(6); PG8_BAR;
    for (;;) {
        const bool has_next = S.get(ui + 1, nxt);
        const char* nA0 = has_next ? nxt.a0 : cA0; const char* nA1 = has_next ? nxt.a1 : cA1;
        const char* nB0 = has_next ? nxt.b0 : cB0; const char* nB1 = has_next ? nxt.b1 : cB1;
        const int nt = cur.nt;
        for (int t = 0; t < nt; t += 2) {
            const bool last = (t == nt - 2);
            const char* a1h1 = cA1 + (size_t)(t + 1) * kstep;
            const char* a2h0 = last ? nA0 : cA0 + (size_t)(t + 2) * kstep; const char* a2h1 = last ? nA1 : cA1 + (size_t)(t + 2) * kstep;
            const char* b2h0 = last ? nB0 : cB0 + (size_t)(t + 2) * kstep; const char* b2h1 = last ? nB1 : cB1 + (size_t)(t + 2) * kstep;
            const char* a3h0 = a2h0 + kstep; const char* b3h0 = b2h0 + kstep; const char* b3h1 = b2h1 + kstep;
            PG8_LDB(B0, 0, 0); PG8_SCHED; PG8_LDA(At, 0, 0); PG8_STAGE(PG8_SA(1, 1), a1h1, va[1]);
            if constexpr (GATHER) { if (last && has_next) { PG8_LOADV(nxt, va); } }
            PG8_WAIT_L(8); PG8_BAR; PG8_WAIT_L(0); PG8_MMA(0, 0, At, B0); PG8_BAR; PG8_SCHED;
            PG8_LDB(B1, 0, 1); PG8_STAGE(PG8_SB(0, 0), b2h0, voffB);
            PG8_BAR; PG8_WAIT_L(0); PG8_MMA(0, 1, At, B1); PG8_BAR;
            PG8_LDA(At, 0, 1); PG8_STAGE(PG8_SA(0, 0), a2h0, va[0]);
            PG8_BAR; PG8_WAIT_L(0); PG8_MMA(1, 0, At, B0); PG8_BAR; PG8_SCHED;
            PG8_STAGE(PG8_SB(0, 1), b2h1, voffB);
            PG8_WAIT_V(6); PG8_BAR; PG8_MMA(1, 1, At, B1); PG8_BAR;
            PG8_LDB(B0, 1, 0); PG8_SCHED; PG8_LDA(At, 1, 0); PG8_STAGE(PG8_SA(0, 1), a2h1, va[1]);
            PG8_WAIT_L(8); PG8_BAR; PG8_WAIT_L(0); PG8_MMA(0, 0, At, B0); PG8_BAR; PG8_SCHED;
            PG8_LDB(B1, 1, 1); PG8_STAGE(PG8_SB(1, 0), b3h0, voffB);
            PG8_BAR; PG8_WAIT_L(0); PG8_MMA(0, 1, At, B1); PG8_BAR;
            PG8_LDA(At, 1, 1); PG8_STAGE(PG8_SA(1, 0), a3h0, va[0]);
            PG8_BAR; PG8_WAIT_L(0); PG8_MMA(1, 0, At, B0); PG8_BAR; PG8_SCHED;
            PG8_STAGE(PG8_SB(1, 1), b3h1, voffB);
            PG8_WAIT_V(6); PG8_BAR; PG8_MMA(1, 1, At, B1); PG8_BAR;
        }
        E(acc, cur, wr, wc, fr, fq);
        if (!has_next) break;
#pragma unroll
        for (int a = 0; a < 2; ++a)
#pragma unroll
            for (int b = 0; b < 2; ++b)
#pragma unroll
                for (int m = 0; m < 4; ++m)
#pragma unroll
                    for (int n = 0; n < 2; ++n) acc[a][b][m][n] = (f32x4){0.f, 0.f, 0.f, 0.f};
        cur = nxt; cA0 = nA0; cA1 = nA1; cB0 = nB0; cB1 = nB1; ++ui;
    }
    PG8_WAIT_V(0);
    if (wr == 0) PG8_BAR;
    PG8_BAR;
#undef PG8_SA
#undef PG8_SB
#undef PG8_STAGE
#undef PG8_LDA
#undef PG8_LDB
#undef PG8_MMA
#undef PG8_WAIT_V
#undef PG8_WAIT_L
#undef PG8_BAR
#undef PG8_SCHED
#undef PG8_LOADV
}
}
using pg8::GUnit;

struct Params { const float* in[35]; float* out; unsigned char* ws; };
typedef const Params __attribute__((address_space(4))) CParams;
__device__ __forceinline__ CParams* kparams() { CParams* p = (CParams*)__builtin_amdgcn_kernarg_segment_ptr(); asm volatile("" : "+s"(p)); return p; }
enum { I_X = 0, I_C, I_CTX, I_CCTX, I_WMOD, I_BMOD, I_NMIX, I_NFFN, I_WIN, I_HCW, I_HCB, I_HW1, I_HB1, I_HW2, I_HB2, I_HW3, I_HBIAS, I_PW, I_PS,
       I_SCW, I_SCB, I_SDTB, I_SALOG, I_SD, I_SNORM, I_WBR, I_WGATE, I_WOUT, I_RW, I_RB, I_WUP, I_BUP, I_WDN, I_BDN, I_NFIN };

__device__ __forceinline__ int tok_modj(int t) { return t < TL ? (t >> 12) : 8; }

struct TJob { const float* src; size_t ld_src; int K, N; bf16_t* dst; size_t ld_dst; int nmat; size_t src_ms, dst_ms; const float* kscale; };
__device__ __forceinline__ TJob make_tjob(CParams& P, int l, int j) {
    unsigned char* ws = P.ws; TJob J;
    bf16_t* W1T = (bf16_t*)(ws + WS_W1T) + (size_t)l * N1 * 1024;
    bf16_t* WBRT = (bf16_t*)(ws + WS_WBRT) + (size_t)l * 1024 * YCW;
    const float* wbr = P.in[I_WBR] + (size_t)l * 1280 * 1024;
    J.kscale = nullptr; J.nmat = 1; J.src_ms = 0; J.dst_ms = 0; J.ld_src = 1024; J.K = 1024; J.N = 1024; J.ld_dst = 1024;
    if (j == 0) { J.src = P.in[I_WGATE] + (size_t)l * 4 * 1024 * 1024; J.dst = W1T; J.nmat = 4; J.src_ms = (size_t)1024 * 1024; J.dst_ms = (size_t)1024 * 1024; }
    else if (j == 1) { J.src = P.in[I_WIN] + (size_t)l * 1024 * INW + 256; J.ld_src = INW; J.N = 2576; J.dst = W1T + (size_t)4096 * 1024; }
    else if (j == 2) { J.src = wbr; J.K = 256; J.dst = WBRT; J.ld_dst = YCW; }
    else if (j == 3) { J.src = wbr; J.K = 256; J.dst = WBRT + 256; J.ld_dst = YCW; }
    else if (j == 4) { J.src = wbr + (size_t)256 * 1024; J.K = 256; J.dst = WBRT + 512; J.ld_dst = YCW; }
    else if (j == 5) { J.src = wbr + (size_t)768 * 1024; J.K = 512; J.dst = WBRT + 1024; J.ld_dst = YCW; J.kscale = P.in[I_SNORM] + l * 512; }
    else if (j == 6) { J.src = P.in[I_WOUT] + (size_t)l * 1024 * 1024; J.dst = (bf16_t*)(ws + WS_WOUTT) + (size_t)l * 1024 * 1024; }
    else if (j == 7) { J.src = P.in[I_WUP] + (size_t)l * 32 * 1024 * 2048; J.ld_src = 2048; J.N = 2048; J.dst = (bf16_t*)(ws + WS_WUPT) + (size_t)l * 32 * 2048 * 1024; J.nmat = 32; J.src_ms = (size_t)1024 * 2048; J.dst_ms = (size_t)2048 * 1024; }
    else { J.src = P.in[I_WDN] + (size_t)l * 32 * 1024 * 1024; J.dst = (bf16_t*)(ws + WS_WDNT) + (size_t)l * 32 * 1024 * 1024; J.nmat = 32; J.src_ms = (size_t)1024 * 1024; J.dst_ms = (size_t)1024 * 1024; }
    return J;
}
constexpr int MOE_TILES_P0 = 640;
constexpr int TILES_DENSE = 256 + 176 + 16 + 16 + 16 + 32 + 64, TILES_PER_LAYER = TILES_DENSE + 4096 + 2048;
struct TRef { const float* sr; bf16_t* d; size_t ld_dst; int nval; float sc; };
__device__ __forceinline__ TRef tile_locate(CParams& P, int g, int tid) {
    constexpr int PER_L = 256 + 176 + 16 + 16 + 16 + 32 + 64 + 4096 + 2048;
    const int l = g / PER_L; int r = g % PER_L, j = 0;
    const int cnt[9] = {256, 176, 16, 16, 16, 32, 64, 4096, 2048};
#pragma unroll
    for (int q = 0; q < 8; ++q) { if (j == q && r >= cnt[q]) { r -= cnt[q]; j = q + 1; } }
    const TJob J = make_tjob(P, l, j);
    const int ktiles = J.K / 64, ntiles = (J.N + 255) / 256, per = ktiles * ntiles;
    const int mat = r / per, rr = r % per, nt = rr / ktiles, kt = rr % ktiles;
    TRef T; const int row = tid >> 3;
    T.sr = J.src + (size_t)mat * J.src_ms + (size_t)(kt * 64 + row) * J.ld_src + nt * 256;
    T.d = J.dst + (size_t)mat * J.dst_ms + (size_t)(nt * 256) * J.ld_dst + kt * 64; T.ld_dst = J.ld_dst;
    T.nval = (J.N - nt * 256) < 256 ? (J.N - nt * 256) : 256;
    T.sc = J.kscale ? J.kscale[kt * 64 + row] : 1.f;
    return T;
}
__device__ __forceinline__ void p0_transposes(CParams& P, unsigned char* smem, int lo, int hi, int part, int nparts) {
    float* tile = (float*)smem;
    const int tid = otid(); const int G = nparts, TOTAL = hi;
    const int row = tid >> 3, c0 = (tid & 7) * 4;
    int g = lo + part; bool have = g < TOTAL;
    TRef T = tile_locate(P, have ? g : lo, tid);
    f32x4 v[8];
#pragma unroll
    for (int j = 0; j < 8; ++j) { const int c = c0 + 32 * j; v[j] = (have && c < T.nval) ? *(const f32x4*)(T.sr + c) : (f32x4){0.f, 0.f, 0.f, 0.f}; }
#pragma unroll 1
    while (have) {
        const int gn = g + G; const bool hasn = gn < TOTAL;
        __syncthreads();
#pragma unroll
        for (int j = 0; j < 8; ++j) { float* tp = tile + row * 257 + c0 + 32 * j; tp[0] = v[j][0] * T.sc; tp[1] = v[j][1] * T.sc; tp[2] = v[j][2] * T.sc; tp[3] = v[j][3] * T.sc; }
        bf16_t* d = T.d; const size_t ldd = T.ld_dst; const int nval = T.nval;
        if (hasn) { T = tile_locate(P, gn, tid);
#pragma unroll
            for (int j = 0; j < 8; ++j) { const int c = c0 + 32 * j; v[j] = (c < T.nval) ? *(const f32x4*)(T.sr + c) : (f32x4){0.f, 0.f, 0.f, 0.f}; } }
        __syncthreads();
        { const int n = tid >> 1, kh = (tid & 1) * 32;
          if (n < nval) {
#pragma unroll
              for (int q = 0; q < 4; ++q) { u32x4 o;
#pragma unroll
                  for (int e = 0; e < 4; ++e) o[e] = cvt_pk_bf16(tile[(kh + q * 8 + 2 * e) * 257 + n], tile[(kh + q * 8 + 2 * e + 1) * 257 + n]);
                  *(u32x4*)(d + (size_t)n * ldd + kh + q * 8) = o; } } }
        g = gn; have = hasn;
    }
    __syncthreads();
}

__device__ __forceinline__ void p0_prep(CParams& P, unsigned char* smem) {
    const int G = gridDim.x, tid = otid(), bid = obid();
    unsigned char* ws = P.ws;
    for (int l = 0; l < NL; ++l) p0_transposes(P, smem, l * TILES_PER_LAYER, l * TILES_PER_LAYER + TILES_DENSE + MOE_TILES_P0, bid, G);
    {
        float* wt = (float*)smem;
        float* ctab = wt + 64 * 65; float* stab = ctab + 64;
        if (tid < 64) { float s, c; sincospif((float)tid / 32.f, &s, &c); ctab[tid] = c * 0.125f; stab[tid] = s * 0.125f; }
        for (int it = bid; it < NL * 4 * 16; it += G) {
            const int l = it / 64, g = (it / 16) & 3, kb = it & 15;
            __syncthreads();
            { const int row = tid >> 3, c0 = (tid & 7) * 8; const float* sr = P.in[I_WIN] + ((size_t)l * 1024 + kb * 64 + row) * INW + g * 64 + c0;
#pragma unroll
              for (int j = 0; j < 8; ++j) wt[row * 65 + c0 + j] = sr[j]; }
            __syncthreads();
            const int rp = tid >> 2, kq = tid & 3, half = rp >> 6, cp = rp & 63;
            const float* tab = half ? stab : ctab;
            float o[16];
#pragma unroll
            for (int kk = 0; kk < 16; ++kk) o[kk] = 0.f;
            for (int c = 0; c < 64; ++c) { const float tv = tab[(c * cp) & 63];
#pragma unroll
                for (int kk = 0; kk < 16; ++kk) o[kk] += wt[(kq * 16 + kk) * 65 + c] * tv; }
            bf16_t* d = (bf16_t*)(ws + WS_WFT) + ((size_t)l * 512 + (g * 2 + half) * 64 + cp) * 1024 + kb * 64 + kq * 16;
            u32x4 o0, o1;
#pragma unroll
            for (int e = 0; e < 4; ++e) { o0[e] = cvt_pk_bf16(o[2 * e], o[2 * e + 1]); o1[e] = cvt_pk_bf16(o[8 + 2 * e], o[8 + 2 * e + 1]); }
            *(u32x4*)d = o0; *(u32x4*)(d + 8) = o1;
        }
        __syncthreads();
    }
    {
        float* pw = (float*)smem;
        float* wb = pw + 64 * 65;
        for (int it = bid; it < NL * 4 * 4; it += G) {
            const int l = it / 16, g = (it / 4) & 3, nb = it & 3;
            __syncthreads();
            for (int e = tid; e < 4096; e += NTH) { const int c = e >> 6, d = e & 63;
                pw[c * 65 + d] = P.in[I_PW][(((size_t)l * 4 + g) * 64 + c) * 64 + d] * P.in[I_PS][l * 256 + g * 64 + d]; }
            for (int e = tid; e < 64 * 256; e += NTH) { const int d = e >> 8, n = e & 255;
                wb[d * 257 + n] = P.in[I_WBR][((size_t)l * 1280 + 512 + g * 64 + d) * 1024 + nb * 256 + n]; }
            __syncthreads();
            const int n = tid & 255, ch = tid >> 8;
            bf16_t* d0 = (bf16_t*)(ws + WS_WBRT) + ((size_t)l * 1024 + nb * 256 + n) * YCW + 768 + g * 64 + ch * 32;
            float o[32];
#pragma unroll
            for (int e = 0; e < 32; ++e) o[e] = 0.f;
#pragma unroll 1
            for (int d = 0; d < 64; ++d) { const float wv = wb[d * 257 + n];
#pragma unroll
                for (int e = 0; e < 32; ++e) o[e] += pw[(ch * 32 + e) * 65 + d] * wv; }
#pragma unroll
            for (int q = 0; q < 4; ++q) { u32x4 ov;
#pragma unroll
                for (int e = 0; e < 4; ++e) ov[e] = cvt_pk_bf16(o[q * 8 + 2 * e], o[q * 8 + 2 * e + 1]);
                *(u32x4*)(d0 + q * 8) = ov; }
        }
        __syncthreads();
    }
    {
        bf16_t* D4C = (bf16_t*)(ws + WS_D4C); bf16_t* D4S = (bf16_t*)(ws + WS_D4S); bf16_t* D256 = (bf16_t*)(ws + WS_D256);
        const int gth = bid * NTH + tid, nth = G * NTH;
        for (int ch = gth; ch < 2048 * 512; ch += nth) {
            const int pp = ch >> 9, p0 = (ch & 511) * 8;
            u32x4 oc, os; float cv[8], sv[8];
#pragma unroll
            for (int e = 0; e < 8; ++e) { const int j = (pp * (p0 + e)) & 4095; float s, c; sincospif((float)j / 2048.f, &s, &c); cv[e] = c * (1.f / 64.f); sv[e] = -s * (1.f / 64.f); }
#pragma unroll
            for (int e = 0; e < 4; ++e) { oc[e] = cvt_pk_bf16(cv[2 * e], cv[2 * e + 1]); os[e] = cvt_pk_bf16(sv[2 * e], sv[2 * e + 1]); }
            *(u32x4*)(D4C + (size_t)pp * 4096 + p0) = oc; *(u32x4*)(D4S + (size_t)pp * 4096 + p0) = os;
        }
        for (int ch = gth; ch < 256 * 64; ch += nth) {
            const int pp = ch >> 6, k0 = (ch & 63) * 8; u32x4 o; float v[8];
#pragma unroll
            for (int e = 0; e < 8; ++e) { const int k = k0 + e; const int j = (pp * (k & 255)) & 255; float s, c; sincospif((float)j / 128.f, &s, &c); v[e] = (k < 256 ? c : -s) * (1.f / 16.f); }
#pragma unroll
            for (int e = 0; e < 4; ++e) o[e] = cvt_pk_bf16(v[2 * e], v[2 * e + 1]);
            *(u32x4*)(D256 + (size_t)pp * 4096 + k0) = o;
        }
    }
    {
        float* feats = (float*)smem;
        float* h1 = feats + 64 * 33;
        float* h2 = h1 + 64 * 65;
        const float dmin = 4.605170185988091f / 1.5f, dmax = 4.605170185988091f / 0.3f;
        for (int it = bid; it < NL * 68; it += G) {
            const int l = it / 68, r = it % 68, cfg = r < 64 ? 0 : 1, tile = cfg ? r - 64 : r, n = cfg ? 256 : 4096;
            __syncthreads();
            for (int e = tid; e < 64 * 33; e += NTH) { const int i = e / 33, f = e % 33; const int pos = tile * 64 + i;
                float v;
                if (f == 0) v = (float)pos / (float)(n - 1);
                else { const int j = (f - 1) & 15; const float fr = 1e-4f + (float)j * ((15.f - 1e-4f) / 15.f);
                       const float ang = 6.283185307179586f * (float)pos / (float)n * fr; v = (f <= 16) ? cosf(ang) : -sinf(ang); }
                feats[e] = v; }
            __syncthreads();
            { const int j = tid & 63, pg = tid >> 6; const float* w1 = P.in[I_HW1] + (size_t)l * 33 * 64; const float b = P.in[I_HB1][l * 64 + j];
              for (int q = 0; q < 8; ++q) { const int i = pg * 8 + q; float s = b; for (int f = 0; f < 33; ++f) s += feats[i * 33 + f] * w1[f * 64 + j]; h1[i * 65 + j] = sinf(s); } }
            __syncthreads();
            { const int j = tid & 63, pg = tid >> 6; const float* w2 = P.in[I_HW2] + (size_t)l * 64 * 64; const float b = P.in[I_HB2][l * 64 + j];
              for (int q = 0; q < 8; ++q) { const int i = pg * 8 + q; float s = b; for (int f = 0; f < 64; ++f) s += h1[i * 65 + f] * w2[f * 64 + j]; h2[i * 65 + j] = sinf(s); } }
            __syncthreads();
            { const int o = tid, c = o & 255, dir = o >> 8; const float* w3 = P.in[I_HW3] + (size_t)l * 64 * 512;
              float w[64];
#pragma unroll
              for (int f = 0; f < 64; ++f) w[f] = w3[f * 512 + o];
              const float delta = dmin + (float)c * ((dmax - dmin) / 255.f);
              float* kst = h2 + 64 * 65;
              float* kt = (float*)(ws + WS_KRAW) + ((size_t)l * 2 + cfg) * 512 * 4096 + tile * 64;
              float asum = 0.f;
#pragma unroll 1
              for (int i0 = 0; i0 < 64; i0 += 16) {
#pragma unroll 1
                  for (int ii = 0; ii < 16; ++ii) { const int i = i0 + ii; float s = 0.f;
#pragma unroll
                      for (int f = 0; f < 64; ++f) s += h2[i * 65 + f] * w[f];
                      const int pos = tile * 64 + i; const float tt = (float)pos / (float)(n - 1);
                      s *= expf(-tt * delta);
                      kst[o * 17 + ii] = s;
                      if (!(dir == 1 && pos == 0)) asum += fabsf(s); }
                  __syncthreads();
#pragma unroll
                  for (int q = 0; q < 4; ++q) { const int ch = tid + q * NTH, oo = ch >> 2, j = (ch & 3) * 4; const float* sp = kst + oo * 17 + j;
                      *(f32x4*)(kt + (size_t)oo * 4096 + i0 + j) = (f32x4){sp[0], sp[1], sp[2], sp[3]}; }
                  __syncthreads();
              }
              ((float*)(ws + WS_KPART))[(((size_t)l * 2 + cfg) * 64 + tile) * 512 + o] = asum; }
        }
        __syncthreads();
    }
    for (int e = bid * NTH + tid; e < NL * 32 * 1024; e += G * NTH) { const int l = e >> 15, ex = (e >> 10) & 31, k = e & 1023;
        const float wv = P.in[I_RW][((size_t)l * 1024 + k) * 32 + ex]; const bf16_t hi = f2bf(wv); const bf16_t lo = f2bf(wv - bf2f(hi));
        bf16_t* d = (bf16_t*)(ws + WS_WRT) + (size_t)l * 2 * 32 * 1024 + (size_t)ex * 1024 + k; d[0] = hi; d[32 * 1024] = lo; }
    {
        float* sc = (float*)smem;
        float* red = sc + 9 * 1024;
        for (int it = bid; it < NL * 24; it += G) {
            const int l = it / 24, nb = it % 24;
            __syncthreads();
            for (int e = tid; e < 9 * 1024; e += NTH) { const int j = e >> 10, k = e & 1023; const float v = j < 8 ? P.in[I_C][j * 1024 + k] : P.in[I_CCTX][k]; sc[e] = fsilu(v); }
            __syncthreads();
            const int n = nb * 256 + (tid & 255), kh = tid >> 8;
            const float* w = P.in[I_WMOD] + (size_t)l * 1024 * 6144 + n;
            float a[9];
#pragma unroll
            for (int j = 0; j < 9; ++j) a[j] = 0.f;
#pragma unroll 8
            for (int k = kh * 512; k < kh * 512 + 512; ++k) { const float wv = w[(size_t)k * 6144];
#pragma unroll
                for (int j = 0; j < 9; ++j) a[j] += sc[j * 1024 + k] * wv; }
            if (kh == 1) {
#pragma unroll
                for (int j = 0; j < 9; ++j) red[(tid & 255) * 9 + j] = a[j]; }
            __syncthreads();
            if (kh == 0) { const float b = P.in[I_BMOD][l * 6144 + n];
#pragma unroll
                for (int j = 0; j < 9; ++j) ((float*)(ws + WS_MOD))[((size_t)l * 9 + j) * 6144 + n] = a[j] + red[(tid & 255) * 9 + j] + b; }
        }
        __syncthreads();
    }
}

__device__ __forceinline__ void norm_row_store(const f32x4 (&v)[4], const float* gain, const float* sc, const float* sh, bf16_t* dst, int lane) {
    float ss = 0.f;
#pragma unroll
    for (int q = 0; q < 4; ++q) ss += v[q][0] * v[q][0] + v[q][1] * v[q][1] + v[q][2] * v[q][2] + v[q][3] * v[q][3];
    ss = wave_sum(ss);
    const float rs = rsqrtf(ss * (1.f / 1024.f) + EPSN);
#pragma unroll
    for (int q = 0; q < 4; ++q) { const int c = q * 256 + lane * 4;
        const f32x4 g = *(const f32x4*)(gain + c), a = *(const f32x4*)(sc + c), b = *(const f32x4*)(sh + c);
        u32x2 o; o[0] = cvt_pk_bf16(v[q][0] * rs * g[0] * (1.f + a[0]) + b[0], v[q][1] * rs * g[1] * (1.f + a[1]) + b[1]);
        o[1] = cvt_pk_bf16(v[q][2] * rs * g[2] * (1.f + a[2]) + b[2], v[q][3] * rs * g[3] * (1.f + a[3]) + b[3]);
        *(u32x2*)(dst + c) = o; }
}
__device__ __forceinline__ void p1_norm0(CParams& P) {
    const int tid_ = otid(), lane = tid_ & 63, w = (obid() * NTH + tid_) >> 6, nw = gridDim.x * (NTH / 64);
    bf16_t* H = (bf16_t*)(P.ws + WS_H); const float* MOD = (const float*)(P.ws + WS_MOD);
    for (int t = w; t < T; t += nw) {
        const float* src = t < TL ? P.in[I_X] + (size_t)t * 1024 : P.in[I_CTX] + (size_t)(t - TL) * 1024;
        f32x4 v[4];
#pragma unroll
        for (int q = 0; q < 4; ++q) v[q] = *(const f32x4*)(src + q * 256 + lane * 4);
        const float* md = MOD + (size_t)tok_modj(t) * 6144;
        norm_row_store(v, P.in[I_NMIX], md + 1024, md, H + (size_t)t * 1024, lane);
    }
}

#ifndef EXP_P3
#define EXP_P3 0
#endif
struct TileGeo { int tok0, b, pos0, slen, isctx; };
__device__ __forceinline__ TileGeo tile_geo(int tt) {
    TileGeo g; g.tok0 = tt * 64;
    if (g.tok0 < TL) { g.isctx = 0; g.b = g.tok0 >> 12; g.pos0 = g.tok0 & 4095; g.slen = 4096; }
    else { g.isctx = 1; const int r = g.tok0 - TL; g.b = r >> 8; g.pos0 = r & 255; g.slen = 256; }
    return g;
}
__device__ __forceinline__ void unpack4(u32x2 u, float (&o)[4]) { o[0] = bflo(u[0]); o[1] = bfhi(u[0]); o[2] = bflo(u[1]); o[3] = bfhi(u[1]); }
__device__ __forceinline__ void unpack8(u32x4 u, float (&o)[8]) {
#pragma unroll
    for (int e = 0; e < 4; ++e) { o[2 * e] = bflo(u[e]); o[2 * e + 1] = bfhi(u[e]); } }

__device__ __forceinline__ void p3_prep(CParams& P, unsigned char* smem, int l) {
    const int G = gridDim.x, tid = otid(), bid = obid();
    unsigned char* ws = P.ws;
    const bf16_t* PJ = (const bf16_t*)(ws + WS_PJ);
    if (!(EXP_P3 & 1)) {
        bf16_t* vvL = (bf16_t*)smem;
        const int c4 = tid & 63, tq = tid >> 6;
        const float* cw = P.in[I_HCW] + (size_t)l * 3 * 768; const float* cb = P.in[I_HCB] + (size_t)l * 768;
        float wx[3][4], wv[3][4], bx[4], bv[4];
#pragma unroll
        for (int e = 0; e < 4; ++e) { bx[e] = cb[256 + 4 * c4 + e]; bv[e] = cb[512 + 4 * c4 + e];
#pragma unroll
            for (int k = 0; k < 3; ++k) { wx[k][e] = cw[k * 768 + 256 + 4 * c4 + e]; wv[k][e] = cw[k * 768 + 512 + 4 * c4 + e]; } }
        u32x2 xq[10], vq[10]; bool okq[10];
#define P3A_REQ(ttx) do { const TileGeo g_ = tile_geo(ttx); const int p0_ = g_.pos0 + tq * 8; const bf16_t* rowp_ = PJ + (size_t)(g_.tok0 + tq * 8) * PJW; \
            _Pragma("unroll") for (int j = 0; j < 10; ++j) { const int pp = p0_ + j - 1; okq[j] = (pp >= 0 && pp < g_.slen); const bf16_t* rp = rowp_ + (ptrdiff_t)(okq[j] ? j - 1 : 0) * PJW; \
                xq[j] = *(const u32x2*)(rp + 256 + 4 * c4); vq[j] = *(const u32x2*)(rp + 512 + 4 * c4); } } while (0)
        int tt = bid;
        if (tt < T / 64) P3A_REQ(tt);
#pragma unroll 1
        for (; tt < T / 64; tt += G) {
            const TileGeo g = tile_geo(tt);
            float rx[3][4], rv[3][4], vva[8][4];
#define P3A_ROW(k, j) do { unpack4(xq[j], rx[k]); unpack4(vq[j], rv[k]); _Pragma("unroll") for (int e = 0; e < 4; ++e) { rx[k][e] = okq[j] ? rx[k][e] : 0.f; rv[k][e] = okq[j] ? rv[k][e] : 0.f; } } while (0)
            P3A_ROW(0, 0); P3A_ROW(1, 1);
#pragma unroll
            for (int j = 0; j < 8; ++j) {
                P3A_ROW(2, j + 2);
#pragma unroll
                for (int e = 0; e < 4; ++e) {
                    const float x2 = wx[0][e] * rx[0][e] + wx[1][e] * rx[1][e] + wx[2][e] * rx[2][e] + bx[e];
                    const float vv = wv[0][e] * rv[0][e] + wv[1][e] * rv[1][e] + wv[2][e] * rv[2][e] + bv[e];
                    vva[j][e] = x2 * vv;
                    rx[0][e] = rx[1][e]; rx[1][e] = rx[2][e]; rv[0][e] = rv[1][e]; rv[1][e] = rv[2][e]; }
            }
#undef P3A_ROW
#pragma unroll
            for (int e = 0; e < 4; ++e) { u32x4 o4;
#pragma unroll
                for (int p = 0; p < 4; ++p) o4[p] = cvt_pk_bf16(vva[2 * p][e], vva[2 * p + 1][e]);
                *(u32x4*)(vvL + (4 * c4 + e) * 72 + ((tq + (c4 & 7)) & 7) * 8) = o4; }
            if (tt + G < T / 64) P3A_REQ(tt + G);
            __syncthreads();
            { const int c = tid >> 1, hf = tid & 1;
              bf16_t* d = g.isctx ? (bf16_t*)(ws + WS_VVTC) + ((size_t)g.b * 256 + c) * 256 + g.pos0 + hf * 32
                                  : (bf16_t*)(ws + WS_VVT) + ((size_t)g.b * 256 + c) * 4096 + g.pos0 + hf * 32;
#pragma unroll
              for (int q = 0; q < 4; ++q) *(u32x4*)(d + q * 8) = *(const u32x4*)(vvL + c * 72 + (((hf * 4 + q) + ((c >> 2) & 7)) & 7) * 8); }
            __syncthreads();
        }
#undef P3A_REQ
    }
    if (!(EXP_P3 & 2)) {
        bf16_t* YC = (bf16_t*)(ws + WS_YC);
        const int c8 = tid & 31, ts = tid >> 5;
        const int gi = c8 >> 3, hw = 1 << gi;
        for (int tt = (bid + 85) % G; tt < T / 64; tt += G) {
            const TileGeo g = tile_geo(tt);
            const int rlen = g.isctx ? 256 : 64;
            const int tl0 = ts * 4, rpos0 = (g.pos0 + tl0) % rlen;
            const bf16_t* base = PJ + (size_t)(g.tok0 + tl0 - rpos0) * PJW + 768 + 8 * c8;
            float sm4[4][8], self[4][8];
#pragma unroll
            for (int q = 0; q < 4; ++q)
#pragma unroll
                for (int e = 0; e < 8; ++e) sm4[q][e] = 0.f;
            u32x4 rw[19];
#pragma unroll
            for (int dj = -8; dj < 11; ++dj) { int j = rpos0 + dj; j = j < 0 ? 0 : (j >= rlen ? rlen - 1 : j); rw[dj + 8] = *(const u32x4*)(base + (size_t)j * PJW); }
#pragma unroll
            for (int dj = -8; dj < 11; ++dj) {
                const int j = rpos0 + dj; const bool inrow = (j >= 0 && j < rlen);
                float v[8]; unpack8(rw[dj + 8], v);
#pragma unroll
                for (int q = 0; q < 4; ++q) {
                    const bool inw = inrow && dj >= q - hw && dj < q + hw;
#pragma unroll
                    for (int e = 0; e < 8; ++e) sm4[q][e] += inw ? v[e] : 0.f;
                    if (dj == q) {
#pragma unroll
                        for (int e = 0; e < 8; ++e) self[q][e] = v[e]; } }
            }
#pragma unroll
            for (int q = 0; q < 4; ++q) {
                const int rpos = rpos0 + q; int lo = rpos - hw; lo = lo < 0 ? 0 : lo; int hi = rpos + hw; hi = hi > rlen ? rlen : hi;
                const float inv = 1.f / (float)(hi - lo);
                u32x4 o;
#pragma unroll
                for (int e = 0; e < 4; ++e) o[e] = cvt_pk_bf16(sm4[q][2 * e] * inv - self[q][2 * e], sm4[q][2 * e + 1] * inv - self[q][2 * e + 1]);
                *(u32x4*)(YC + (size_t)(g.tok0 + tl0 + q) * YCW + 768 + 8 * c8) = o;
            }
        }
    }
    if (!(EXP_P3 & 4)) {
        bf16_t* xsL = (bf16_t*)smem;
        bf16_t* XBN = (bf16_t*)(ws + WS_XBN);
        const int c8 = tid & 127, tq = tid >> 7;
        const float* cw = P.in[I_SCW] + (size_t)l * 3 * 1024; const float* cb = P.in[I_SCB] + (size_t)l * 1024;
        float w[3][8], bb[8];
#pragma unroll
        for (int e = 0; e < 8; ++e) { bb[e] = cb[8 * c8 + e];
#pragma unroll
            for (int k = 0; k < 3; ++k) w[k][e] = cw[k * 1024 + 8 * c8 + e]; }
        u32x4 rw[18]; bool okr[18];
#define P3C_REQ(ttx) do { const TileGeo g_ = tile_geo(ttx); const int p0_ = g_.pos0 + tq * 16; const bf16_t* rowp_ = PJ + (size_t)(g_.tok0 + tq * 16) * PJW + 1536 + 8 * c8; \
            _Pragma("unroll") for (int j = 0; j < 18; ++j) { const int pp = p0_ + j - 1; okr[j] = (pp >= 0 && pp < g_.slen); rw[j] = *(const u32x4*)(rowp_ + (ptrdiff_t)(okr[j] ? j - 1 : 0) * PJW); } } while (0)
        int tt = (bid + 170) % G;
        if (tt < T / 64) P3C_REQ(tt);
#pragma unroll 1
        for (; tt < T / 64; tt += G) {
            const TileGeo g = tile_geo(tt);
            float r0[8], r1[8], r2[8]; u32x4 oall[16];
            unpack8(rw[0], r0); unpack8(rw[1], r1);
#pragma unroll
            for (int e = 0; e < 8; ++e) { r0[e] = okr[0] ? r0[e] : 0.f; r1[e] = okr[1] ? r1[e] : 0.f; }
#pragma unroll
            for (int j = 0; j < 16; ++j) {
                unpack8(rw[j + 2], r2);
#pragma unroll
                for (int e = 0; e < 8; ++e) r2[e] = okr[j + 2] ? r2[e] : 0.f;
                float o[8];
#pragma unroll
                for (int e = 0; e < 8; ++e) { o[e] = fsilu(w[0][e] * r0[e] + w[1][e] * r1[e] + w[2][e] * r2[e] + bb[e]); r0[e] = r1[e]; r1[e] = r2[e]; }
                u32x4 ov;
#pragma unroll
                for (int e = 0; e < 4; ++e) ov[e] = cvt_pk_bf16(o[2 * e], o[2 * e + 1]);
                *(u32x4*)(XBN + (size_t)(g.tok0 + tq * 16 + j) * 1024 + 8 * c8) = ov;
                oall[j] = ov;
            }
            if (c8 < 96) {
#pragma unroll
                for (int e = 0; e < 8; ++e) { u32x4 lo4, hi4;
#pragma unroll
                    for (int p = 0; p < 4; ++p) {
                        lo4[p] = __builtin_amdgcn_perm(oall[2 * p + 1][e >> 1], oall[2 * p][e >> 1], (e & 1) ? 0x07060302u : 0x05040100u);
                        hi4[p] = __builtin_amdgcn_perm(oall[2 * p + 9][e >> 1], oall[2 * p + 8][e >> 1], (e & 1) ? 0x07060302u : 0x05040100u); }
                    bf16_t* rowb = xsL + (8 * c8 + e) * 72; const int rot = c8 & 7;
                    *(u32x4*)(rowb + (((tq * 2) + rot) & 7) * 8) = lo4; *(u32x4*)(rowb + (((tq * 2 + 1) + rot) & 7) * 8) = hi4; }
            }
            if (tt + G < T / 64) P3C_REQ(tt + G);
            __syncthreads();
            for (int ch = tid; ch < 768 * 8; ch += NTH) { const int c = ch >> 3, q = ch & 7;
                bf16_t* d = g.isctx ? (bf16_t*)(ws + WS_XSTC) + ((size_t)g.b * 768 + c) * 256 + g.pos0 + q * 8
                                    : (bf16_t*)(ws + WS_XST) + ((size_t)g.b * 768 + c) * 4096 + g.pos0 + q * 8;
                *(u32x4*)d = *(const u32x4*)(xsL + c * 72 + ((q + ((c >> 3) & 7)) & 7) * 8); }
            __syncthreads();
        }
#undef P3C_REQ
        const float* dtr = (const float*)(ws + WS_DTR); float* dt = (float*)(ws + WS_DT);
        for (int e = bid * NTH + tid; e < T * 16; e += G * NTH) dt[e] = fsoftplus(dtr[e] + P.in[I_SDTB][l * 16 + (e & 15)]);
    }
}

#define EPI_ROWS_BEGIN _Pragma("unroll") for (int ai = 0; ai < 2; ++ai) { _Pragma("unroll") for (int m = 0; m < 4; ++m) { const int rl = ai * 128 + wr * 64 + m * 16 + fr;
#define EPI_ROWS_END } }
#ifndef EXP_BR
#define EXP_BR 0
#endif
typedef f32x4 acc_t[2][2][4][2];
__device__ __forceinline__ u32x4 pack8(const f32x4& a, const f32x4& b) { u32x4 o; o[0] = cvt_pk_bf16(a[0], a[1]); o[1] = cvt_pk_bf16(a[2], a[3]); o[2] = cvt_pk_bf16(b[0], b[1]); o[3] = cvt_pk_bf16(b[2], b[3]); return o; }

struct Src1 {
    const char* H; const char* W1T; const char* WFT; int G, c;
    __device__ __forceinline__ bool get(int i, GUnit& u) const {
        const int L = i * G + c; constexpr int NU1 = (T / 256) * (N1 / 256);
        if (L < NU1) { int pm, pn; pg8::remap_tile(L, T / 256, N1 / 256, pm, pn);
            u.a0 = H + (size_t)pm * 256 * 2048; u.a1 = u.a0 + (size_t)128 * 2048; u.b0 = W1T + (size_t)pn * 256 * 2048; u.b1 = u.b0 + (size_t)128 * 2048;
            u.nt = 16; u.pm = pm; u.pn = pn; u.kind = pn < 16 ? 0 : (pn < 26 ? 1 : 2); u.gidx = nullptr; u.e = 0; return true; }
        const int j = L - NU1; if (j >= 2 * (T / 256)) return false;
        const int pm = j & 1, pn = j >> 1;
        u.a0 = WFT + (size_t)pm * 256 * 2048; u.a1 = u.a0 + (size_t)128 * 2048; u.b0 = H + (size_t)pn * 256 * 2048; u.b1 = u.b0 + (size_t)128 * 2048;
        u.nt = 16; u.pm = pm; u.pn = pn; u.kind = 3; u.gidx = nullptr; u.e = 0; return true;
    }
};
struct Epi1 {
    bf16_t* Gt; bf16_t* PJ; float* DTR; bf16_t* VT; bf16_t* VTC;
    __device__ __forceinline__ void operator()(const acc_t& acc, const GUnit& u, int wr, int wc, int fr, int fq) const {
        const int cl = wc * 32 + 8 * fq;
        if (u.kind == 0) {
            EPI_ROWS_BEGIN { bf16_t* rp = Gt + (size_t)(u.pm * 256 + rl) * 4096 + u.pn * 256 + cl;
#pragma unroll
                for (int bj = 0; bj < 2; ++bj) { f32x4 a = acc[ai][bj][m][0], b = acc[ai][bj][m][1];
#pragma unroll
                    for (int e = 0; e < 4; ++e) { a[e] = fsigmoid(a[e]); b[e] = fsigmoid(b[e]); }
                    *(u32x4*)(rp + bj * 128) = pack8(a, b); } } EPI_ROWS_END
        } else if (u.kind == 1) {
            EPI_ROWS_BEGIN { bf16_t* rp = PJ + (size_t)(u.pm * 256 + rl) * PJW + (u.pn - 16) * 256 + cl;
#pragma unroll
                for (int bj = 0; bj < 2; ++bj) *(u32x4*)(rp + bj * 128) = pack8(acc[ai][bj][m][0], acc[ai][bj][m][1]); } EPI_ROWS_END
        } else if (u.kind == 2) {
            if (wc == 0 && fq < 2) {
                EPI_ROWS_BEGIN { float* rp = DTR + (size_t)(u.pm * 256 + rl) * 16 + 8 * fq; *(f32x4*)rp = acc[ai][0][m][0]; *(f32x4*)(rp + 4) = acc[ai][0][m][1]; } EPI_ROWS_END
            }
        } else {
#pragma unroll
            for (int bj = 0; bj < 2; ++bj) {
                const int tok = u.pn * 256 + bj * 128 + cl;
                bf16_t* cb;
                if (tok < TL) { const int b = tok >> 12, p = tok & 4095; cb = VT + ((size_t)b * 256) * 8192 + p; }
                else { const int r = tok - TL, b = r >> 8, q = r & 255; cb = VTC + ((size_t)b * 256) * 8192 + q; }
                const int hoff = tok < TL ? 4096 : 256;
                EPI_ROWS_BEGIN { const int r = u.pm * 256 + rl, g = r >> 7, half = (r >> 6) & 1, cp = r & 63;
                    *(u32x4*)(cb + (size_t)(g * 64 + cp) * 8192 + half * hoff) = pack8(acc[ai][bj][m][0], acc[ai][bj][m][1]); } EPI_ROWS_END
            }
        }
    }
};

struct SrcDft {
    const char* D4C; const char* D4S; const char* D256; const char* VT; const char* VTC; int first, step;
    __device__ __forceinline__ bool get(int i, GUnit& u) const {
        const int L = first + i * step; u.gidx = nullptr; u.e = 0;
        if (L < 0 || L >= 136) return false;
        if (L < 128) { const int sc = L >> 6, r = L & 63, pm = r & 7, pn = r >> 3;
            u.a0 = (sc ? D4S : D4C) + (size_t)pm * 256 * 8192; u.a1 = u.a0 + (size_t)128 * 8192;
            u.b0 = VT + (size_t)pn * 256 * 16384 + (size_t)sc * 8192; u.b1 = u.b0 + (size_t)128 * 16384;
            u.nt = 64; u.pm = pm; u.pn = pn; u.kind = sc; return true; }
        const int pn = L - 128;
        u.a0 = D256; u.a1 = u.a0 + (size_t)128 * 8192; u.b0 = VTC + (size_t)pn * 256 * 16384; u.b1 = u.b0 + (size_t)128 * 16384;
        u.nt = 8; u.pm = 0; u.pn = pn; u.kind = 2; return true;
    }
};
struct EpiDft {
    bf16_t* YC;
    __device__ __forceinline__ void operator()(const acc_t& acc, const GUnit& u, int wr, int wc, int fr, int fq) const {
        const int cl = wc * 32 + 8 * fq;
        if (u.kind == 2) {
            EPI_ROWS_BEGIN { bf16_t* rp = YC + (size_t)(TL + u.pn * 256 + rl) * YCW + cl;
#pragma unroll
                for (int bj = 0; bj < 2; ++bj) { const u32x4 o = pack8(acc[ai][bj][m][0] * 0.5f, acc[ai][bj][m][1] * 0.5f); *(u32x4*)(rp + bj * 128) = o; *(u32x4*)(rp + 256 + bj * 128) = o; } } EPI_ROWS_END
        } else {
            const int coff = u.kind == 1 ? 256 : 0; const float msign = u.kind == 1 ? -1.f : 1.f;
            EPI_ROWS_BEGIN { const int pp = u.pm * 256 + rl;
                bf16_t* rp = YC + (size_t)(u.pn * 4096 + pp) * YCW + coff + cl;
                bf16_t* rm = YC + (size_t)(u.pn * 4096 + ((4096 - pp) & 4095)) * YCW + coff + cl;
#pragma unroll
                for (int bj = 0; bj < 2; ++bj) { *(u32x4*)(rp + bj * 128) = pack8(acc[ai][bj][m][0], acc[ai][bj][m][1]);
                    if (pp != 0) *(u32x4*)(rm + bj * 128) = pack8(acc[ai][bj][m][0] * msign, acc[ai][bj][m][1] * msign); } } EPI_ROWS_END
        }
    }
};
__device__ __forceinline__ void dft_nyquist(const bf16_t* VT, bf16_t* YC, int row0, int nrows) {
    const int tid = otid(), lane = tid & 63, w = tid >> 6;
    for (int vr = row0 + w; vr < row0 + nrows && vr < 2048; vr += NTH / 64) {
        const bf16_t* src = VT + (size_t)vr * 8192;
        float s = 0.f;
#pragma unroll
        for (int q = 0; q < 8; ++q) { float v[8]; unpack8(*(const u32x4*)(src + q * 512 + lane * 8), v);
            s += (v[0] - v[1]) + (v[2] - v[3]) + (v[4] - v[5]) + (v[6] - v[7]); }
        s = wave_sum(s) * (1.f / 64.f);
        if (lane == 0) { const int b = vr >> 8, gc = vr & 255; bf16_t* d = YC + (size_t)(b * 4096 + 2048) * YCW + gc; d[0] = f2bf(s); d[256] = (bf16_t)0; }
    }
}

struct SrcBr {
    const char* YC; const char* WBRT; int G, c, nM;
    __device__ __forceinline__ bool get(int i, GUnit& u) const {
        const int k = i & 3, L = (i >> 2) * G + c; if (L >= nM * 4) return false;
        int pm, pn; pg8::remap_tile(L, nM, 4, pm, pn);
        const int koff = k == 0 ? 0 : (k == 1 ? 512 : (k == 2 ? 768 : 1024));
        u.a0 = YC + ((size_t)pm * 256 * YCW + koff) * 2; u.a1 = u.a0 + (size_t)128 * YCW * 2;
        u.b0 = WBRT + ((size_t)pn * 256 * YCW + koff) * 2; u.b1 = u.b0 + (size_t)128 * YCW * 2;
        u.nt = (k == 0 || k == 3) ? 8 : 4; u.pm = pm; u.pn = pn; u.kind = k; u.gidx = nullptr; u.e = 0; return true;
    }
};
struct EpiBr {
    const bf16_t* Gt; bf16_t* MG; const float* SSQ;
    __device__ __forceinline__ void operator()(const acc_t& acc, const GUnit& u, int wr, int wc, int fr, int fq) const {
        if (EXP_BR >= 2) return;
        const int cl = wc * 32 + 8 * fq, k = u.kind;
        const size_t row0 = (size_t)u.pm * 256 + wr * 64 + fr;
        const int colb = u.pn * 256 + cl;
        float rs[8];
#pragma unroll
        for (int i = 0; i < 8; ++i) rs[i] = 1.f;
        if (k == 3) {
            f32x4 s0[8], s1[8];
#pragma unroll
            for (int i = 0; i < 8; ++i) { const size_t row = row0 + (i >> 2) * 128 + (i & 3) * 16; s0[i] = *(const f32x4*)(SSQ + row * 8); s1[i] = *(const f32x4*)(SSQ + row * 8 + 4); }
#pragma unroll
            for (int i = 0; i < 8; ++i) rs[i] = rsqrtf((s0[i][0] + s0[i][1] + s0[i][2] + s0[i][3] + s1[i][0] + s1[i][1] + s1[i][2] + s1[i][3]) * (1.f / 512.f) + EPSN);
        }
#pragma unroll
        for (int ai = 0; ai < 2; ++ai) {
            u32x4 gv[4][2], mv[4][2];
#pragma unroll
            for (int m = 0; m < 4; ++m)
#pragma unroll
                for (int bj = 0; bj < 2; ++bj) { const size_t row = row0 + ai * 128 + m * 16;
                    gv[m][bj] = EXP_BR >= 1 ? (u32x4){0x3f803f80u, 0x3f803f80u, 0x3f803f80u, 0x3f803f80u} : *(const u32x4*)(Gt + row * 4096 + k * 1024 + colb + bj * 128);
                    mv[m][bj] = (k == 0 || EXP_BR >= 1) ? (u32x4){0u, 0u, 0u, 0u} : *(const u32x4*)(MG + row * 1024 + colb + bj * 128); }
#pragma unroll
            for (int m = 0; m < 4; ++m)
#pragma unroll
                for (int bj = 0; bj < 2; ++bj) { const size_t row = row0 + ai * 128 + m * 16;
                    float gt[8], mg[8]; unpack8(gv[m][bj], gt); unpack8(mv[m][bj], mg);
                    f32x4 a = acc[ai][bj][m][0], b = acc[ai][bj][m][1]; const float r = rs[ai * 4 + m];
#pragma unroll
                    for (int e = 0; e < 4; ++e) { a[e] = mg[e] + gt[e] * a[e] * r; b[e] = mg[4 + e] + gt[4 + e] * b[e] * r; }
                    *(u32x4*)(MG + row * 1024 + colb + bj * 128) = pack8(a, b); }
        }
    }
};

struct SrcOut {
    const char* MG; const char* WOUTT; int G, c, nM;
    __device__ __forceinline__ bool get(int i, GUnit& u) const {
        const int L = i * G + c; if (L >= nM * 4) return false;
        int pm, pn; pg8::remap_tile(L, nM, 4, pm, pn);
        u.a0 = MG + (size_t)pm * 256 * 2048; u.a1 = u.a0 + (size_t)128 * 2048; u.b0 = WOUTT + (size_t)pn * 256 * 2048; u.b1 = u.b0 + (size_t)128 * 2048;
        u.nt = 16; u.pm = pm; u.pn = pn; u.kind = 0; u.gidx = nullptr; u.e = 0; return true;
    }
};
template <bool F32IN> struct EpiOut {
    const void* xlat; const void* xctx; bf16_t* X1; const float* MODL;
    __device__ __forceinline__ void operator()(const acc_t& acc, const GUnit& u, int wr, int wc, int fr, int fq) const {
        const int cl = wc * 32 + 8 * fq;
        const int mj = u.pm < TL / 256 ? (u.pm >> 4) : 8;
        const size_t xoff = u.pm < TL / 256 ? (size_t)u.pm * 256 * 1024 : (size_t)(u.pm - TL / 256) * 256 * 1024;
        const void* xb = u.pm < TL / 256 ? xlat : xctx;
        const float* g1 = MODL + (size_t)mj * 6144 + 2048 + u.pn * 256 + cl;
        f32x4 gv[2][2];
#pragma unroll
        for (int bj = 0; bj < 2; ++bj) { gv[bj][0] = *(const f32x4*)(g1 + bj * 128); gv[bj][1] = *(const f32x4*)(g1 + bj * 128 + 4); }
#pragma unroll
        for (int ai = 0; ai < 2; ++ai) {
            f32x4 xv[4][2][2];
#pragma unroll
            for (int m = 0; m < 4; ++m)
#pragma unroll
                for (int bj = 0; bj < 2; ++bj) { const size_t o = xoff + (size_t)(ai * 128 + wr * 64 + m * 16 + fr) * 1024 + u.pn * 256 + cl + bj * 128;
                    if constexpr (F32IN) { const float* xr = (const float*)xb + o; xv[m][bj][0] = *(const f32x4*)xr; xv[m][bj][1] = *(const f32x4*)(xr + 4); }
                    else { float t[8]; unpack8(*(const u32x4*)((const bf16_t*)xb + o), t); xv[m][bj][0] = (f32x4){t[0], t[1], t[2], t[3]}; xv[m][bj][1] = (f32x4){t[4], t[5], t[6], t[7]}; } }
#pragma unroll
            for (int m = 0; m < 4; ++m)
#pragma unroll
                for (int bj = 0; bj < 2; ++bj) { bf16_t* orow = X1 + ((size_t)u.pm * 256 + ai * 128 + wr * 64 + m * 16 + fr) * 1024 + u.pn * 256 + cl + bj * 128;
                    *(u32x4*)orow = pack8(xv[m][bj][0] + gv[bj][0] * acc[ai][bj][m][0], xv[m][bj][1] + gv[bj][1] * acc[ai][bj][m][1]); }
        }
    }
};

struct SrcUp {
    const char* H2; const char* WUPT; const int* rtok; const int* meta; int G, c;
    __device__ __forceinline__ bool get(int i, GUnit& u) const {
        const int nu = meta[33]; int ru, j;
        if (G == 256) {
            const int x = c & 7, y = c >> 3; ru = i * 32 + (x >> 1) * 8 + (y & 7); j = (x & 1) * 4 + (y >> 3);
            if (i * 32 >= nu) return false;
            if (ru >= nu) { ru = nu - 1; j = -1; }
        } else { const int L = i * G + c; if (L >= nu * 8) return false; ru = L >> 3; j = L & 7; }
        if (j < 0) return false;
        int e = 0;
#pragma unroll
        for (int s = 16; s > 0; s >>= 1) if (meta[e + s] <= ru) e += s;
        u.a0 = H2; u.a1 = H2; u.gidx = rtok + (size_t)ru * 256;
        u.b0 = WUPT + ((size_t)e * 2048 + j * 128) * 2048; u.b1 = u.b0 + (size_t)1024 * 2048;
        u.nt = 16; u.pm = ru; u.pn = j; u.kind = 0; u.e = e; return true;
    }
};
struct EpiUp {
    bf16_t* ACT; const float* BUP;
    __device__ __forceinline__ void operator()(const acc_t& acc, const GUnit& u, int wr, int wc, int fr, int fq) const {
        const int cl = wc * 32 + 8 * fq, col = u.pn * 128 + cl;
        const float* bp = BUP + (size_t)u.e * 2048 + col;
        const f32x4 bg0 = *(const f32x4*)bp, bg1 = *(const f32x4*)(bp + 4), bl0 = *(const f32x4*)(bp + 1024), bl1 = *(const f32x4*)(bp + 1028);
        EPI_ROWS_BEGIN { f32x4 g0 = acc[ai][0][m][0] + bg0, g1 = acc[ai][0][m][1] + bg1, l0 = acc[ai][1][m][0] + bl0, l1 = acc[ai][1][m][1] + bl1;
#pragma unroll
            for (int e = 0; e < 4; ++e) {
                float a = fminf(g0[e], 7.f), b = fminf(fmaxf(l0[e], -7.f), 7.f); g0[e] = a * fsigmoid(1.702f * a) * (b + 1.f);
                a = fminf(g1[e], 7.f); b = fminf(fmaxf(l1[e], -7.f), 7.f); g1[e] = a * fsigmoid(1.702f * a) * (b + 1.f); }
            *(u32x4*)(ACT + ((size_t)u.pm * 256 + rl) * 1024 + col) = pack8(g0, g1); } EPI_ROWS_END
    }
};
struct SrcDn {
    const char* ACT; const char* WDNT; const int* meta; int G, c;
    __device__ __forceinline__ bool get(int i, GUnit& u) const {
        const int nu = meta[33]; int ru, j;
        if (G == 256) {
            const int x = c & 7, y = c >> 3; ru = i * 64 + x * 8 + (y & 7); j = y >> 3;
            if (i * 64 >= nu || ru >= nu) return false;
        } else { const int L = i * G + c; if (L >= nu * 4) return false; ru = L >> 2; j = L & 3; }
        int e = 0;
#pragma unroll
        for (int s = 16; s > 0; s >>= 1) if (meta[e + s] <= ru) e += s;
        u.a0 = ACT + (size_t)ru * 256 * 2048; u.a1 = u.a0 + (size_t)128 * 2048;
        u.b0 = WDNT + ((size_t)e * 1024 + j * 256) * 2048; u.b1 = u.b0 + (size_t)128 * 2048;
        u.nt = 16; u.pm = ru; u.pn = j; u.kind = 0; u.e = e; u.gidx = nullptr; return true;
    }
};
struct EpiDn {
    bf16_t* YP; const float* BDN; const int* rpair; const float* rw;
    __device__ __forceinline__ void operator()(const acc_t& acc, const GUnit& u, int wr, int wc, int fr, int fq) const {
        const int cl = wc * 32 + 8 * fq;
        const float* bp = BDN + (size_t)u.e * 1024 + u.pn * 256 + cl;
        f32x4 bv[2][2];
#pragma unroll
        for (int bj = 0; bj < 2; ++bj) { bv[bj][0] = *(const f32x4*)(bp + bj * 128); bv[bj][1] = *(const f32x4*)(bp + bj * 128 + 4); }
        int pr[8]; float wv[8];
#pragma unroll
        for (int i = 0; i < 8; ++i) { const int prow = u.pm * 256 + (i >> 2) * 128 + wr * 64 + (i & 3) * 16 + fr; pr[i] = rpair[prow]; wv[i] = rw[prow]; }
#pragma unroll
        for (int ai = 0; ai < 2; ++ai)
#pragma unroll
            for (int m = 0; m < 4; ++m) { const int pair = pr[ai * 4 + m];
                if (pair >= 0) { const float w = wv[ai * 4 + m]; bf16_t* op = YP + (size_t)pair * 1024 + u.pn * 256 + cl;
#pragma unroll
                    for (int bj = 0; bj < 2; ++bj) *(u32x4*)(op + bj * 128) = pack8((acc[ai][bj][m][0] + bv[bj][0]) * w, (acc[ai][bj][m][1] + bv[bj][1]) * w); } }
    }
};

constexpr int HY_FC = 0, HY_VI = 65536, HY_VRS = 8512, HY_YRS = 4116;
__device__ __forceinline__ void hyena_conv_channel(CParams& P, unsigned char* smem, LAS unsigned char* lds, int l, int c) {
    const int tid = otid(), lane = tid & 63, wid = __builtin_amdgcn_readfirstlane(tid >> 6);
    unsigned char* ws = P.ws;
    const float* KT = (const float*)(ws + WS_KRAW) + (size_t)l * 2 * 512 * 4096;
    const float* KPART = (const float*)(ws + WS_KPART) + (size_t)l * 2 * 64 * 512;
    {
        __syncthreads();
        float* red = (float*)(smem + 140000);
        if (tid < 64) { float s = KPART[(size_t)tid * 512 + c] + KPART[(size_t)tid * 512 + 256 + c]; s = wave_sum(s); if (tid == 0) red[0] = 1.f / s; }
        const f32x4 f0 = *(const f32x4*)(KT + (size_t)c * 4096 + tid * 8), f1 = *(const f32x4*)(KT + (size_t)c * 4096 + tid * 8 + 4);
        const f32x4 g0 = *(const f32x4*)(KT + (size_t)(256 + c) * 4096 + tid * 8), g1 = *(const f32x4*)(KT + (size_t)(256 + c) * 4096 + tid * 8 + 4);
        {
            if (tid < 4) ((unsigned*)(smem + HY_VI + 8 * HY_VRS))[tid] = 0u;
            const bf16_t* vsrc = (const bf16_t*)(ws + WS_VVT) + (size_t)c * 4096;
#pragma unroll
            for (int q = 0; q < 8; ++q) { const int ch = tid + q * NTH, b = ch >> 9, s = (ch & 511) * 8;
                *(u32x4*)(smem + HY_VI + b * HY_VRS + s * 2 + 16 * (s >> 8)) = *(const u32x4*)(vsrc + (size_t)b * 256 * 4096 + s); }
        }
        __syncthreads();
        const float inv = red[0];
        bf16_t* fc = (bf16_t*)(smem + HY_FC);
        const float fw[8] = {f0[0], f0[1], f0[2], f0[3], f1[0], f1[1], f1[2], f1[3]}, bw[8] = {g0[0], g0[1], g0[2], g0[3], g1[0], g1[1], g1[2], g1[3]};
#pragma unroll
        for (int e = 0; e < 8; ++e) { const int lag = tid * 8 + e; const bf16_t fv = f2bf(fw[e] * inv), bv = f2bf(bw[e] * inv);
#pragma unroll
            for (int q = 0; q < 4; ++q) { fc[q * 8192 + q + 4096 - lag] = fv;
                const int ib = q + 4096 + lag; if (lag >= 1 && ib < 8192) fc[q * 8192 + ib] = bv; } }
        if (tid < 4) { for (int i = 0; i <= tid; ++i) fc[tid * 8192 + i] = (bf16_t)0; }
        __syncthreads();
        {
            const int t0 = wid, q = t0 & 3, a = t0 >> 2, rho = lane & 31, h = lane >> 5, col = lane & 31, b = col >> 2, i = col & 3;
            f32x16 acc[4];
#pragma unroll
            for (int ct = 0; ct < 4; ++ct)
#pragma unroll
                for (int e = 0; e < 16; ++e) acc[ct][e] = 0.f;
            const LAS unsigned char* fq_ = lds + HY_FC + q * 16384;
            const LAS unsigned char* vi = lds + HY_VI + b * HY_VRS;
            const int ebase = 4096 - 8 * (rho - h) - 4 * a;
            const int sb0 = 256 * i + 8 * h;
#define HY_LDA(dl_) __builtin_shufflevector(*(const LAS bf16x4*)(fq_ + 2 * (ebase - (dl_))), *(const LAS bf16x4*)(fq_ + 2 * (ebase - (dl_)) + 8), 0, 1, 2, 3, 4, 5, 6, 7)
#define HY_LDB(dst, dl_, ct) do { const int s_ = 1024 * (ct) + sb0 - (dl_); const bool ok_ = (unsigned)s_ < 4096u; \
                dst = *(const LAS bf16x8*)(ok_ ? vi + s_ * 2 + 16 * (s_ >> 8) : zchunk); } while (0)
#define HY_VALID(dl_, ct) ((dl_) >= 1024 * (ct) - 4080 && (dl_) <= 1024 * (ct) + 768)
#define HY_LOADS(AF, BF, dl_, MASK) do { AF = HY_LDA(dl_); _Pragma("unroll") for (int ct = 0; ct < 4; ++ct) if ((MASK >> ct) & 1) HY_LDB(BF[ct], dl_, ct); } while (0)
#define HY_MMAS(AF, BF, MASK) do { _Pragma("unroll") for (int ct = 0; ct < 4; ++ct) if ((MASK >> ct) & 1) acc[ct] = __builtin_amdgcn_mfma_f32_32x32x16_bf16(AF, BF[ct], acc[ct], 0, 0, 0); } while (0)
#define HY_SEGMENT(LO, HI, MASK) do { HY_LOADS(a0, b0, LO, MASK); HY_LOADS(a1, b1, (LO) + 16, MASK); _Pragma("unroll 1") for (int dl = (LO); dl <= (HI); dl += 64) { \
                HY_LOADS(a2, b2, dl + 32, MASK); HY_LOADS(a3, b3, dl + 48, MASK); HY_MMAS(a0, b0, MASK); HY_MMAS(a1, b1, MASK); \
                if (dl + 64 <= (HI)) { HY_LOADS(a0, b0, dl + 64, MASK); HY_LOADS(a1, b1, dl + 80, MASK); } HY_MMAS(a2, b2, MASK); HY_MMAS(a3, b3, MASK); } } while (0)
            const LAS unsigned char* zchunk = lds + HY_VI + 8 * HY_VRS;
            bf16x8 a0, a1, a2, a3, b0[4], b1[4], b2[4], b3[4];
#pragma unroll
            for (int ct = 0; ct < 4; ++ct) { b0[ct] = (bf16x8){0, 0, 0, 0, 0, 0, 0, 0}; b1[ct] = b0[ct]; b2[ct] = b0[ct]; b3[ct] = b0[ct]; }
            HY_SEGMENT(-4080, -3072, 1); HY_SEGMENT(-3056, -2048, 3); HY_SEGMENT(-2032, -1024, 7); HY_SEGMENT(-1008, 768, 15);
            HY_SEGMENT(784, 1792, 14); HY_SEGMENT(1808, 2816, 12); HY_SEGMENT(2832, 3840, 8);
#undef HY_LOADS
#undef HY_MMAS
#undef HY_SEGMENT
#undef HY_LDA
#undef HY_LDB
#undef HY_VALID
            __syncthreads();
            float* Y = (float*)smem;
#pragma unroll
            for (int ct = 0; ct < 4; ++ct)
#pragma unroll
                for (int r = 0; r < 16; ++r) { const int rr = (r & 3) + 8 * (r >> 2) + 4 * h; const int t = 1024 * ct + 256 * i + t0 + 8 * rr;
                    Y[b * HY_YRS + t + (t >> 8)] = acc[ct][r]; }
        }
        __syncthreads();
        {
            const float* Y = (const float*)smem; bf16_t* dst = (bf16_t*)(ws + WS_CVT) + (size_t)c * 4096; const int tid2 = otid();
#pragma unroll 2
            for (int q = 0; q < 8; ++q) { const int ch = tid2 + q * NTH, b = ch >> 9, t = (ch & 511) * 8; const float* yp = Y + b * HY_YRS + t + (t >> 8);
                u32x4 ov; ov[0] = cvt_pk_bf16(yp[0], yp[1]); ov[1] = cvt_pk_bf16(yp[2], yp[3]); ov[2] = cvt_pk_bf16(yp[4], yp[5]); ov[3] = cvt_pk_bf16(yp[6], yp[7]);
                *(u32x4*)(dst + (size_t)b * 256 * 4096 + t) = ov; }
        }
        __syncthreads();
        {
            float* fl = (float*)smem;
            float* vc = fl + 520;
            const float* KT1 = KT + (size_t)512 * 4096; const float* KP1 = KPART + (size_t)64 * 512;
            if (tid < 64) { float s = tid < 4 ? KP1[(size_t)tid * 512 + c] + KP1[(size_t)tid * 512 + 256 + c] : 0.f; s = wave_sum(s); if (tid == 0) red[0] = 1.f / s; }
            { const int lag = tid - 256; float v; if (lag <= -256) v = 0.f; else if (lag >= 0) v = KT1[(size_t)c * 4096 + lag]; else v = KT1[(size_t)(256 + c) * 4096 - lag]; fl[tid + 3] = v; }
            if (tid < 3) { fl[tid] = 0.f; fl[515 + tid] = 0.f; }
            for (int e = tid; e < 2048; e += NTH) { const int b = e >> 8, s = e & 255; vc[e + 8] = bf2f(((const bf16_t*)(ws + WS_VVTC))[((size_t)b * 256 + c) * 256 + s]); }
            __syncthreads();
            const float inv1 = red[0];
            const int b = tid >> 6, tl = tid & 63; float o[4] = {0.f, 0.f, 0.f, 0.f};
#pragma unroll 4
            for (int s4 = 0; s4 < 64; ++s4) {
                const f32x4 vv = *(const f32x4*)(vc + 8 + b * 256 + 4 * s4);
                const f32x4 t0 = *(const f32x4*)(fl + 4 * (tl - s4) + 256), t1 = *(const f32x4*)(fl + 4 * (tl - s4) + 260);
                const float tp[8] = {t0[0], t0[1], t0[2], t0[3], t1[0], t1[1], t1[2], t1[3]};
#pragma unroll
                for (int j = 0; j < 4; ++j)
#pragma unroll
                    for (int k = 0; k < 4; ++k) o[j] += tp[j - k + 3] * vv[k]; }
            *(f32x4*)((float*)(ws + WS_CVTC) + ((size_t)b * 256 + c) * 256 + 4 * tl) = (f32x4){o[0] * inv1, o[1] * inv1, o[2] * inv1, o[3] * inv1};
        }
    }
    __syncthreads();
}

__device__ __forceinline__ void hyena_finish(CParams& P, unsigned char* smem, int l) {
    const int G = gridDim.x, tid = otid(), bid = obid();
    unsigned char* ws = P.ws;
    const bf16_t* PJ = (const bf16_t*)(ws + WS_PJ); bf16_t* YC = (bf16_t*)(ws + WS_YC);
    float* cvL = (float*)smem;
    const int c4 = tid & 63, tq = tid >> 6;
    const float* cw = P.in[I_HCW] + (size_t)l * 3 * 768; const float* cb = P.in[I_HCB] + (size_t)l * 768;
    float w1[3][4], wx[3][4], wv[3][4], b1[4], bx[4], bv[4], hb[4];
#pragma unroll
    for (int e = 0; e < 4; ++e) { b1[e] = cb[4 * c4 + e]; bx[e] = cb[256 + 4 * c4 + e]; bv[e] = cb[512 + 4 * c4 + e]; hb[e] = P.in[I_HBIAS][l * 256 + 4 * c4 + e];
#pragma unroll
        for (int k = 0; k < 3; ++k) { w1[k][e] = cw[k * 768 + 4 * c4 + e]; wx[k][e] = cw[k * 768 + 256 + 4 * c4 + e]; wv[k][e] = cw[k * 768 + 512 + 4 * c4 + e]; } }
    for (int tt = bid; tt < T / 64; tt += G) {
        const TileGeo g = tile_geo(tt);
        __syncthreads();
        if (g.isctx) { const float* src = (const float*)(ws + WS_CVTC) + (size_t)g.b * 256 * 256 + g.pos0;
#pragma unroll
          for (int q = 0; q < 8; ++q) { const int ch = tid + q * NTH, c = ch >> 4, j = (ch & 15) * 4; const f32x4 v = *(const f32x4*)(src + (size_t)c * 256 + j);
              float* d = cvL + c * 68 + j; d[0] = v[0]; d[1] = v[1]; d[2] = v[2]; d[3] = v[3]; } }
        else { const bf16_t* src = (const bf16_t*)(ws + WS_CVT) + (size_t)g.b * 256 * 4096 + g.pos0;
          u32x4 v[4];
#pragma unroll
          for (int q = 0; q < 4; ++q) { const int ch = tid + q * NTH, c = ch >> 3, j = (ch & 7) * 8; v[q] = *(const u32x4*)(src + (size_t)c * 4096 + j); }
#pragma unroll
          for (int q = 0; q < 4; ++q) { const int ch = tid + q * NTH, c = ch >> 3, j = (ch & 7) * 8; float f[8]; unpack8(v[q], f);
              float* d = cvL + c * 68 + j;
#pragma unroll
              for (int e = 0; e < 8; ++e) d[e] = f[e]; } }
        __syncthreads();
        const int p0 = g.pos0 + tq * 8;
        const bf16_t* rowp = PJ + (size_t)(g.tok0 + tq * 8) * PJW;
        float r1[3][4], rx[3][4], rv[3][4];
#define LD_FROW(k, dp) do { const int pp = p0 + (dp); const bool ok_ = (pp >= 0 && pp < g.slen); const bf16_t* rp = rowp + (ptrdiff_t)(ok_ ? (dp) : 0) * PJW; \
            unpack4(*(const u32x2*)(rp + 4 * c4), r1[k]); unpack4(*(const u32x2*)(rp + 256 + 4 * c4), rx[k]); unpack4(*(const u32x2*)(rp + 512 + 4 * c4), rv[k]); \
            _Pragma("unroll") for (int e = 0; e < 4; ++e) { r1[k][e] = ok_ ? r1[k][e] : 0.f; rx[k][e] = ok_ ? rx[k][e] : 0.f; rv[k][e] = ok_ ? rv[k][e] : 0.f; } } while (0)
        LD_FROW(0, -1); LD_FROW(1, 0);
#pragma unroll
        for (int j = 0; j < 8; ++j) {
            LD_FROW(2, j + 1);
            float o[4];
#pragma unroll
            for (int e = 0; e < 4; ++e) {
                const float x1 = w1[0][e] * r1[0][e] + w1[1][e] * r1[1][e] + w1[2][e] * r1[2][e] + b1[e];
                const float x2 = wx[0][e] * rx[0][e] + wx[1][e] * rx[1][e] + wx[2][e] * rx[2][e] + bx[e];
                const float vv = wv[0][e] * rv[0][e] + wv[1][e] * rv[1][e] + wv[2][e] * rv[2][e] + bv[e];
                const float xv = x2 * vv;
                o[e] = x1 * (cvL[(4 * c4 + e) * 68 + tq * 8 + j] + xv * hb[e]);
                r1[0][e] = r1[1][e]; r1[1][e] = r1[2][e]; rx[0][e] = rx[1][e]; rx[1][e] = rx[2][e]; rv[0][e] = rv[1][e]; rv[1][e] = rv[2][e]; }
            u32x2 ov; ov[0] = cvt_pk_bf16(o[0], o[1]); ov[1] = cvt_pk_bf16(o[2], o[3]);
            *(u32x2*)(YC + (size_t)(g.tok0 + tq * 8 + j) * YCW + 512 + 4 * c4) = ov;
        }
#undef LD_FROW
    }
    __syncthreads();
}

constexpr int SS_LD = 136;
__device__ __forceinline__ int ssd_tokbase(int b, int cc) { return cc < 2 ? TL + b * 256 + cc * 128 : b * 4096 + (cc - 2) * 128; }
__device__ __forceinline__ const bf16_t* ssd_trow(const unsigned char* ws, int b, int cc, int row) {
    return cc < 2 ? (const bf16_t*)(ws + WS_XSTC) + ((size_t)b * 768 + row) * 256 + cc * 128 : (const bf16_t*)(ws + WS_XST) + ((size_t)b * 768 + row) * 4096 + (cc - 2) * 128;
}
__device__ __forceinline__ void ssd_dt_arrays(CParams& P, float* sm, int l, int b, int g, int cc, int un) {
    const int tid = otid(), lane = tid & 63, w = __builtin_amdgcn_readfirstlane(tid >> 6), dir = w >> 2, r = w & 3, c = dir * 8 + g * 4 + r;
    const float* DT = (const float*)(P.ws + WS_DT); const int tb = ssd_tokbase(b, cc);
    const float d0 = DT[(size_t)(tb + 2 * lane) * 16 + c], d1 = DT[(size_t)(tb + 2 * lane + 1) * 16 + c];
    const float a = -expf(P.in[I_SALOG][l * 16 + c]);
    const float v0 = d0 * a, v1 = d1 * a, p = v0 + v1;
    float inc = p;
#pragma unroll
    for (int d = 1; d < 64; d <<= 1) { const float y = __int_as_float(__builtin_amdgcn_ds_bpermute((lane - d) * 4, __float_as_int(inc))); inc += (lane >= d) ? y : 0.f; }
    const float E = inc - p, tot = __int_as_float(__builtin_amdgcn_readlane(__float_as_int(inc), 63));
    const float s0 = dir ? tot - E : E + v0, s1 = dir ? tot - E - v0 : inc;
    const int o = dir * 512 + (2 * lane) * 4 + r;
    sm[o] = d0; sm[o + 4] = d1; sm[1024 + o] = s0; sm[1024 + o + 4] = s1;
    float* ag = (float*)(P.ws + WS_ACSG) + (size_t)un * 1024; ag[o] = s0; ag[o + 4] = s1;
    { const float sref = dir ? s0 : s1;
      const float ref = __int_as_float(__builtin_amdgcn_ds_bpermute((dir ? (lane & ~7) : (lane | 7)) * 4, __float_as_int(sref)));
      f32x2 wl; wl[0] = d0 * __expf(ref - s0); wl[1] = d1 * __expf(ref - s1); *(f32x2*)(sm + 3072 + dir * 512 + r * 128 + 2 * lane) = wl; }
    { f32x2 wv; wv[0] = d0 * __expf(tot - s0); wv[1] = d1 * __expf(tot - s1); *(f32x2*)(sm + 2048 + dir * 512 + r * 128 + 2 * lane) = wv; }
}
#define SS_FRAG(base, row, k0) (*(const LAS bf16x8*)((base) + ((row) * SS_LD + (k0) + 8 * fq) * 2))

__device__ __forceinline__ void ssd_a_unit(CParams& P, unsigned char* smem, LAS unsigned char* lds, int l, int un) {
    const int tid = otid(), lane = tid & 63, w = __builtin_amdgcn_readfirstlane(tid >> 6), fr = lane & 15, fq = lane >> 4;
    unsigned char* ws = P.ws;
    constexpr int R0 = 0, R1 = 34816, R2 = 69632, R3 = 104448, RS = 121856;
    float* sm = (float*)(smem + RS); float* dtf = sm; float* dtb = sm + 512; float* acf = sm + 1024; float* acb = sm + 1536;
    const bf16_t* XBN = (const bf16_t*)(ws + WS_XBN);
    const int b = un / (2 * NCH), g = (un / NCH) & 1, cc = un % NCH, tb = ssd_tokbase(b, cc);
    __syncthreads();
    u32x4 cv[4], bv[4], tv[4], xv[2];
#pragma unroll
    for (int q = 0; q < 4; ++q) { const int ch = tid + q * NTH, row = ch >> 4, k8 = (ch & 15) * 8;
        cv[q] = *(const u32x4*)(XBN + (size_t)(tb + row) * 1024 + 768 + g * 128 + k8); bv[q] = *(const u32x4*)(XBN + (size_t)(tb + row) * 1024 + 512 + g * 128 + k8);
        tv[q] = *(const u32x4*)(ssd_trow(ws, b, cc, 512 + g * 128 + row) + k8); }
#pragma unroll
    for (int q = 0; q < 2; ++q) { const int ch = tid + q * NTH, row = ch >> 4, k8 = (ch & 15) * 8; xv[q] = *(const u32x4*)(ssd_trow(ws, b, cc, g * 256 + row) + k8); }
    ssd_dt_arrays(P, sm, l, b, g, cc, un);
#pragma unroll
    for (int q = 0; q < 4; ++q) { const int ch = tid + q * NTH, row = ch >> 4, k8 = (ch & 15) * 8;
        *(u32x4*)(smem + R0 + (row * SS_LD + k8) * 2) = cv[q]; *(u32x4*)(smem + R1 + (row * SS_LD + k8) * 2) = bv[q]; *(u32x4*)(smem + R2 + (row * SS_LD + k8) * 2) = tv[q]; }
    __syncthreads();
    f32x4 S[8];
#pragma unroll
    for (int nt = 0; nt < 8; ++nt) S[nt] = (f32x4){0.f, 0.f, 0.f, 0.f};
#pragma unroll
    for (int k0 = 0; k0 < 128; k0 += 32) { const bf16x8 af = SS_FRAG(lds + R0, 16 * w + fr, k0);
#pragma unroll
        for (int nt = 0; nt < 8; ++nt) S[nt] = __builtin_amdgcn_mfma_f32_16x16x32_bf16(SS_FRAG(lds + R1, 16 * nt + fr, k0), af, S[nt], 0, 0, 0); }
#pragma unroll 1
    for (int r = 0; r < 4; ++r) {
        __syncthreads();
#pragma unroll
        for (int q = 0; q < 2; ++q) { const int ch = tid + q * NTH, row = ch >> 4, k8 = (ch & 15) * 8; *(u32x4*)(smem + R3 + (row * SS_LD + k8) * 2) = xv[q]; }
        if (r < 3) {
#pragma unroll
            for (int q = 0; q < 2; ++q) { const int ch = tid + q * NTH, row = ch >> 4, k8 = (ch & 15) * 8; xv[q] = *(const u32x4*)(ssd_trow(ws, b, cc, g * 256 + (r + 1) * 64 + row) + k8); } }
        { const int i = 16 * w + fr; const float afi = acf[i * 4 + r], abi = acb[i * 4 + r], dfi = dtf[i * 4 + r];
#pragma unroll
          for (int nt = 0; nt < 8; ++nt) { float o[4];
              if (nt == w) {
#pragma unroll
                  for (int e = 0; e < 4; ++e) { const int j = 16 * nt + 4 * fq + e;
                      const bool fw = j < i; const float* ap = fw ? acf : acb; const float* dp = fw ? dtf : dtb;
                      float wgt = __expf((fw ? afi : abi) - ap[j * 4 + r]) * dp[j * 4 + r];
                      wgt += (j == i) ? dfi : 0.f;
                      o[e] = S[nt][e] * wgt; }
              } else {
                  const bool fw = nt < w;
                  const float E = __expf(fw ? afi - acf[(16 * nt + 15) * 4 + r] : abi - acb[(16 * nt) * 4 + r]);
                  const f32x4 wv = *(const f32x4*)(sm + 3072 + (fw ? 0 : 512) + r * 128 + 16 * nt + 4 * fq);
#pragma unroll
                  for (int e = 0; e < 4; ++e) o[e] = S[nt][e] * (E * wv[e]);
              }
              u32x2 ov; ov[0] = cvt_pk_bf16(o[0], o[1]); ov[1] = cvt_pk_bf16(o[2], o[3]);
              *(u32x2*)(smem + R0 + (i * SS_LD + 16 * nt + 4 * fq) * 2) = ov; } }
        __syncthreads();
        { const int p = tid >> 3, j0 = (tid & 7) * 16; const float* wf = sm + 2048 + r * 128 + j0; const float* wb = wf + 512;
#pragma unroll
          for (int h2 = 0; h2 < 2; ++h2) { float v[8]; unpack8(*(const u32x4*)(smem + R3 + (p * SS_LD + j0 + 8 * h2) * 2), v); u32x4 of, ob; float vf[8], vb[8];
              const f32x4 f0 = *(const f32x4*)(wf + 8 * h2), f1 = *(const f32x4*)(wf + 8 * h2 + 4), b0 = *(const f32x4*)(wb + 8 * h2), b1 = *(const f32x4*)(wb + 8 * h2 + 4);
#pragma unroll
              for (int e = 0; e < 4; ++e) { vf[e] = v[e] * f0[e]; vf[e + 4] = v[e + 4] * f1[e]; vb[e] = v[e] * b0[e]; vb[e + 4] = v[e + 4] * b1[e]; }
#pragma unroll
              for (int e = 0; e < 4; ++e) { of[e] = cvt_pk_bf16(vf[2 * e], vf[2 * e + 1]); ob[e] = cvt_pk_bf16(vb[2 * e], vb[2 * e + 1]); }
              *(u32x4*)(smem + R1 + (p * SS_LD + j0 + 8 * h2) * 2) = of; *(u32x4*)(smem + R1 + 17408 + (p * SS_LD + j0 + 8 * h2) * 2) = ob; } }
        { f32x4 yd[4];
#pragma unroll
          for (int nt = 0; nt < 4; ++nt) yd[nt] = (f32x4){0.f, 0.f, 0.f, 0.f};
#pragma unroll
          for (int k0 = 0; k0 < 128; k0 += 32) { const bf16x8 af = SS_FRAG(lds + R0, 16 * w + fr, k0);
#pragma unroll
              for (int nt = 0; nt < 4; ++nt) yd[nt] = __builtin_amdgcn_mfma_f32_16x16x32_bf16(SS_FRAG(lds + R3, 16 * nt + fr, k0), af, yd[nt], 0, 0, 0); }
          bf16_t* yp = (bf16_t*)(ws + WS_YD) + (size_t)(tb + 16 * w + fr) * 512 + g * 256 + r * 64 + 4 * fq;
#pragma unroll
          for (int nt = 0; nt < 4; ++nt) { u32x2 ov; ov[0] = cvt_pk_bf16(yd[nt][0], yd[nt][1]); ov[1] = cvt_pk_bf16(yd[nt][2], yd[nt][3]); *(u32x2*)(yp + 16 * nt) = ov; } }
        __syncthreads();
#pragma unroll
        for (int dir = 0; dir < 2; ++dir) {
            const int pt = w & 3, nt0 = (w >> 2) * 4;
            f32x4 st[4];
#pragma unroll
            for (int q = 0; q < 4; ++q) st[q] = (f32x4){0.f, 0.f, 0.f, 0.f};
#pragma unroll
            for (int k0 = 0; k0 < 128; k0 += 32) { const bf16x8 af = SS_FRAG(lds + R1 + dir * 17408, 16 * pt + fr, k0);
#pragma unroll
                for (int q = 0; q < 4; ++q) st[q] = __builtin_amdgcn_mfma_f32_16x16x32_bf16(SS_FRAG(lds + R2, 16 * (nt0 + q) + fr, k0), af, st[q], 0, 0, 0); }
            bf16_t* sp = (bf16_t*)(ws + WS_ST) + ((((size_t)(b * 2 + g) * 4 + r) * 2 + dir) * NCH + cc) * 8192 + (16 * pt + fr) * 128 + 4 * fq;
#pragma unroll
            for (int q = 0; q < 4; ++q) { u32x2 ov; ov[0] = cvt_pk_bf16(st[q][0], st[q][1]); ov[1] = cvt_pk_bf16(st[q][2], st[q][3]); *(u32x2*)(sp + 16 * (nt0 + q)) = ov; }
        }
    }
    if (tid < 8) { const int dir = tid >> 2, r = tid & 3; ((float*)(ws + WS_ACT))[(((size_t)(b * 2 + g) * 4 + r) * 2 + dir) * NCH + cc] = dir ? acb[r] : acf[127 * 4 + r]; }
    __syncthreads();
}

__device__ __forceinline__ void ssd_phase_b(CParams& P) {
    unsigned char* ws = P.ws;
    const bf16_t* ST = (const bf16_t*)(ws + WS_ST); const float* ACTS = (const float*)(ws + WS_ACT); bf16_t* HENT = (bf16_t*)(ws + WS_HENT);
    for (int it = obid() * NTH + otid(); it < NB * 2 * 4 * 2 * 2048; it += gridDim.x * NTH) {
        const int hd = it >> 11, e4 = (it & 2047) * 4, dir = hd & 1;
        f32x4 h = (f32x4){0.f, 0.f, 0.f, 0.f};
#pragma unroll
        for (int hf = 0; hf < 2; ++hf) {
            u32x2 sv[17]; float dv[17];
#pragma unroll
            for (int s = 0; s < 17; ++s) { const int st = hf * 17 + s; const int cc = dir == 0 ? st : (st < 2 ? 1 - st : NCH + 1 - st);
                sv[s] = __builtin_nontemporal_load((const u32x2*)(ST + ((size_t)hd * NCH + cc) * 8192 + e4)); dv[s] = ACTS[(size_t)hd * NCH + cc]; }
#pragma unroll
            for (int s = 0; s < 17; ++s) { const int st = hf * 17 + s; const int cc = dir == 0 ? st : (st < 2 ? 1 - st : NCH + 1 - st);
                u32x2 ov; ov[0] = cvt_pk_bf16(h[0], h[1]); ov[1] = cvt_pk_bf16(h[2], h[3]); *(u32x2*)(HENT + ((size_t)hd * NCH + cc) * 8192 + e4) = ov;
                h = h * __expf(dv[s]) + (f32x4){bflo(sv[s][0]), bfhi(sv[s][0]), bflo(sv[s][1]), bfhi(sv[s][1])}; }
        }
    }
}

__device__ __forceinline__ void ssd_phase_c(CParams& P, unsigned char* smem, LAS unsigned char* lds, int l) {
    const int G = gridDim.x, tid = otid(), bid = obid(), lane = tid & 63, w = __builtin_amdgcn_readfirstlane(tid >> 6), fr = lane & 15, fq = lane >> 4;
    unsigned char* ws = P.ws;
    constexpr int R0 = 0, R1 = 34816, R2 = 52224, RS = 69632;
    float* sm = (float*)(smem + RS); float* acf = sm + 1024; float* acb = sm + 1536;
    const bf16_t* XBN = (const bf16_t*)(ws + WS_XBN); const bf16_t* PJ = (const bf16_t*)(ws + WS_PJ); const bf16_t* HENT = (const bf16_t*)(ws + WS_HENT);
    bf16_t* YC = (bf16_t*)(ws + WS_YC); const bf16_t* YD = (const bf16_t*)(ws + WS_YD); float* SSQ = (float*)(ws + WS_SSQ); const float* DT = (const float*)(ws + WS_DT);
    constexpr int NIT = NB * 2 * NCH * 4;
    const int it0 = (int)((unsigned)(bid * NIT) / (unsigned)G), it1 = (int)((unsigned)((bid + 1) * NIT) / (unsigned)G);
    const int i = 16 * w + fr;
    u32x4 hv[4], cvn[4]; u32x2 ydn[4], xrn[4], zrn[4]; float acn[2];
#define SC_REQ(itx, newunit) do { const int un_ = (itx) >> 2, r_ = (itx) & 3, b_ = un_ / (2 * NCH), g_ = (un_ / NCH) & 1, cc_ = un_ % NCH, tb_ = ssd_tokbase(b_, cc_); \
        const size_t tok_ = (size_t)tb_ + i; const int hc_ = g_ * 256 + r_ * 64 + 4 * fq; \
        _Pragma("unroll") for (int q = 0; q < 4; ++q) { const int ch = tid + q * NTH, dir = ch >> 10, hrow = (ch >> 4) & 63, k8 = (ch & 15) * 8; \
            hv[q] = __builtin_nontemporal_load((const u32x4*)(HENT + ((((size_t)(b_ * 2 + g_) * 4 + r_) * 2 + dir) * NCH + cc_) * 8192 + hrow * 128 + k8)); } \
        _Pragma("unroll") for (int nt = 0; nt < 4; ++nt) { ydn[nt] = *(const u32x2*)(YD + tok_ * 512 + hc_ + 16 * nt); xrn[nt] = *(const u32x2*)(XBN + tok_ * 1024 + hc_ + 16 * nt); zrn[nt] = *(const u32x2*)(PJ + tok_ * PJW + 1024 + hc_ + 16 * nt); } \
        if (newunit) { \
            _Pragma("unroll") for (int q = 0; q < 4; ++q) { const int ch = tid + q * NTH, row = ch >> 4, k8 = (ch & 15) * 8; cvn[q] = *(const u32x4*)(XBN + (size_t)(tb_ + row) * 1024 + 768 + g_ * 128 + k8); } \
            _Pragma("unroll") for (int q = 0; q < 2; ++q) acn[q] = ((const float*)(ws + WS_ACSG))[(size_t)un_ * 1024 + tid + q * NTH]; } \
        } while (0)
    if (it0 < it1) SC_REQ(it0, true);
    int cur_un = -1;
#pragma unroll 1
    for (int it = it0; it < it1; ++it) {
        const int un = it >> 2, r = it & 3, b = un / (2 * NCH), g = (un / NCH) & 1, cc = un % NCH, tb = ssd_tokbase(b, cc);
        const size_t tok = (size_t)tb + i; const int hc = g * 256 + r * 64 + 4 * fq;
        __syncthreads();
        if (un != cur_un) {
            cur_un = un;
#pragma unroll
            for (int q = 0; q < 2; ++q) sm[1024 + tid + q * NTH] = acn[q];
#pragma unroll
            for (int q = 0; q < 4; ++q) { const int ch = tid + q * NTH, row = ch >> 4, k8 = (ch & 15) * 8; *(u32x4*)(smem + R0 + (row * SS_LD + k8) * 2) = cvn[q]; }
        }
#pragma unroll
        for (int q = 0; q < 4; ++q) { const int ch = tid + q * NTH, dir = ch >> 10, hrow = (ch >> 4) & 63, k8 = (ch & 15) * 8; *(u32x4*)(smem + (dir ? R2 : R1) + (hrow * SS_LD + k8) * 2) = hv[q]; }
        u32x2 ydv[4], xr[4], zr[4];
#pragma unroll
        for (int nt = 0; nt < 4; ++nt) { ydv[nt] = ydn[nt]; xr[nt] = xrn[nt]; zr[nt] = zrn[nt]; }
        if (it + 1 < it1) { const bool nu_ = ((it + 1) >> 2) != un; SC_REQ(it + 1, nu_); }
        __syncthreads();
        f32x4 yf[4], yb[4];
#pragma unroll
        for (int nt = 0; nt < 4; ++nt) { yf[nt] = (f32x4){0.f, 0.f, 0.f, 0.f}; yb[nt] = (f32x4){0.f, 0.f, 0.f, 0.f}; }
#pragma unroll
        for (int k0 = 0; k0 < 128; k0 += 32) { const bf16x8 af = SS_FRAG(lds + R0, 16 * w + fr, k0);
#pragma unroll
            for (int nt = 0; nt < 4; ++nt) { yf[nt] = __builtin_amdgcn_mfma_f32_16x16x32_bf16(SS_FRAG(lds + R1, 16 * nt + fr, k0), af, yf[nt], 0, 0, 0);
                                             yb[nt] = __builtin_amdgcn_mfma_f32_16x16x32_bf16(SS_FRAG(lds + R2, 16 * nt + fr, k0), af, yb[nt], 0, 0, 0); } }
        const float ef = __expf(acf[i * 4 + r]), eb = __expf(acb[i * 4 + r]), dsk = P.in[I_SD][l * 8 + g * 4 + r];
        float ssq = 0.f;
#pragma unroll
        for (int nt = 0; nt < 4; ++nt) {
            float xv[4], zv[4], yv[4]; unpack4(xr[nt], xv); unpack4(zr[nt], zv); unpack4(ydv[nt], yv);
            float o[4];
#pragma unroll
            for (int e = 0; e < 4; ++e) { o[e] = (yv[e] + ef * yf[nt][e] + eb * yb[nt][e] + xv[e] * dsk) * fsilu(zv[e]); ssq += o[e] * o[e]; }
            u32x2 ov; ov[0] = cvt_pk_bf16(o[0], o[1]); ov[1] = cvt_pk_bf16(o[2], o[3]);
            *(u32x2*)(YC + tok * YCW + 1024 + hc + 16 * nt) = ov; }
        ssq += swz_xor<16>(ssq); ssq = xor32_sum(ssq);
        if (fq == 0) SSQ[tok * 8 + g * 4 + r] = ssq;
    }
#undef SC_REQ
    __syncthreads();
}

__device__ __forceinline__ void p7a_route(CParams& P, unsigned char* smem, LAS unsigned char* lds, int l, const int TT) {
    const int G = gridDim.x, tid = otid(), bid = obid(), lane = tid & 63, w = __builtin_amdgcn_readfirstlane(tid >> 6), fr = lane & 15, fq = lane >> 4;
    unsigned char* ws = P.ws;
    constexpr int HLD = 1032, OFF_HI = 0, OFF_LO = 16 * HLD * 2, OFF_PART = 2 * 16 * HLD * 2, OFF_LG = OFF_PART + 8 * 16 * 32 * 4, OFF_HIST = OFF_LG + 16 * 32 * 4;
    float* part = (float*)(smem + OFF_PART); float* lg = (float*)(smem + OFF_LG); int* hist = (int*)(smem + OFF_HIST);
    const bf16_t* X1 = (const bf16_t*)(ws + WS_X1); bf16_t* H2 = (bf16_t*)(ws + WS_H2);
    const float* MODL = (const float*)(ws + WS_MOD) + (size_t)l * 9 * 6144;
    const float* nf = P.in[I_NFFN] + (size_t)l * 1024;
    bf16x8 wh[2][4], wl[2][4];
    { const bf16_t* wr = (const bf16_t*)(ws + WS_WRT) + (size_t)l * 2 * 32 * 1024;
#pragma unroll
      for (int nt = 0; nt < 2; ++nt)
#pragma unroll
          for (int ks = 0; ks < 4; ++ks) { const size_t o = (size_t)(16 * nt + fr) * 1024 + 128 * w + 32 * ks + 8 * fq;
              wh[nt][ks] = *(const bf16x8*)(wr + o); wl[nt][ks] = *(const bf16x8*)(wr + 32 * 1024 + o); } }
    if (tid < 32) hist[tid] = 0;
    f32x4 gn[4];
#pragma unroll
    for (int q = 0; q < 4; ++q) gn[q] = *(const f32x4*)(nf + q * 256 + lane * 4);
    const int nit = (TT / 16 + G - 1) / G;
    f32x4 v[2][4];
    { const int t0 = bid * 16;
#pragma unroll
      for (int j = 0; j < 2; ++j)
#pragma unroll
          for (int q = 0; q < 4; ++q) { float t_[4] = {0.f, 0.f, 0.f, 0.f}; if (t0 < TT) unpack4(*(const u32x2*)(X1 + (size_t)(t0 + 2 * w + j) * 1024 + q * 256 + lane * 4), t_); v[j][q] = (f32x4){t_[0], t_[1], t_[2], t_[3]}; } }
    for (int it = 0; it < nit; ++it) {
        const int t0 = (it * G + bid) * 16;
        __syncthreads();
        if (t0 < TT) {
            f32x4 av[4], bv[4];
            { const float* md = MODL + (size_t)tok_modj(t0) * 6144;
#pragma unroll
              for (int q = 0; q < 4; ++q) { av[q] = *(const f32x4*)(md + 4096 + q * 256 + lane * 4); bv[q] = *(const f32x4*)(md + 3072 + q * 256 + lane * 4); } }
#pragma unroll
            for (int j = 0; j < 2; ++j) {
                const int t = t0 + 2 * w + j;
                float ss = 0.f;
#pragma unroll
                for (int q = 0; q < 4; ++q) ss += v[j][q][0] * v[j][q][0] + v[j][q][1] * v[j][q][1] + v[j][q][2] * v[j][q][2] + v[j][q][3] * v[j][q][3];
                ss = wave_sum(ss); const float rs = rsqrtf(ss * (1.f / 1024.f) + EPSN);
#pragma unroll
                for (int q = 0; q < 4; ++q) { const int c = q * 256 + lane * 4;
                    const f32x4 g = gn[q], a = av[q], b = bv[q];
                    float o[4], lo[4];
#pragma unroll
                    for (int e = 0; e < 4; ++e) o[e] = v[j][q][e] * rs * g[e] * (1.f + a[e]) + b[e];
                    u32x2 ov; ov[0] = cvt_pk_bf16(o[0], o[1]); ov[1] = cvt_pk_bf16(o[2], o[3]);
                    *(u32x2*)(H2 + (size_t)t * 1024 + c) = ov;
                    lo[0] = o[0] - bflo(ov[0]); lo[1] = o[1] - bfhi(ov[0]); lo[2] = o[2] - bflo(ov[1]); lo[3] = o[3] - bfhi(ov[1]);
                    u32x2 lv; lv[0] = cvt_pk_bf16(lo[0], lo[1]); lv[1] = cvt_pk_bf16(lo[2], lo[3]);
                    *(u32x2*)(smem + OFF_HI + ((2 * w + j) * HLD + c) * 2) = ov; *(u32x2*)(smem + OFF_LO + ((2 * w + j) * HLD + c) * 2) = lv; }
            }
        }
        { const int tn = ((it + 1) * G + bid) * 16;
          if (it + 1 < nit && tn < TT) {
#pragma unroll
              for (int j = 0; j < 2; ++j)
#pragma unroll
                  for (int q = 0; q < 4; ++q) { float t_[4]; unpack4(*(const u32x2*)(X1 + (size_t)(tn + 2 * w + j) * 1024 + q * 256 + lane * 4), t_); v[j][q] = (f32x4){t_[0], t_[1], t_[2], t_[3]}; } } }
        __syncthreads();
        if (t0 < TT) {
            f32x4 acc[2] = {(f32x4){0.f, 0.f, 0.f, 0.f}, (f32x4){0.f, 0.f, 0.f, 0.f}};
#pragma unroll
            for (int ks = 0; ks < 4; ++ks) {
                const bf16x8 ah = *(const LAS bf16x8*)(lds + OFF_HI + (fr * HLD + 128 * w + 32 * ks + 8 * fq) * 2), al = *(const LAS bf16x8*)(lds + OFF_LO + (fr * HLD + 128 * w + 32 * ks + 8 * fq) * 2);
#pragma unroll
                for (int nt = 0; nt < 2; ++nt) { acc[nt] = __builtin_amdgcn_mfma_f32_16x16x32_bf16(wh[nt][ks], ah, acc[nt], 0, 0, 0);
                    acc[nt] = __builtin_amdgcn_mfma_f32_16x16x32_bf16(wl[nt][ks], ah, acc[nt], 0, 0, 0); acc[nt] = __builtin_amdgcn_mfma_f32_16x16x32_bf16(wh[nt][ks], al, acc[nt], 0, 0, 0); } }
#pragma unroll
            for (int nt = 0; nt < 2; ++nt) *(f32x4*)(part + (w * 16 + fr) * 32 + 16 * nt + 4 * fq) = acc[nt];
        }
        __syncthreads();
        if (t0 < TT) {
            const int tk = tid >> 5, e = tid & 31; float x = P.in[I_RB][l * 32 + e];
#pragma unroll
            for (int q = 0; q < 8; ++q) x += part[(q * 16 + tk) * 32 + e];
            float vv[4]; int ix[4];
#pragma unroll
            for (int k = 0; k < 4; ++k) {
                float m = x; m = fmaxf(m, swz_xor<1>(m)); m = fmaxf(m, swz_xor<2>(m)); m = fmaxf(m, swz_xor<4>(m)); m = fmaxf(m, swz_xor<8>(m)); m = fmaxf(m, swz_xor<16>(m));
                const unsigned long long bm = __ballot(x == m); const unsigned hm = (unsigned)(bm >> (lane & 32));
                const int bi = __builtin_ctz(hm);
                vv[k] = m; ix[k] = bi; if (e == bi) x = -3.0e38f; }
            if (e == 0) {
                const int t = t0 + tk; float ex[4], sum = 0.f;
#pragma unroll
                for (int k = 0; k < 4; ++k) { ex[k] = expf(vv[k] - vv[0]); sum += ex[k]; }
                const float inv = 1.f / sum;
#pragma unroll
                for (int k = 0; k < 4; ++k) { ((int*)(ws + WS_TKE))[(size_t)t * 4 + k] = ix[k]; ((float*)(ws + WS_TKW))[(size_t)t * 4 + k] = ex[k] * inv; atomicAdd(&hist[ix[k]], 1); }
            }
        }
    }
    __syncthreads();
    if (tid < 32) ((int*)(ws + WS_BCNT))[bid * 32 + tid] = hist[tid];
}
__device__ __forceinline__ void p7b_scatter(CParams& P, unsigned char* smem, const int TT) {
    const int G = gridDim.x, tid = otid(), bid = obid();
    unsigned char* ws = P.ws;
    int* cur = (int*)smem; int* tot = cur + 32; int* rst = tot + 32; int* ust = rst + 32;
    const int* BC = (const int*)(ws + WS_BCNT);
    __syncthreads();
    int* ptot = ust + 40; int* pbef = ptot + 512;
    { const int e = tid & 31, pr = tid >> 5; int before = 0, total = 0;
      for (int b = pr; b < G; b += 16) { const int c = BC[b * 32 + e]; total += c; before += (b < bid) ? c : 0; }
      ptot[pr * 32 + e] = total; pbef[pr * 32 + e] = before; }
    __syncthreads();
    if (tid < 32) { int before = 0, total = 0;
#pragma unroll
        for (int pr = 0; pr < 16; ++pr) { total += ptot[pr * 32 + tid]; before += pbef[pr * 32 + tid]; }
        tot[tid] = total; cur[tid] = before; }
    __syncthreads();
    if (tid == 0) { int u = 0; for (int e = 0; e < 32; ++e) { ust[e] = u; rst[e] = u * 256; u += (tot[e] + 255) >> 8; } ust[32] = u; }
    __syncthreads();
    if (tid < 32) cur[tid] += rst[tid];
    if (bid == 0 && tid < 33) ((int*)(ws + WS_META))[tid] = ust[tid];
    if (bid == 0 && tid == 33) ((int*)(ws + WS_META))[33] = ust[32];
    __syncthreads();
    int* RTOK = (int*)(ws + WS_RTOK); int* RPAIR = (int*)(ws + WS_RPAIR); float* RW = (float*)(ws + WS_RW);
    const int nit = (TT / 16 + G - 1) / G;
    for (int pi = tid; pi < nit * 64; pi += NTH) {
        const int it = pi >> 6, wq = (pi >> 2) & 15, k = pi & 3, t = (it * G + bid) * 16 + wq;
        if (t < TT) { const int e = ((const int*)(ws + WS_TKE))[(size_t)t * 4 + k]; const int pos = atomicAdd(&cur[e], 1);
            RTOK[pos] = t; RPAIR[pos] = t * 4 + k; RW[pos] = ((const float*)(ws + WS_TKW))[(size_t)t * 4 + k]; }
    }
    for (int e = bid; e < 32; e += G) { const int lo = rst[e] + tot[e], hi = rst[e] + (((tot[e] + 255) >> 8) << 8);
        for (int r = lo + tid; r < hi; r += NTH) { RTOK[r] = 0; RPAIR[r] = -1; RW[r] = 0.f; } }
    __syncthreads();
}

__device__ __forceinline__ void p10_combine(CParams& P, int l) {
    const int tid_ = otid(), lane = tid_ & 63, gw = (obid() * NTH + tid_) >> 6, nw = gridDim.x * (NTH / 64);
    unsigned char* ws = P.ws;
    const bf16_t* X1 = (const bf16_t*)(ws + WS_X1); const bf16_t* YP = (const bf16_t*)(ws + WS_YP);
    const float* MODL = (const float*)(ws + WS_MOD) + (size_t)l * 9 * 6144;
    const int TT = (l == NL - 1) ? TL : T;
    const int per = (TT + nw - 1) / nw, tb = gw * per, te = (tb + per < TT) ? tb + per : TT;
    if (tb >= te) return;
    f32x4 gain[4], g2v[4], scv[4], shv[4]; int curj = -1;
    u32x2 xn[4], yn[4][4];
#define P10_REQ(tx) do { _Pragma("unroll") for (int q = 0; q < 4; ++q) { const int c = q * 256 + lane * 4; xn[q] = *(const u32x2*)(X1 + (size_t)(tx) * 1024 + c); \
        _Pragma("unroll") for (int k = 0; k < 4; ++k) yn[q][k] = __builtin_nontemporal_load((const u32x2*)(YP + ((size_t)(tx) * 4 + k) * 1024 + c)); } } while (0)
    P10_REQ(tb);
#pragma unroll
    for (int q = 0; q < 4; ++q) gain[q] = (l < NL - 1) ? *(const f32x4*)(P.in[I_NMIX] + (size_t)(l + 1) * 1024 + q * 256 + lane * 4) : *(const f32x4*)(P.in[I_NFIN] + q * 256 + lane * 4);
#pragma unroll 1
    for (int t = tb; t < te; ++t) {
        const int mj = tok_modj(t);
        if (mj != curj) { curj = mj; const float* md = MODL + (size_t)mj * 6144; const float* mdn = md + (size_t)9 * 6144;
#pragma unroll
            for (int q = 0; q < 4; ++q) { const int c = q * 256 + lane * 4; g2v[q] = *(const f32x4*)(md + 5120 + c);
                if (l < NL - 1) { scv[q] = *(const f32x4*)(mdn + 1024 + c); shv[q] = *(const f32x4*)(mdn + c); } } }
        f32x4 v[4];
#pragma unroll
        for (int q = 0; q < 4; ++q) { f32x4 s = (f32x4){0.f, 0.f, 0.f, 0.f};
#pragma unroll
            for (int k = 0; k < 4; ++k) { float y[4]; unpack4(yn[q][k], y); s[0] += y[0]; s[1] += y[1]; s[2] += y[2]; s[3] += y[3]; }
            float x1_[4]; unpack4(xn[q], x1_);
            v[q] = (f32x4){x1_[0], x1_[1], x1_[2], x1_[3]} + g2v[q] * s; }
        if (t + 1 < te) P10_REQ(t + 1);
        float ss = 0.f;
#pragma unroll
        for (int q = 0; q < 4; ++q) ss += v[q][0] * v[q][0] + v[q][1] * v[q][1] + v[q][2] * v[q][2] + v[q][3] * v[q][3];
        ss = wave_sum(ss); const float rs = rsqrtf(ss * (1.f / 1024.f) + EPSN);
        if (l < NL - 1) {
#pragma unroll
            for (int q = 0; q < 4; ++q) { const int c = q * 256 + lane * 4;
                u32x2 o_; o_[0] = cvt_pk_bf16(v[q][0], v[q][1]); o_[1] = cvt_pk_bf16(v[q][2], v[q][3]); *(u32x2*)((bf16_t*)(ws + WS_XC) + (size_t)t * 1024 + c) = o_;
                u32x2 h_; h_[0] = cvt_pk_bf16(v[q][0] * rs * gain[q][0] * (1.f + scv[q][0]) + shv[q][0], v[q][1] * rs * gain[q][1] * (1.f + scv[q][1]) + shv[q][1]);
                h_[1] = cvt_pk_bf16(v[q][2] * rs * gain[q][2] * (1.f + scv[q][2]) + shv[q][2], v[q][3] * rs * gain[q][3] * (1.f + scv[q][3]) + shv[q][3]);
                *(u32x2*)((bf16_t*)(ws + WS_H) + (size_t)t * 1024 + c) = h_; }
        } else {
#pragma unroll
            for (int q = 0; q < 4; ++q) { const int c = q * 256 + lane * 4; *(f32x4*)(P.out + (size_t)t * 1024 + c) = v[q] * rs * gain[q]; }
        }
    }
#undef P10_REQ
}

#ifndef PROBE_ID
#define PROBE_ID 0
#endif
template <class Tsrc> __device__ __forceinline__ void probe_dump(const Tsrc* src, size_t n, float* out) {
    const size_t nout = (size_t)TL * 1024; const size_t gth = (size_t)blockIdx.x * NTH + threadIdx.x, nth = (size_t)gridDim.x * NTH;
    for (size_t i = gth; i < nout; i += nth) { float v;
        if constexpr (sizeof(Tsrc) == 2) v = bf2f(((const bf16_t*)src)[i % n]); else v = (float)src[i % n];
        out[i] = v; }
}
#define PROBE_AT(id, type, off, n) do { if (PROBE_ID == (id) && l == 0) { GRID_BAR(); probe_dump((const type*)(WSP + (off)), (size_t)(n), kparams()->out); return; } } while (0)

template <class Tsrc> __device__ __forceinline__ void probe_max(const Tsrc* src, size_t lo, size_t hi, float* out, unsigned* word) {
    const size_t nout = (size_t)TL * 1024; const size_t gth = (size_t)blockIdx.x * NTH + threadIdx.x, nth = (size_t)gridDim.x * NTH;
    float m = 0.f;
    for (size_t i = lo + gth; i < hi; i += nth) { float v; if constexpr (sizeof(Tsrc) == 2) v = bf2f(((const bf16_t*)src)[i]); else v = (float)src[i]; m = fmaxf(m, fabsf(v)); }
    atomicMax(word, __float_as_uint(m));
    for (size_t i = gth; i < nout; i += nth) out[i] = 0.f;
}
#define PROBE_MAX(id, type, off, lo, hi) do { if (PROBE_ID == (id) && l == 0) { GRID_BAR(); unsigned* w_ = (unsigned*)(WSP + WS_CTL) + 3600; probe_max((const type*)(WSP + (off)), (size_t)(lo), (size_t)(hi), kparams()->out, w_); \
    GRID_BAR(); if (blockIdx.x == 0 && threadIdx.x == 0) kparams()->out[0] = __uint_as_float(__hip_atomic_load(w_, __ATOMIC_RELAXED, __HIP_MEMORY_SCOPE_AGENT)); return; } } while (0)

template <class Tsrc> __device__ __forceinline__ void probe_cnt(const Tsrc* src, size_t lo, size_t hi, float thr, float* out, unsigned* word) {
    const size_t nout = (size_t)TL * 1024; const size_t gth = (size_t)blockIdx.x * NTH + threadIdx.x, nth = (size_t)gridDim.x * NTH;
    unsigned m = 0;
    for (size_t i = lo + gth; i < hi; i += nth) { float v; if constexpr (sizeof(Tsrc) == 2) v = bf2f(((const bf16_t*)src)[i]); else v = (float)src[i]; m += (fabsf(v) > thr || v != v) ? 1u : 0u; }
    atomicAdd(word, m);
    for (size_t i = gth; i < nout; i += nth) out[i] = 0.f;
}
#define PROBE_CNT(id, type, off, lo, hi, thr) do { if (PROBE_ID == (id) && l == 0) { GRID_BAR(); unsigned* w_ = (unsigned*)(WSP + WS_CTL) + 3600; probe_cnt((const type*)(WSP + (off)), (size_t)(lo), (size_t)(hi), thr, kparams()->out, w_); \
    GRID_BAR(); if (blockIdx.x == 0 && threadIdx.x == 0) kparams()->out[0] = 100.f + (float)__hip_atomic_load(w_, __ATOMIC_RELAXED, __HIP_MEMORY_SCOPE_AGENT); return; } } while (0)

__device__ __forceinline__ void probe_cnt2(const bf16_t* src, int r0, int r1, int c0, int c1, int ld, float thr, float* out, unsigned* word) {
    const size_t nout = (size_t)TL * 1024; const size_t gth = (size_t)blockIdx.x * NTH + threadIdx.x, nth = (size_t)gridDim.x * NTH;
    unsigned m = 0; const size_t w = (size_t)(c1 - c0), n = (size_t)(r1 - r0) * w;
    for (size_t i = gth; i < n; i += nth) { const size_t r = r0 + i / w, c = c0 + i % w; const float v = bf2f(src[r * ld + c]); m += (fabsf(v) > thr || v != v) ? 1u : 0u; }
    atomicAdd(word, m);
    for (size_t i = gth; i < nout; i += nth) out[i] = 0.f;
}
#define PROBE_CNT2(id, off, r0, r1, c0, c1, ld, thr) do { if (PROBE_ID == (id) && l == 0) { GRID_BAR(); unsigned* w_ = (unsigned*)(WSP + WS_CTL) + 3600; probe_cnt2((const bf16_t*)(WSP + (off)), r0, r1, c0, c1, ld, thr, kparams()->out, w_); \
    GRID_BAR(); if (blockIdx.x == 0 && threadIdx.x == 0) kparams()->out[0] = 100.f + (float)__hip_atomic_load(w_, __ATOMIC_RELAXED, __HIP_MEMORY_SCOPE_AGENT); return; } } while (0)

#ifndef PROBE_TI
#define PROBE_TI -1
#endif
#ifndef PROBE_TJ
#define PROBE_TJ 0
#endif
__device__ __forceinline__ void tstamp(unsigned char* wsp, int slot) {
    if (PROBE_TI >= 0 && blockIdx.x == 0 && threadIdx.x == 0) {
        unsigned long long* tw = (unsigned long long*)(wsp + WS_CTL + 14400);
        const unsigned long long now = wall_clock64(); const unsigned long long prev = tw[0];
        if (slot >= 0) tw[1 + slot] += now - prev;
        tw[0] = now;
    }
}
__device__ __forceinline__ void tdump(unsigned char* wsp, float* out) {
    if (PROBE_TI >= 0 && blockIdx.x == 0 && threadIdx.x == 0) {
        const unsigned long long* tw = (const unsigned long long*)(wsp + WS_CTL + 14400);
        out[0] = 10.f * log2f((float)tw[1 + (PROBE_TI >= 0 ? PROBE_TI : 0)] * 0.01f + 1.f) - 25.f;
    }
}
constexpr int MOE_TILES_P5 = 3712;
#ifndef EXP_P4
#define EXP_P4 0
#endif
#ifndef DUP_MASK
#define DUP_MASK 0
#endif
#define smem fresh_smem()
#define lds fresh_lds()
#define bid obid()
#define LL l
#define P (*kparams())
#define WSP (kparams()->ws)
#define TS(slot) tstamp(WSP, slot)
#define GRID_BAR() do { XcdBarrier b_; b_.bar = (unsigned*)(kparams()->ws + WS_CTL); b_.x = xb_xcc_id(); b_.st = (volatile LAS unsigned*)(lds + LDS_XB); xcd_barrier(b_); } while (0)
template <int l> __device__ __forceinline__ void run_layer() {
    const int G = gridDim.x;
    constexpr int TT = (l == NL - 1) ? TL : T;
        for (int rep_ = 0; rep_ < ((DUP_MASK & 2) ? 2 : 1); ++rep_) {
        { Src1 S{(const char*)(WSP + WS_H), (const char*)(WSP + WS_W1T) + (size_t)LL * N1 * 2048, (const char*)(WSP + WS_WFT) + (size_t)LL * 512 * 2048, G, bid};
          Epi1 E{(bf16_t*)(WSP + WS_G), (bf16_t*)(WSP + WS_PJ), (float*)(WSP + WS_DTR), (bf16_t*)(WSP + WS_VT), (bf16_t*)(WSP + WS_VTC)};
          pg8::gemm_phase<false>(lds, S, E, 1024, 1024); }
        PROBE_AT(1, bf16_t, WS_PJ, (size_t)T * PJW);
        PROBE_AT(2, bf16_t, WS_G, (size_t)T * 4096);
        PROBE_MAX(20, bf16_t, WS_G, 0, (size_t)T * 4096);
        PROBE_MAX(21, bf16_t, WS_PJ, 0, (size_t)T * PJW);
        PROBE_CNT(23, bf16_t, WS_G, 0, (size_t)T * 4096, 1.001f);
        PROBE_CNT2(24, WS_G, 0, T, 0, 2048, 4096, 1.001f);
        PROBE_CNT2(25, WS_G, 0, T, 3840, 4096, 4096, 1.001f);
        PROBE_CNT2(26, WS_G, 0, 256, 0, 4096, 4096, 1.001f);
        PROBE_MAX(22, bf16_t, WS_H, 0, (size_t)T * 1024);
        GRID_BAR();
        }
        TS(2);
        for (int rep_ = 0; rep_ < ((DUP_MASK & (32 | 64)) ? 2 : 1); ++rep_) {
        p3_prep(P, smem, LL);
        GRID_BAR();
        }
        TS(3);
        for (int rep_ = 0; rep_ < ((DUP_MASK & 4) ? 2 : 1); ++rep_) {
        { dft_nyquist((const bf16_t*)(WSP + WS_VT), (bf16_t*)(WSP + WS_YC), bid * 8, 8);
          if (G < 256) for (int r0_ = G * 8; r0_ < 2048; r0_ += 8) dft_nyquist((const bf16_t*)(WSP + WS_VT), (bf16_t*)(WSP + WS_YC), r0_, 8);
          unsigned* wq_ = (unsigned*)(WSP + WS_CTL) + 3800 + l;
#pragma unroll 1
          for (;;) {
              __syncthreads();
              if (threadIdx.x == 0) *(volatile LAS int*)(lds + LDS_XB + 32) = (int)__hip_atomic_fetch_add(wq_, 1u, __ATOMIC_RELAXED, __HIP_MEMORY_SCOPE_AGENT);
              __syncthreads();
              const int idx_ = __builtin_amdgcn_readfirstlane(*(volatile LAS int*)(lds + LDS_XB + 32));
              if (idx_ >= 136 + 256 + NB * 2 * NCH) break;
              if (idx_ < 136) { if (EXP_P4 & 1) continue;
                  SrcDft S{(const char*)(WSP + WS_D4C), (const char*)(WSP + WS_D4S), (const char*)(WSP + WS_D256), (const char*)(WSP + WS_VT), (const char*)(WSP + WS_VTC), idx_, 1000};
                  EpiDft E{(bf16_t*)(WSP + WS_YC)};
                  pg8::gemm_phase<false>(lds, S, E, 4096, 8192); }
              else if (idx_ < 136 + 256) { if (!(EXP_P4 & 2)) hyena_conv_channel(P, smem, lds, LL, idx_ - 136); }
              else { if (!(EXP_P4 & 4)) ssd_a_unit(P, smem, lds, LL, idx_ - 136 - 256); }
          }
          TS(16); }
        GRID_BAR();
        }
        TS(4);
        for (int rep_ = 0; rep_ < ((DUP_MASK & (32 | 128)) ? 2 : 1); ++rep_) {
        ssd_phase_b(P);
        hyena_finish(P, smem, LL);
        GRID_BAR();
        }
        TS(5);
        for (int rep_ = 0; rep_ < ((DUP_MASK & (32 | 256)) ? 2 : 1); ++rep_) {
        ssd_phase_c(P, smem, lds, LL);
        PROBE_AT(3, bf16_t, WS_YC, (size_t)T * YCW);
        GRID_BAR();
        }
        TS(6);
        for (int rep_ = 0; rep_ < ((DUP_MASK & 16) ? 2 : 1); ++rep_) {
        { SrcBr S{(const char*)(WSP + WS_YC), (const char*)(WSP + WS_WBRT) + (size_t)LL * 1024 * YCW * 2, G, bid, TT / 256};
          EpiBr E{(const bf16_t*)(WSP + WS_G), (bf16_t*)(WSP + WS_MG), (const float*)(WSP + WS_SSQ)};
          pg8::gemm_phase<false>(lds, S, E, YCW, YCW); }
        {
            constexpr int NSU = (TT / 256) * 4; const int rem = NSU % G, b_ = bid;
            const int nearly = rem == 0 ? G : G - rem, part = rem == 0 ? b_ : b_ - rem;
            if (part >= 0) p0_transposes(P, smem, l * TILES_PER_LAYER + TILES_DENSE + MOE_TILES_P0, l * TILES_PER_LAYER + TILES_DENSE + MOE_TILES_P0 + MOE_TILES_P5, part, nearly); }
        GRID_BAR();
        }
        TS(7);
        for (int rep_ = 0; rep_ < ((DUP_MASK & 32768) ? 2 : 1); ++rep_) {
        PROBE_AT(6, bf16_t, WS_MG, (size_t)T * 1024);
        PROBE_AT(7, float, WS_SSQ, (size_t)T * 8);
        { SrcOut S{(const char*)(WSP + WS_MG), (const char*)(WSP + WS_WOUTT) + (size_t)LL * 1024 * 2048, G, bid, TT / 256};
          if constexpr (l == 0) { EpiOut<true> E{P.in[I_X], P.in[I_CTX], (bf16_t*)(WSP + WS_X1), (const float*)(WSP + WS_MOD) + (size_t)LL * 9 * 6144}; pg8::gemm_phase<false>(lds, S, E, 1024, 1024); }
          else { EpiOut<false> E{(const bf16_t*)(WSP + WS_XC), (const bf16_t*)(WSP + WS_XC) + (size_t)TL * 1024, (bf16_t*)(WSP + WS_X1), (const float*)(WSP + WS_MOD) + (size_t)LL * 9 * 6144}; pg8::gemm_phase<false>(lds, S, E, 1024, 1024); } }
        {
            constexpr int NSU = (TT / 256) * 4; const int rem = NSU % G, b_ = bid;
            const int nearly = rem == 0 ? G : G - rem, part = rem == 0 ? b_ : b_ - rem;
            if (part >= 0) p0_transposes(P, smem, l * TILES_PER_LAYER + TILES_DENSE + MOE_TILES_P0 + MOE_TILES_P5, (l + 1) * TILES_PER_LAYER, part, nearly); }
        GRID_BAR();
        }
        TS(8);
        for (int rep_ = 0; rep_ < ((DUP_MASK & (32 | 512)) ? 2 : 1); ++rep_) {
        PROBE_AT(4, bf16_t, WS_X1, (size_t)T * 1024);
        p7a_route(P, smem, lds, LL, TT);
        GRID_BAR();
        }
        TS(9);
        for (int rep_ = 0; rep_ < ((DUP_MASK & (32 | 1024)) ? 2 : 1); ++rep_) {
        p7b_scatter(P, smem, TT);
        GRID_BAR();
        if (DUP_MASK & 65536) { GRID_BAR(); GRID_BAR(); GRID_BAR(); GRID_BAR(); GRID_BAR(); GRID_BAR(); GRID_BAR(); GRID_BAR(); }
        }
        TS(10);
        for (int rep_ = 0; rep_ < ((DUP_MASK & 8) ? 2 : 1); ++rep_) {
        { SrcUp S{(const char*)(WSP + WS_H2), (const char*)(WSP + WS_WUPT) + (size_t)LL * 32 * 2048 * 2048, (const int*)(WSP + WS_RTOK), (const int*)(WSP + WS_META), G, bid};
          EpiUp E{(bf16_t*)(WSP + WS_ACTB), P.in[I_BUP] + (size_t)LL * 32 * 2048};
          pg8::gemm_phase<true>(lds, S, E, 1024, 1024); }
        GRID_BAR();
        }
        TS(11);
        for (int rep_ = 0; rep_ < ((DUP_MASK & 8) ? 2 : 1); ++rep_) {
        { SrcDn S{(const char*)(WSP + WS_ACTB), (const char*)(WSP + WS_WDNT) + (size_t)LL * 32 * 1024 * 2048, (const int*)(WSP + WS_META), G, bid};
          EpiDn E{(bf16_t*)(WSP + WS_YP), P.in[I_BDN] + (size_t)LL * 32 * 1024, (const int*)(WSP + WS_RPAIR), (const float*)(WSP + WS_RW)};
          pg8::gemm_phase<false>(lds, S, E, 1024, 1024); }
        GRID_BAR();
        }
        TS(12);
        for (int rep_ = 0; rep_ < ((DUP_MASK & (32 | 2048)) ? 2 : 1); ++rep_) {
        PROBE_AT(5, bf16_t, WS_YP, (size_t)T * 4 * 1024);
        p10_combine(P, LL);
        GRID_BAR();
        }
        TS(13);
}
__global__ void __launch_bounds__(NTH, 2) fwd_kernel(Params Pk) {
    const int tid = threadIdx.x, G = gridDim.x;
    if (tid < 4) ((volatile LAS unsigned*)(lds + LDS_XB))[tid] = 0u;
    __syncthreads();
    (void)xcd_barrier_post((unsigned*)(Pk.ws + WS_CTL), (volatile LAS unsigned*)(lds + LDS_XB));

    TS(-1);
    for (int rep_ = 0; rep_ < ((DUP_MASK & 1) ? 2 : 1); ++rep_) {
    p0_prep(P, smem);
    GRID_BAR();
    }
    TS(0);
    p1_norm0(P);
    GRID_BAR();
    TS(1);
    run_layer<0>(); run_layer<1>(); run_layer<2>(); run_layer<3>();
    if (PROBE_TI >= 0) { GRID_BAR(); tdump(WSP, kparams()->out); }
}
#undef bid
#undef LL
#undef smem
#undef lds
#undef GRID_BAR
#undef P
#undef WSP
#undef TS

extern "C" void kernel_launch(void* const* d_in, const int* in_sizes, int n_in, void* d_out, int out_size, void* d_ws, size_t ws_size, hipStream_t stream) {
    static int grid = 0;
    if (grid == 0) {
        if (n_in != 35 || ws_size < WS_END) { fprintf(stderr, "kernel_launch: need 35 inputs and %zu bytes of workspace (got %d, %zu)\n", (size_t)WS_END, n_in, ws_size); grid = -1; return; }
        int dev = 0, cus = 0, per_cu = 0;
        if (hipGetDevice(&dev) != hipSuccess || hipDeviceGetAttribute(&cus, hipDeviceAttributeMultiprocessorCount, dev) != hipSuccess) { grid = -1; return; }
        if (hipFuncSetAttribute((const void*)fwd_kernel, hipFuncAttributeMaxDynamicSharedMemorySize, LDS_BYTES) != hipSuccess) { fprintf(stderr, "kernel_launch: hipFuncSetAttribute failed\n"); grid = -1; return; }
        if (hipOccupancyMaxActiveBlocksPerMultiprocessor(&per_cu, (const void*)fwd_kernel, NTH, LDS_BYTES) != hipSuccess || per_cu < 1) { fprintf(stderr, "kernel_launch: occupancy query says %d\n", per_cu); }
        (void)hipGetLastError();
        grid = cus;
    }
    if (grid < 0) return;
    (void)in_sizes; (void)out_size;
    hipMemsetAsync((char*)d_ws + WS_CTL, 0, 16384, stream);
    Params p{};
    for (int i = 0; i < 35; ++i) p.in[i] = (const float*)d_in[i];
    p.out = (float*)d_out; p.ws = (unsigned char*)d_ws;
    hipLaunchKernelGGL(fwd_kernel, dim3(grid), dim3(NTH), LDS_BYTES, stream, p);
}
```
